# Optimizing an MI355X kernel written in HIP

```python
import math
import jax, jax.numpy as jnp
from jax import lax
import numpy as np

D_MODEL = 1024
BATCH = 2
SEQ = 8192
DEPTH = 1

CHUNK = 64
Q_BLOCK = 128
N_HEADS_A = 4
HEAD_DIM = 64
D_ATTN = N_HEADS_A * 2 * HEAD_DIM
POOL_WINDOWS = (2, 4, 8, 16)
N_POOL_GROUPS = 4
POOL_GROUP_DIM = 128
D_POOL = N_POOL_GROUPS * POOL_GROUP_DIM
D_IN = 3 * D_ATTN + D_POOL + 2 * D_MODEL
N_BUCKETS = 32
MAX_DISTANCE = 128
N_EXPERT_GROUPS = 4
EXPERTS_PER_GROUP = 4
N_EXPERTS = N_EXPERT_GROUPS * EXPERTS_PER_GROUP
TOP_K_INNER = 2
D_EXPERT = 512
RMS_EPS = 1e-6

kernel_name = "hybrid_diffattn_pool_hmoe_block"


def rms_norm(x, g):
    xf = x.astype(jnp.float32)
    y = xf * lax.rsqrt(jnp.mean(xf * xf, axis=-1, keepdims=True) + RMS_EPS)
    return (y * g.astype(jnp.float32)).astype(x.dtype)


def t5_bucket(rel):
    nb = N_BUCKETS // 2
    max_exact = nb // 2
    bucket = jnp.where(rel > 0, nb, 0)
    n = jnp.abs(rel)
    n_f = jnp.maximum(n, max_exact).astype(jnp.float32)
    large = max_exact + (jnp.log(n_f / max_exact) / math.log(MAX_DISTANCE / max_exact)
                         * (nb - max_exact)).astype(jnp.int32)
    large = jnp.minimum(large, nb - 1)
    return bucket + jnp.where(n < max_exact, n, large)


def diff_attention(q, k, v, rel_bias, lam):
    s = q.shape[1]
    scale = HEAD_DIM ** -0.5
    outs = []
    for i in range(s // Q_BLOCK):
        q0 = i * Q_BLOCK
        kend = q0 + Q_BLOCK
        qb = q[:, q0:kend]
        kb = k[:, :kend]
        vb = v[:, :kend]
        qpos = jnp.arange(q0, kend)
        kpos = jnp.arange(kend)
        rel = kpos[None, :] - qpos[:, None]
        bias = jnp.transpose(rel_bias[t5_bucket(rel)], (2, 0, 1)).astype(jnp.float32)
        mask = (kpos[None, :] // CHUNK) <= (qpos[:, None] // CHUNK)
        logits = jnp.einsum('bqhmd,bkhmd->bhmqk', qb, kb,
                            preferred_element_type=jnp.float32) * scale + bias[None, :, None]
        logits = jnp.where(mask, logits, -jnp.inf)
        p = jax.nn.softmax(logits, axis=-1)
        a = p[:, :, 0] - lam * p[:, :, 1]
        outs.append(jnp.einsum('bhqk,bkhe->bqhe', a.astype(v.dtype), vb))
    return jnp.concatenate(outs, axis=1)


def multiscale_pool(u, pool_w, pool_scale):
    b, s, _ = u.shape
    ug = u.reshape(b, s, N_POOL_GROUPS, POOL_GROUP_DIM)
    t = jnp.arange(s)
    pooled = []
    for g, w in enumerate(POOL_WINDOWS):
        ch = ug[:, :, g].astype(jnp.float32)
        cs = jnp.concatenate([jnp.zeros((b, 1, POOL_GROUP_DIM), jnp.float32),
                              jnp.cumsum(ch, axis=1)], axis=1)
        lo = jnp.maximum(t + 1 - w, 0)
        win_sum = cs[:, 1:] - cs[:, lo]
        count = jnp.minimum(t + 1, w).astype(jnp.float32)
        pooled.append(win_sum / count[None, :, None] - ch)
    m = jnp.stack(pooled, axis=2).astype(u.dtype)
    y = jnp.einsum('bsgc,gcd->bsgd', m, pool_w).reshape(b, s, D_POOL)
    return y * pool_scale


def hierarchical_moe(h, wg_r, bg_r, we_r, be_r, w_gate, w_up, w_down):
    b, s, d = h.shape
    t = h.reshape(-1, d)
    g_prob = jax.nn.softmax((t @ wg_r + bg_r).astype(jnp.float32), axis=-1)
    g_val, g_idx = lax.top_k(g_prob, 1)
    e_logits = (t @ we_r + be_r).astype(jnp.float32).reshape(-1, N_EXPERT_GROUPS, EXPERTS_PER_GROUP)
    e_sel = jnp.take_along_axis(e_logits, g_idx[:, :, None], axis=1)[:, 0]
    e_prob = jax.nn.softmax(e_sel, axis=-1)
    e_val, e_idx = lax.top_k(e_prob, TOP_K_INNER)
    e_val = e_val / jnp.sum(e_val, axis=-1, keepdims=True)
    weights = g_val * e_val
    expert_id = g_idx * EXPERTS_PER_GROUP + e_idx
    combine = jnp.sum(jax.nn.one_hot(expert_id, N_EXPERTS, dtype=jnp.float32)
                      * weights[..., None], axis=1)
    y = jnp.zeros(t.shape, jnp.float32)
    for e in range(N_EXPERTS):
        hid = jax.nn.silu(t @ w_gate[e]) * (t @ w_up[e])
        y = y + combine[:, e:e + 1] * (hid @ w_down[e]).astype(jnp.float32)
    return y.astype(h.dtype).reshape(b, s, d)


def setup_inputs(seed: int = 0) -> dict:
    key = jax.random.key(seed)
    ks = jax.random.split(key, 32)
    L, D = DEPTH, D_MODEL
    nrm = lambda k, shape, sc: jax.random.normal(k, shape, jnp.float32) * sc
    return {
        "x": nrm(ks[0], (BATCH, SEQ, D), 1.0),
        "c": nrm(ks[1], (BATCH, D), 1.0),
        "rel_bias": nrm(ks[2], (N_BUCKETS, N_HEADS_A), 0.5),
        "ada_w": nrm(ks[3], (L, D, 6 * D), 0.5 * D ** -0.5),
        "ada_b": nrm(ks[4], (L, 6 * D), 0.02),
        "norm1_g": 1.0 + nrm(ks[5], (L, D), 0.02),
        "w_in": nrm(ks[6], (L, D, D_IN), D ** -0.5),
        "q_norm_g": 1.0 + nrm(ks[7], (L, HEAD_DIM), 0.02),
        "k_norm_g": 1.0 + nrm(ks[8], (L, HEAD_DIM), 0.02),
        "lambda_q1": nrm(ks[9], (L, HEAD_DIM), 0.1),
        "lambda_k1": nrm(ks[10], (L, HEAD_DIM), 0.1),
        "lambda_q2": nrm(ks[11], (L, HEAD_DIM), 0.1),
        "lambda_k2": nrm(ks[12], (L, HEAD_DIM), 0.1),
        "subln_g": 1.0 + nrm(ks[13], (L, 2 * HEAD_DIM), 0.02),
        "w_branch_attn": nrm(ks[14], (L, D_ATTN, D), D_ATTN ** -0.5),
        "pool_w": nrm(ks[15], (L, N_POOL_GROUPS, POOL_GROUP_DIM, POOL_GROUP_DIM), POOL_GROUP_DIM ** -0.5),
        "pool_scale": 1.0 + nrm(ks[16], (L, D_POOL), 0.1),
        "w_branch_pool": nrm(ks[17], (L, D_POOL, D), D_POOL ** -0.5),
        "w_out": nrm(ks[18], (L, D, D), D ** -0.5),
        "norm2_g": 1.0 + nrm(ks[19], (L, D), 0.02),
        "router_group_w": nrm(ks[20], (L, D, N_EXPERT_GROUPS), D ** -0.5),
        "router_group_b": nrm(ks[21], (L, N_EXPERT_GROUPS), 0.01),
        "router_expert_w": nrm(ks[22], (L, D, N_EXPERTS), D ** -0.5),
        "router_expert_b": nrm(ks[23], (L, N_EXPERTS), 0.01),
        "expert_w_gate": nrm(ks[24], (L, N_EXPERTS, D, D_EXPERT), D ** -0.5),
        "expert_w_up": nrm(ks[25], (L, N_EXPERTS, D, D_EXPERT), D ** -0.5),
        "expert_w_down": nrm(ks[26], (L, N_EXPERTS, D_EXPERT, D), D_EXPERT ** -0.5),
    }


def reference(x, c, rel_bias, ada_w, ada_b, norm1_g, w_in, q_norm_g, k_norm_g,
              lambda_q1, lambda_k1, lambda_q2, lambda_k2, subln_g, w_branch_attn,
              pool_w, pool_scale, w_branch_pool, w_out, norm2_g,
              router_group_w, router_group_b, router_expert_w, router_expert_b,
              expert_w_gate, expert_w_up, expert_w_down):
    b, s, d = x.shape
    f32 = jnp.float32
    split_pts = [D_ATTN, 2 * D_ATTN, 3 * D_ATTN, 3 * D_ATTN + D_POOL, 3 * D_ATTN + D_POOL + D_MODEL]
    for l in range(DEPTH):
        mod = jax.nn.silu(c) @ ada_w[l] + ada_b[l]
        shift1, scale1, gate1, shift2, scale2, gate2 = jnp.split(mod[:, None, :], 6, axis=-1)

        h = rms_norm(x, norm1_g[l]) * (1 + scale1) + shift1
        proj = h @ w_in[l]
        q, k, v, u, g_attn, g_pool = jnp.split(proj, split_pts, axis=-1)

        q = rms_norm(q.reshape(b, s, N_HEADS_A, 2, HEAD_DIM), q_norm_g[l])
        k = rms_norm(k.reshape(b, s, N_HEADS_A, 2, HEAD_DIM), k_norm_g[l])
        v = v.reshape(b, s, N_HEADS_A, 2 * HEAD_DIM)
        lambda_init = 0.8 - 0.6 * math.exp(-0.3 * l)
        lam = (jnp.exp(jnp.sum(lambda_q1[l].astype(f32) * lambda_k1[l].astype(f32)))
               - jnp.exp(jnp.sum(lambda_q2[l].astype(f32) * lambda_k2[l].astype(f32)))
               + lambda_init)
        o = diff_attention(q, k, v, rel_bias, lam)
        o = rms_norm(o, subln_g[l]) * (1.0 - lambda_init)
        y_attn = o.reshape(b, s, D_ATTN) @ w_branch_attn[l]

        y_pool = multiscale_pool(u, pool_w[l], pool_scale[l]) @ w_branch_pool[l]

        merged = jax.nn.sigmoid(g_attn) * y_attn + jax.nn.sigmoid(g_pool) * y_pool
        x = x + gate1 * (merged @ w_out[l])

        h2 = rms_norm(x, norm2_g[l]) * (1 + scale2) + shift2
        x = x + gate2 * hierarchical_moe(h2, router_group_w[l], router_group_b[l],
                                         router_expert_w[l], router_expert_b[l],
                                         expert_w_gate[l], expert_w_up[l], expert_w_down[l])
    return x
```

```cpp
#include <hip/hip_runtime.h>
#include <cstdio>
#include <cstdint>
#include <cmath>

#ifndef MK_N_LAUNCHES
#define MK_N_LAUNCHES 1
#endif

#define GAS __attribute__((address_space(1)))
#define LAS __attribute__((address_space(3)))
typedef unsigned short bf16;
typedef unsigned v4u __attribute__((ext_vector_type(4)));
typedef unsigned v2u __attribute__((ext_vector_type(2)));
typedef float f32x4 __attribute__((ext_vector_type(4)));

constexpr int NB = 2, SEQ = 8192, DM = 1024, MTOK = NB * SEQ, DIN = 4096, DATT = 512, DPOOL = 512, NEXP = 16, DEXP = 512;
constexpr int NHEAD = 4, HD = 64;
constexpr float RMS_EPS = 1e-6f;
constexpr float LOG2E = 1.4426950408889634f;
constexpr float LAMBDA_INIT = 0.2f;
constexpr int NWAVES = 8, NTHR = 512;
constexpr int LDS_BYTES = 147456;
constexpr int MOE_ROWS = 36864;

constexpr size_t MiB = 1u << 20;
constexpr size_t WS_CTL = 0, CTL_ZERO_BYTES = 1 * MiB;
constexpr size_t WS_MISC = 1 * MiB;
constexpr size_t WS_LIST = 2 * MiB;
constexpr size_t WS_ROUTE = 3 * MiB;
constexpr size_t WS_WIN = 4 * MiB, WS_WBR = 12 * MiB, WS_WOUT = 14 * MiB, WS_W1 = 16 * MiB, WS_W2 = 48 * MiB;
constexpr size_t WS_XN = 64 * MiB;
constexpr size_t WS_Q = 96 * MiB, WS_K = 112 * MiB, WS_V = 128 * MiB, WS_U = 144 * MiB, WS_GA = 160 * MiB, WS_GP = 192 * MiB;
constexpr size_t WS_AB = 224 * MiB;
constexpr size_t WS_HID = 96 * MiB, WS_Y = 132 * MiB;
constexpr size_t WS_END = 256 * MiB;
constexpr int MF_LAM = 0, MF_BIAS = 64  , MF_MOD = 2048  , MF_MODP = 16384  ;
constexpr int CW_CNT = 64;
constexpr int CW_BAR = 4096;

struct Args { const float* in[27]; float* out; unsigned char* ws; int ph_lo, ph_hi; };

struct P {
    const float *x, *c, *rel_bias, *ada_w, *ada_b, *norm1_g, *w_in, *q_norm_g, *k_norm_g, *lq1, *lk1, *lq2, *lk2, *subln_g, *wba, *pool_w, *pool_scale, *wbp, *w_out, *norm2_g,
        *rgw, *rgb, *rew, *reb, *wgate, *wup, *wdown;
    float* out; unsigned char* ws;
    unsigned* ctl; float* miscf; unsigned* list; int* route;
    bf16 *WIN, *WBR, *WOUT, *W1, *W2, *XN, *Q, *K, *V, *U, *GA, *GP, *AB, *HID, *Y;
};

__device__ __forceinline__ unsigned f2bf(float f) { unsigned u = __float_as_uint(f); return (u + 0x7fffu + ((u >> 16) & 1u)) >> 16; }
__device__ __forceinline__ unsigned pk2(float lo, float hi) { return f2bf(lo) | (f2bf(hi) << 16); }
__device__ __forceinline__ float bf2f(unsigned h) { return __uint_as_float(h << 16); }
__device__ __forceinline__ float bflo(unsigned w) { return __uint_as_float(w << 16); }
__device__ __forceinline__ float bfhi(unsigned w) { return __uint_as_float(w & 0xffff0000u); }
__device__ __forceinline__ float wave_sum(float v) {
#pragma unroll
    for (int o = 1; o < 64; o <<= 1) v += __shfl_xor(v, o);
    return v;
}
__device__ __forceinline__ float wave_max(float v) {
#pragma unroll
    for (int o = 1; o < 64; o <<= 1) v = fmaxf(v, __shfl_xor(v, o));
    return v;
}
__device__ __forceinline__ float sigmoidf_(float v) { return 1.0f / (1.0f + __expf(-v)); }
__device__ __forceinline__ float siluf_(float v) { return v / (1.0f + __expf(-v)); }
__device__ __forceinline__ int t5_bucket(int rel) {
    int n = rel < 0 ? -rel : rel;
    int b;
    if (n < 8) b = n; else if (n < 12) b = 8; else if (n < 16) b = 9; else if (n < 23) b = 10; else if (n < 32) b = 11; else if (n < 46) b = 12; else if (n < 64) b = 13; else if (n < 91) b = 14; else b = 15;
    return b + (rel > 0 ? 16 : 0);
}

#define XB_TMO      128
#define XB_XCNT(j)  (256  + 64 * (j))
#define XB_XSUB(j)  (1280 + 64 * (j))
#define XB_XGEN(j)  (2304 + 64 * (j))
#define XB_TOP      3328
#define XB_TOPGEN   3392
#define XCD_BAR_WORDS 3456
#define XB_SPIN_CAP (1u << 18)
__device__ __forceinline__ unsigned xb_ld(unsigned* p)              { return __hip_atomic_load(p, __ATOMIC_RELAXED, __HIP_MEMORY_SCOPE_AGENT); }
__device__ __forceinline__ unsigned xb_add(unsigned* p, unsigned v) { return __hip_atomic_fetch_add(p, v, __ATOMIC_RELAXED, __HIP_MEMORY_SCOPE_AGENT); }
__device__ __forceinline__ unsigned xb_xcc_id() { return (unsigned)__builtin_amdgcn_s_getreg((3 << 11) | 20) & 0xFu; }
#define XB_SPIN(cond, bar) do { unsigned _sp = 0; while (cond) { __builtin_amdgcn_s_sleep(1); \
    if ((++_sp & 255u) == 0u) { if (xb_ld(&(bar)[XB_TMO])) break; if (_sp > XB_SPIN_CAP) { atomicAdd(&(bar)[XB_TMO], 1u); break; } } } } while (0)
struct XcdBarrier { unsigned* bar; unsigned x; volatile LAS unsigned* st; };
__device__ __forceinline__ XcdBarrier xcd_barrier_post(unsigned* bar, volatile LAS unsigned* st) {
    XcdBarrier b; b.bar = bar; b.x = xb_xcc_id(); b.st = st;
    if (threadIdx.x == 0) (void)xb_add(&bar[XB_XCNT(b.x)], 1u);
    return b;
}
__device__ __forceinline__ void xcd_barrier_complete(unsigned* bar, unsigned x, unsigned& nloc, unsigned& nx) {
    const unsigned G = gridDim.x * gridDim.y * gridDim.z;
    unsigned sum, cnt, mine, sp = 0u;
    for (;;) {
        sum = 0u; cnt = 0u; mine = 0u;
#pragma unroll
        for (unsigned j = 0; j < 16; ++j) { const unsigned c = xb_ld(&bar[XB_XCNT(j)]); sum += c; cnt += (c > 0u) ? 1u : 0u; mine = (j == x) ? c : mine; }
        if (sum == G) break;
        __builtin_amdgcn_s_sleep(1);
        if ((++sp & 255u) == 0u) { if (xb_ld(&bar[XB_TMO])) break; if (sp > XB_SPIN_CAP) { atomicAdd(&bar[XB_TMO], 1u); break; } }
    }
    nloc = mine > 0u ? mine : 1u; nx = cnt > 0u ? cnt : 1u;
}
__device__ __forceinline__ void xcd_barrier(const XcdBarrier& b) {
    asm volatile("s_waitcnt vmcnt(0)" ::: "memory");
    __syncthreads();
    if (threadIdx.x == 0) {
        unsigned* bar = b.bar;
        __builtin_amdgcn_s_waitcnt(0);
        unsigned nloc = b.st[0], nx = b.st[1];
        if (nloc == 0u) { xcd_barrier_complete(bar, b.x, nloc, nx); b.st[0] = nloc; b.st[1] = nx; }
        const unsigned old = xb_add(&bar[XB_XSUB(b.x)], 1u);
        const unsigned gen = old / nloc;
        if (old + 1u == (gen + 1u) * nloc) {
            __builtin_amdgcn_fence(__ATOMIC_RELEASE, "agent");
            asm volatile("s_waitcnt vmcnt(0)" ::: "memory");
            const unsigned og = xb_add(&bar[XB_TOP], 1u);
            const unsigned tg = og / nx;
            if (og + 1u == (tg + 1u) * nx) xb_add(&bar[XB_TOPGEN], 1u);
            else XB_SPIN(xb_ld(&bar[XB_TOPGEN]) == tg, bar);
            __builtin_amdgcn_fence(__ATOMIC_ACQUIRE, "agent");
            xb_add(&bar[XB_XGEN(b.x)], 1u);
            asm volatile("s_waitcnt vmcnt(0)" ::: "memory");
        } else {
            XB_SPIN(xb_ld(&bar[XB_XGEN(b.x)]) == gen, bar);
            __builtin_amdgcn_fence(__ATOMIC_ACQUIRE, "agent");
            asm volatile("s_waitcnt vmcnt(0)" ::: "memory");
        }
    }
    __syncthreads();
}

__device__ __forceinline__ void transpose_item(const float* W, int N, bf16* dst, int dpitch, int drow0, int dk0, float* scr, int k0, int n0, int lane) {
#pragma unroll 8
    for (int i = 0; i < 32; ++i) { const int kk = 2 * i + (lane >> 5); scr[kk * 33 + (lane & 31)] = W[(size_t)(k0 + kk) * N + n0 + (lane & 31)]; }
    __builtin_amdgcn_s_waitcnt(0xC07F); asm volatile("" ::: "memory");
    const int c = lane & 7;
#pragma unroll
    for (int j = 0; j < 4; ++j) { const int n = (lane >> 3) + 8 * j; const float* s = scr + (8 * c) * 33 + n;
        v4u o; o.x = pk2(s[0 * 33], s[1 * 33]); o.y = pk2(s[2 * 33], s[3 * 33]); o.z = pk2(s[4 * 33], s[5 * 33]); o.w = pk2(s[6 * 33], s[7 * 33]);
        *(v4u*)(dst + (size_t)(drow0 + n) * dpitch + dk0 + k0 + 8 * c) = o; }
    __builtin_amdgcn_s_waitcnt(0xC07F); asm volatile("" ::: "memory");
}
__device__ __forceinline__ int win_rowmap(int n0) {
    if (n0 >= 1024) return n0;
    const int t = n0 >> 8, rem = n0 & 255, wc = rem >> 6, bj = (rem & 63) >> 5;
    return 256 * t + 128 * bj + 32 * wc;
}
__device__ __forceinline__ int win_colmap_inv(int np) {
    if (np >= 1024) return np;
    const int t = np >> 8, rem = np & 255, bj = rem >> 7, wc = (rem & 127) >> 5, j = rem & 31;
    return 256 * t + 64 * wc + 32 * bj + j;
}
__device__ __forceinline__ void ph_prologue(const P& p, unsigned char* ldsb, int bid, int nb) {
    const int tid = threadIdx.x, lane = tid & 63, wave = tid >> 6;
    float* scr = (float*)(ldsb + wave * 16384);
    const int gw = bid * NWAVES + wave, NGW = nb * NWAVES;
    constexpr int I_IN = 16 * 128, I_BA = 8 * 32, I_BP = 8 * 32, I_OUT = 16 * 32, I_G = 16 * 256, I_U = 16 * 256, I_D = 16 * 256, I_MOD = 96 * 16;
    constexpr int NITEMS = I_MOD + I_IN + I_BA + I_BP + I_OUT + I_G + I_U + I_D;
    for (int it = gw; it < NITEMS; it += NGW) {
        int r = it;
        if (r < I_MOD) {
            const int ch = r % 96, sp = r / 96, j = ch * 64 + lane, k0 = sp * 64;
            const float s0 = siluf_(p.c[k0 + lane]), s1 = siluf_(p.c[DM + k0 + lane]);
            float a0 = 0.f, a1 = 0.f;
#pragma unroll 8
            for (int kk = 0; kk < 64; ++kk) { const float w = p.ada_w[(size_t)(k0 + kk) * 6144 + j]; a0 += __shfl(s0, kk) * w; a1 += __shfl(s1, kk) * w; }
            p.miscf[MF_MODP + (sp * 2 + 0) * 6144 + j] = a0; p.miscf[MF_MODP + (sp * 2 + 1) * 6144 + j] = a1;
            continue;
        }
        r -= I_MOD;
        if (r < I_IN) { const int kb = r / 128, nbk = r % 128; transpose_item(p.w_in, DIN, p.WIN, DM, win_rowmap(nbk * 32), 0, scr, kb * 64, nbk * 32, lane); continue; } r -= I_IN;
        if (r < I_BA) { const int kb = r / 32, nbk = r % 32; transpose_item(p.wba, DM, p.WBR, DM, nbk * 32, 0, scr, kb * 64, nbk * 32, lane); continue; } r -= I_BA;
        if (r < I_BP) { const int kb = r / 32, nbk = r % 32; transpose_item(p.wbp, DM, p.WBR, DM, nbk * 32, 512, scr, kb * 64, nbk * 32, lane); continue; } r -= I_BP;
        if (r < I_OUT) { const int kb = r / 32, nbk = r % 32; transpose_item(p.w_out, DM, p.WOUT, DM, nbk * 32, 0, scr, kb * 64, nbk * 32, lane); continue; } r -= I_OUT;
        if (r < I_G) { const int e = r / 256, q = r % 256, kb = q / 16, nbk = q % 16, n0 = nbk * 32;
            transpose_item(p.wgate + (size_t)e * DM * DEXP, DEXP, p.W1 + (size_t)e * 1024 * 1024, DM, 256 * (n0 >> 7) + (n0 & 127), 0, scr, kb * 64, n0, lane); continue; } r -= I_G;
        if (r < I_U) { const int e = r / 256, q = r % 256, kb = q / 16, nbk = q % 16, n0 = nbk * 32;
            transpose_item(p.wup + (size_t)e * DM * DEXP, DEXP, p.W1 + (size_t)e * 1024 * 1024, DM, 256 * (n0 >> 7) + 128 + (n0 & 127), 0, scr, kb * 64, n0, lane); continue; } r -= I_U;
        { const int e = r / 256, q = r % 256, kb = q / 32, nbk = q % 32;
            transpose_item(p.wdown + (size_t)e * DEXP * DM, DM, p.W2 + (size_t)e * 1024 * 512, DEXP, nbk * 32, 0, scr, kb * 64, nbk * 32, lane); }
    }
    if (bid == 0 && wave == 0) {
        float a = p.lq1[lane] * p.lk1[lane], b2 = p.lq2[lane] * p.lk2[lane];
        a = wave_sum(a); b2 = wave_sum(b2);
        const float lam = __expf(a) - __expf(b2) + LAMBDA_INIT;
        const float gq = wave_max(fabsf(p.q_norm_g[lane])), gk = wave_max(fabsf(p.k_norm_g[lane]));
        if (lane == 0) p.miscf[MF_LAM] = lam;
        for (int h = 0; h < NHEAD; ++h) {
            float bm = lane < 32 ? fabsf(p.rel_bias[lane * 4 + h]) : 0.f; bm = wave_max(bm);
            const float shift = 8.0f * gq * gk + bm;
            for (int i = lane; i < 384; i += 64) { const int rel = i - 256; p.miscf[MF_BIAS + h * 384 + i] = (p.rel_bias[t5_bucket(rel) * 4 + h] - shift) * LOG2E; }
        }
    }
}

__device__ __forceinline__ float mod_sum(const P& p, int b, int j) {
    float s = p.ada_b[j];
#pragma unroll
    for (int sp = 0; sp < 16; ++sp) s += p.miscf[MF_MODP + (sp * 2 + b) * 6144 + j];
    return s;
}
__device__ __forceinline__ void ph_norm1(const P& p, unsigned char* ldsb, int bid, int nb) {
    const int tid = threadIdx.x, lane = tid & 63, wave = tid >> 6;
    float* la = (float*)ldsb; float* ls = la + 1024;
    for (int rb = bid; rb < 256; rb += nb) {
        const int b = rb / 128;
        __syncthreads();
        for (int c = tid; c < 1024; c += NTHR) { la[c] = p.norm1_g[c] * (1.0f + mod_sum(p, b, 1024 + c)); ls[c] = mod_sum(p, b, c); }
        if (tid < 48) { const int j = rb * 48 + tid; p.miscf[MF_MOD + j] = mod_sum(p, j / 6144, j % 6144); }
        __syncthreads();
        for (int i = 0; i < 8; ++i) {
            const int row = rb * 64 + wave * 8 + i;
            const f32x4* xr = (const f32x4*)(p.x + (size_t)row * DM) + lane;
            f32x4 v[4]; float ss = 0.f;
#pragma unroll
            for (int j = 0; j < 4; ++j) { v[j] = xr[64 * j]; ss += v[j].x * v[j].x + v[j].y * v[j].y + v[j].z * v[j].z + v[j].w * v[j].w; }
            const float rstd = rsqrtf(wave_sum(ss) * (1.0f / DM) + RMS_EPS);
            v2u* o = (v2u*)(p.XN + (size_t)row * DM) + lane;
#pragma unroll
            for (int j = 0; j < 4; ++j) { const int c = (64 * j + lane) * 4; const f32x4 a = *(const f32x4*)(la + c), s = *(const f32x4*)(ls + c);
                v2u w; w.x = pk2(v[j].x * rstd * a.x + s.x, v[j].y * rstd * a.y + s.y); w.y = pk2(v[j].z * rstd * a.z + s.z, v[j].w * rstd * a.w + s.w); o[64 * j] = w; }
        }
    }
}

template <class Epi>
__device__ __forceinline__ void gemm_nt_naive(const bf16* A, int lda, const bf16* Bt, int ldb, int M, int N, int K, const Epi& epi, unsigned char* ldsb, int bid, int nb) {
    float* As = (float*)ldsb;
    float* Bs = As + 32 * 68;
    const int tid = threadIdx.x, tm = tid >> 5, tn = tid & 31;
    const int ntn = N / 128, nt = (M / 64) * ntn;
    for (int t = bid; t < nt; t += nb) {
        const int m0 = (t / ntn) * 64, n0 = (t % ntn) * 128;
        float acc[4][4];
#pragma unroll
        for (int i = 0; i < 4; ++i)
#pragma unroll
            for (int j = 0; j < 4; ++j) acc[i][j] = 0.f;
        for (int k0 = 0; k0 < K; k0 += 32) {
            __syncthreads();
            { const int r = tid >> 3, kq = (tid & 7) * 4; const v2u v = *(const v2u*)(A + (size_t)(m0 + r) * lda + k0 + kq);
              As[(kq + 0) * 68 + r] = bflo(v.x); As[(kq + 1) * 68 + r] = bfhi(v.x); As[(kq + 2) * 68 + r] = bflo(v.y); As[(kq + 3) * 68 + r] = bfhi(v.y); }
            { const int r = tid >> 2, kq = (tid & 3) * 8; const v4u v = *(const v4u*)(Bt + (size_t)(n0 + r) * ldb + k0 + kq);
              Bs[(kq + 0) * 132 + r] = bflo(v.x); Bs[(kq + 1) * 132 + r] = bfhi(v.x); Bs[(kq + 2) * 132 + r] = bflo(v.y); Bs[(kq + 3) * 132 + r] = bfhi(v.y);
              Bs[(kq + 4) * 132 + r] = bflo(v.z); Bs[(kq + 5) * 132 + r] = bfhi(v.z); Bs[(kq + 6) * 132 + r] = bflo(v.w); Bs[(kq + 7) * 132 + r] = bfhi(v.w); }
            __syncthreads();
#pragma unroll 8
            for (int k = 0; k < 32; ++k) {
                const f32x4 a = *(const f32x4*)(As + k * 68 + tm * 4), b = *(const f32x4*)(Bs + k * 132 + tn * 4);
#pragma unroll
                for (int i = 0; i < 4; ++i)
#pragma unroll
                    for (int j = 0; j < 4; ++j) acc[i][j] += a[i] * b[j];
            }
        }
#pragma unroll
        for (int i = 0; i < 4; ++i)
#pragma unroll
            for (int j = 0; j < 4; ++j) epi(m0 + tm * 4 + i, n0 + tn * 4 + j, acc[i][j]);
    }
}

struct EpiInNaive {
    float* qkraw; bf16 *V, *U, *GA, *GP;
    __device__ __forceinline__ void operator()(int r, int np, float v) const {
        const int c = win_colmap_inv(np);
        if (c < 1024) qkraw[(size_t)r * 1024 + c] = v;
        else if (c < 1536) V[(size_t)r * 512 + c - 1024] = (bf16)f2bf(v);
        else if (c < 2048) U[(size_t)r * 512 + c - 1536] = (bf16)f2bf(v);
        else if (c < 3072) GA[(size_t)r * 1024 + c - 2048] = (bf16)f2bf(sigmoidf_(v));
        else GP[(size_t)r * 1024 + c - 3072] = (bf16)f2bf(sigmoidf_(v));
    }
};
__device__ __forceinline__ void ph_inproj_naive(const P& p, unsigned char* ldsb, int bid, int nb) {
    EpiInNaive e{p.out, p.V, p.U, p.GA, p.GP};
    gemm_nt_naive(p.XN, DM, p.WIN, DM, MTOK, DIN, DM, e, ldsb, bid, nb);
}
__device__ __forceinline__ void ph_qknorm_naive(const P& p, int bid, int nb) {
    const int tid = threadIdx.x, lane = tid & 63, wave = tid >> 6;
    for (int row = bid * NWAVES + wave; row < MTOK; row += nb * NWAVES) {
        const float* src = p.out + (size_t)row * 1024 + lane * 16;
        float v[16]; float ss = 0.f;
#pragma unroll
        for (int i = 0; i < 16; ++i) { v[i] = src[i]; ss += v[i] * v[i]; }
        ss += __shfl_xor(ss, 1); ss += __shfl_xor(ss, 2);
        const float rstd = rsqrtf(ss * (1.0f / 64.0f) + RMS_EPS);
        const bool isq = lane < 32; const int d0 = (lane & 3) * 16;
        bf16* dst = (isq ? p.Q : p.K) + (size_t)row * 512 + (lane & 31) * 16;
#pragma unroll
        for (int i = 0; i < 16; ++i) { const float g = isq ? p.q_norm_g[d0 + i] * (0.125f * LOG2E) : p.k_norm_g[d0 + i]; dst[i] = (bf16)f2bf(v[i] * rstd * g); }
    }
}

__device__ __forceinline__ float block_max(float v, float* red, int tid) {
    v = wave_max(v); __syncthreads(); if ((tid & 63) == 0) red[tid >> 6] = v; __syncthreads();
    float r = red[0];
#pragma unroll
    for (int i = 1; i < 8; ++i) r = fmaxf(r, red[i]);
    return r;
}
__device__ __forceinline__ float block_sum(float v, float* red, int tid) {
    v = wave_sum(v); __syncthreads(); if ((tid & 63) == 0) red[tid >> 6] = v; __syncthreads();
    float r = 0.f;
#pragma unroll
    for (int i = 0; i < 8; ++i) r += red[i];
    return r;
}
__device__ __forceinline__ void ph_attn_naive(const P& p, unsigned char* ldsb, int bid, int nb) {
    float* sc1 = (float*)ldsb; float* sc2 = sc1 + 8192; float* qs = sc2 + 8192; float* red = qs + 128; float* po = red + 32;
    const int tid = threadIdx.x;
    const float lam = p.miscf[MF_LAM];
    for (int item = bid; item < NB * NHEAD * SEQ; item += nb) {
        const int q = item % SEQ, bh = item / SEQ, h = bh % NHEAD, b = bh / NHEAD;
        const int nk = 64 * (q / 64 + 1);
        const size_t rowq = (size_t)b * SEQ + q;
        __syncthreads();
        if (tid < 128) qs[tid] = bf2f(p.Q[rowq * 512 + h * 128 + tid]);
        __syncthreads();
        float mx1 = -INFINITY, mx2 = -INFINITY;
        for (int j = tid; j < nk; j += NTHR) {
            const bf16* kr = p.K + ((size_t)b * SEQ + j) * 512 + h * 128;
            float s1 = 0.f, s2 = 0.f;
#pragma unroll
            for (int d = 0; d < 64; d += 8) {
                const v4u a = *(const v4u*)(kr + d), c = *(const v4u*)(kr + 64 + d);
                s1 += qs[d] * bflo(a.x) + qs[d + 1] * bfhi(a.x) + qs[d + 2] * bflo(a.y) + qs[d + 3] * bfhi(a.y) + qs[d + 4] * bflo(a.z) + qs[d + 5] * bfhi(a.z) + qs[d + 6] * bflo(a.w) + qs[d + 7] * bfhi(a.w);
                s2 += qs[64 + d] * bflo(c.x) + qs[65 + d] * bfhi(c.x) + qs[66 + d] * bflo(c.y) + qs[67 + d] * bfhi(c.y) + qs[68 + d] * bflo(c.z) + qs[69 + d] * bfhi(c.z) + qs[70 + d] * bflo(c.w) + qs[71 + d] * bfhi(c.w);
            }
            int rel = j - q; if (rel < -256) rel = -256;
            const float bv = p.miscf[MF_BIAS + h * 384 + rel + 256];
            s1 += bv; s2 += bv; sc1[j] = s1; sc2[j] = s2; mx1 = fmaxf(mx1, s1); mx2 = fmaxf(mx2, s2);
        }
        mx1 = block_max(mx1, red, tid); mx2 = block_max(mx2, red, tid);
        float l1 = 0.f, l2 = 0.f;
        for (int j = tid; j < nk; j += NTHR) { const float p1 = exp2f(sc1[j] - mx1), p2 = exp2f(sc2[j] - mx2); sc1[j] = p1; sc2[j] = p2; l1 += p1; l2 += p2; }
        l1 = block_sum(l1, red, tid); l2 = block_sum(l2, red, tid);
        const float i1 = 1.0f / l1, i2 = lam / l2;
        const int d = tid & 127, kq = tid >> 7;
        float o = 0.f;
        const bf16* vb = p.V + (size_t)b * SEQ * 512 + h * 128 + d;
        for (int j = kq; j < nk; j += 4) o += (sc1[j] * i1 - sc2[j] * i2) * bf2f(vb[(size_t)j * 512]);
        po[kq * 128 + d] = o;
        __syncthreads();
        float ov = 0.f, ss = 0.f;
        if (tid < 128) { ov = po[tid] + po[128 + tid] + po[256 + tid] + po[384 + tid]; ss = ov * ov; }
        ss = block_sum(ss, red, tid);
        if (tid < 128) { const float r = rsqrtf(ss * (1.0f / 128.0f) + RMS_EPS); p.AB[rowq * 1024 + h * 128 + tid] = (bf16)f2bf(ov * r * p.subln_g[tid] * (1.0f - LAMBDA_INIT)); }
    }
}
__device__ __forceinline__ void ph_pool_naive(const P& p, unsigned char* ldsb, int bid, int nb) {
    float* mt = (float*)ldsb;
    const int tid = threadIdx.x, i = tid >> 5, c4 = (tid & 31) * 4;
    for (int item = bid; item < (MTOK / 16) * 4; item += nb) {
        const int rb = item >> 2, g = item & 3, w = 2 << g;
        const int r = rb * 16 + i, t = r % SEQ;
        __syncthreads();
#pragma unroll
        for (int cc = 0; cc < 4; ++cc) { const int c = c4 + cc; float s = 0.f;
            for (int jj = 0; jj < w; ++jj) if (t - jj >= 0) s += bf2f(p.U[(size_t)(r - jj) * 512 + g * 128 + c]);
            const float cnt = (float)(t + 1 < w ? t + 1 : w);
            mt[i * 128 + c] = s / cnt - bf2f(p.U[(size_t)r * 512 + g * 128 + c]); }
        __syncthreads();
#pragma unroll
        for (int dd = 0; dd < 4; ++dd) { const int d = c4 + dd; float a = 0.f;
            for (int c = 0; c < 128; ++c) a += mt[i * 128 + c] * p.pool_w[(size_t)(g * 128 + c) * 128 + d];
            p.AB[(size_t)r * 1024 + 512 + g * 128 + d] = (bf16)f2bf(a * p.pool_scale[g * 128 + d]); }
    }
}

struct EpiBrA { bf16* MG; const bf16* GA; __device__ __forceinline__ void operator()(int r, int c, float v) const { MG[(size_t)r * 1024 + c] = (bf16)f2bf(bf2f(GA[(size_t)r * 1024 + c]) * v); } };
struct EpiBrB { bf16* MG; const bf16* GP; __device__ __forceinline__ void operator()(int r, int c, float v) const { MG[(size_t)r * 1024 + c] = (bf16)f2bf(bf2f(MG[(size_t)r * 1024 + c]) + bf2f(GP[(size_t)r * 1024 + c]) * v); } };
__device__ __forceinline__ void ph_branch_naive(const P& p, unsigned char* ldsb, int bid, int nb) {
    EpiBrA ea{p.XN, p.GA}; gemm_nt_naive(p.AB, 1024, p.WBR, 1024, MTOK, DM, 512, ea, ldsb, bid, nb);
    __syncthreads();
    EpiBrB eb{p.XN, p.GP}; gemm_nt_naive(p.AB + 512, 1024, p.WBR + 512, 1024, MTOK, DM, 512, eb, ldsb, bid, nb);
}
struct EpiOutNaive { const float* x; const float* mod; float* out; __device__ __forceinline__ void operator()(int r, int c, float v) const {
    const int b = r / SEQ; out[(size_t)r * 1024 + c] = x[(size_t)r * 1024 + c] + mod[b * 6144 + 2048 + c] * v; } };
__device__ __forceinline__ void ph_wout_naive(const P& p, unsigned char* ldsb, int bid, int nb) {
    EpiOutNaive e{p.x, p.miscf + MF_MOD, p.out}; gemm_nt_naive(p.XN, 1024, p.WOUT, 1024, MTOK, DM, DM, e, ldsb, bid, nb);
}

__device__ __forceinline__ void ph_norm2_route(const P& p, unsigned char* ldsb, int bid, int nb) {
    const int tid = threadIdx.x, lane = tid & 63, wave = tid >> 6;
    float* la = (float*)ldsb; float* ls = la + 1024; float* wr = ls + 1024;
    for (int i = tid; i < 1024 * 20; i += NTHR) { const int o = i / 1024, c = i % 1024; wr[i] = o < 4 ? p.rgw[c * 4 + o] : p.rew[c * 16 + o - 4]; }
    for (int rb = bid; rb < 256; rb += nb) {
        const int b = rb / 128;
        __syncthreads();
        for (int c = tid; c < 1024; c += NTHR) { la[c] = p.norm2_g[c] * (1.0f + p.miscf[MF_MOD + b * 6144 + 4096 + c]); ls[c] = p.miscf[MF_MOD + b * 6144 + 3072 + c]; }
        __syncthreads();
#pragma unroll 1
        for (int i = 0; i < 8; ++i) {
            const int row = rb * 64 + wave * 8 + i;
            const f32x4* xr = (const f32x4*)(p.out + (size_t)row * DM) + lane;
            f32x4 v[4]; float ss = 0.f;
#pragma unroll
            for (int j = 0; j < 4; ++j) { v[j] = xr[64 * j]; ss += v[j].x * v[j].x + v[j].y * v[j].y + v[j].z * v[j].z + v[j].w * v[j].w; }
            const float rstd = rsqrtf(wave_sum(ss) * (1.0f / DM) + RMS_EPS);
            v2u* o = (v2u*)(p.XN + (size_t)row * DM) + lane;
#pragma unroll
            for (int j = 0; j < 4; ++j) { const int c = (64 * j + lane) * 4; const f32x4 a = *(const f32x4*)(la + c), s = *(const f32x4*)(ls + c);
                f32x4 hh; hh.x = v[j].x * rstd * a.x + s.x; hh.y = v[j].y * rstd * a.y + s.y; hh.z = v[j].z * rstd * a.z + s.z; hh.w = v[j].w * rstd * a.w + s.w;
                v2u w; w.x = pk2(hh.x, hh.y); w.y = pk2(hh.z, hh.w); o[64 * j] = w; v[j] = hh; }
            float mylg = 0.f;
#pragma unroll 1
            for (int oo = 0; oo < 20; ++oo) { float s = 0.f;
#pragma unroll
                for (int j = 0; j < 4; ++j) { const f32x4 w = *(const f32x4*)(wr + oo * 1024 + (64 * j + lane) * 4); s += v[j].x * w.x + v[j].y * w.y + v[j].z * w.z + v[j].w * w.w; }
                s = wave_sum(s); mylg = (lane == oo) ? s : mylg; }
            float lg[20];
#pragma unroll
            for (int k = 0; k < 20; ++k) lg[k] = __shfl(mylg, k);
            if (lane == 0) {
                const float g0 = lg[0] + p.rgb[0], g1 = lg[1] + p.rgb[1], g2 = lg[2] + p.rgb[2], g3 = lg[3] + p.rgb[3];
                int gi = 0; float gm = g0;
                if (g1 > gm) { gm = g1; gi = 1; } if (g2 > gm) { gm = g2; gi = 2; } if (g3 > gm) { gm = g3; gi = 3; }
                const float gval = 1.0f / (__expf(g0 - gm) + __expf(g1 - gm) + __expf(g2 - gm) + __expf(g3 - gm));
                float el[4];
#pragma unroll
                for (int k = 0; k < 4; ++k) { float t = 0.f;
#pragma unroll
                    for (int gg = 0; gg < 4; ++gg) t = (gg == gi) ? lg[4 + gg * 4 + k] + p.reb[gg * 4 + k] : t;
                    el[k] = t; }
                int i0 = 0; float m0 = el[0];
#pragma unroll
                for (int k = 1; k < 4; ++k) if (el[k] > m0) { m0 = el[k]; i0 = k; }
                int i1 = 0; float m1 = -INFINITY;
#pragma unroll
                for (int k = 0; k < 4; ++k) if (k != i0 && el[k] > m1) { m1 = el[k]; i1 = k; }
                const float e1 = __expf(m1 - m0);
                const float w0 = gval / (1.0f + e1), w1 = gval * e1 / (1.0f + e1);
                const int x0 = gi * 4 + i0, x1 = gi * 4 + i1;
                const unsigned p0 = atomicAdd(p.ctl + CW_CNT + x0, 1u), p1 = atomicAdd(p.ctl + CW_CNT + x1, 1u);
                p.list[x0 * MTOK + p0] = (unsigned)row; p.list[x1 * MTOK + p1] = (unsigned)row;
                int4 ri; ri.x = x0 | (x1 << 8); ri.y = (int)(p0 | (p1 << 16)); ri.z = __float_as_int(w0); ri.w = __float_as_int(w1); *(int4*)(p.route + (size_t)row * 4) = ri;
            }
        }
    }
}

__device__ __forceinline__ void moe_offsets(const P& p, int* arr) {
    __syncthreads();
    if (threadIdx.x == 0) { int o = 0;
        for (int e = 0; e < NEXP; ++e) { const int n = (int)__hip_atomic_load(p.ctl + CW_CNT + e, __ATOMIC_RELAXED, __HIP_MEMORY_SCOPE_AGENT); arr[e] = n; arr[16 + e] = o; o += (n + 255) & ~255; }
        arr[32] = o; }
    __syncthreads();
}
__device__ __forceinline__ void ph_moe1_naive(const P& p, unsigned char* ldsb, int bid, int nb) {
    float* hs = (float*)ldsb;
    const int tid = threadIdx.x;
    int* cnt = (int*)(ldsb + 65536); int* off = cnt + 16; moe_offsets(p, cnt);
#pragma unroll 1
    for (int e = 0; e < NEXP; ++e) {
        const int n = cnt[e];
#pragma unroll 1
        for (int pb = bid; pb * 8 < n; pb += nb) {
            __syncthreads();
            for (int idx = tid; idx < 8 * 128; idx += NTHR) { const int s = idx >> 7, ch = idx & 127, pos = pb * 8 + s;
                if (pos < n) { const unsigned tok = p.list[e * MTOK + pos]; const v4u v = *(const v4u*)(p.XN + (size_t)tok * 1024 + ch * 8);
                    float* d = hs + s * 1024 + ch * 8; d[0] = bflo(v.x); d[1] = bfhi(v.x); d[2] = bflo(v.y); d[3] = bfhi(v.y); d[4] = bflo(v.z); d[5] = bfhi(v.z); d[6] = bflo(v.w); d[7] = bfhi(v.w); }
                else { float* d = hs + s * 1024 + ch * 8;
#pragma unroll
                    for (int q = 0; q < 8; ++q) d[q] = 0.f; } }
            __syncthreads();
            const int j = tid;
            const bf16* gr = p.W1 + (size_t)e * 1024 * 1024 + (size_t)(256 * (j >> 7) + (j & 127)) * 1024; const bf16* ur = gr + 128 * 1024;
            float ag[8], au[8];
#pragma unroll
            for (int s = 0; s < 8; ++s) { ag[s] = 0.f; au[s] = 0.f; }
            for (int k = 0; k < 1024; k += 8) {
                const v4u g = *(const v4u*)(gr + k), u = *(const v4u*)(ur + k);
                const float gf[8] = {bflo(g.x), bfhi(g.x), bflo(g.y), bfhi(g.y), bflo(g.z), bfhi(g.z), bflo(g.w), bfhi(g.w)};
                const float uf[8] = {bflo(u.x), bfhi(u.x), bflo(u.y), bfhi(u.y), bflo(u.z), bfhi(u.z), bflo(u.w), bfhi(u.w)};
#pragma unroll
                for (int s = 0; s < 8; ++s) {
#pragma unroll
                    for (int q = 0; q < 8; ++q) { const float hv = hs[s * 1024 + k + q]; ag[s] += hv * gf[q]; au[s] += hv * uf[q]; } }
            }
#pragma unroll
            for (int s = 0; s < 8; ++s) { const int pos = pb * 8 + s; if (pos < n) p.HID[(size_t)(off[e] + pos) * 512 + j] = (bf16)f2bf(siluf_(ag[s]) * au[s]); }
        }
    }
}
__device__ __forceinline__ void ph_moe2_naive(const P& p, unsigned char* ldsb, int bid, int nb) {
    float* hs = (float*)ldsb;
    const int tid = threadIdx.x;
    int* cnt = (int*)(ldsb + 65536); int* off = cnt + 16; moe_offsets(p, cnt);
#pragma unroll 1
    for (int e = 0; e < NEXP; ++e) {
        const int n = cnt[e];
#pragma unroll 1
        for (int pb = bid; pb * 8 < n; pb += nb) {
            __syncthreads();
            { const int s = tid >> 6, ch = tid & 63, pos = pb * 8 + s; float* d = hs + s * 512 + ch * 8;
                if (pos < n) { const v4u v = *(const v4u*)(p.HID + (size_t)(off[e] + pos) * 512 + ch * 8);
                    d[0] = bflo(v.x); d[1] = bfhi(v.x); d[2] = bflo(v.y); d[3] = bfhi(v.y); d[4] = bflo(v.z); d[5] = bfhi(v.z); d[6] = bflo(v.w); d[7] = bfhi(v.w); }
                else {
#pragma unroll
                    for (int q = 0; q < 8; ++q) d[q] = 0.f; } }
            __syncthreads();
#pragma unroll 1
            for (int half = 0; half < 2; ++half) {
                const int nn = tid + half * 512;
                const bf16* wr = p.W2 + (size_t)e * 1024 * 512 + (size_t)nn * 512;
                float a[8];
#pragma unroll
                for (int s = 0; s < 8; ++s) a[s] = 0.f;
                for (int k = 0; k < 512; k += 8) {
                    const v4u g = *(const v4u*)(wr + k);
                    const float gf[8] = {bflo(g.x), bfhi(g.x), bflo(g.y), bfhi(g.y), bflo(g.z), bfhi(g.z), bflo(g.w), bfhi(g.w)};
#pragma unroll
                    for (int s = 0; s < 8; ++s) {
#pragma unroll
                        for (int q = 0; q < 8; ++q) a[s] += hs[s * 512 + k + q] * gf[q]; }
                }
#pragma unroll
                for (int s = 0; s < 8; ++s) { const int pos = pb * 8 + s; if (pos < n) { const unsigned tok = p.list[e * MTOK + pos]; const int4 ri = *(const int4*)(p.route + (size_t)tok * 4);
                    const float w = ((ri.x & 0xff) == e) ? __int_as_float(ri.z) : __int_as_float(ri.w);
                    p.Y[(size_t)(off[e] + pos) * 1024 + nn] = (bf16)f2bf(a[s] * w); } }
            }
        }
    }
}
__device__ __forceinline__ void ph_combine(const P& p, unsigned char* ldsb, int bid, int nb) {
    const int tid = threadIdx.x, lane = tid & 63, wave = tid >> 6;
    int* cnt = (int*)ldsb; int* off = cnt + 16; moe_offsets(p, cnt);
    for (int row = bid * NWAVES + wave; row < MTOK; row += nb * NWAVES) {
        const int4 ri = *(const int4*)(p.route + (size_t)row * 4);
        const size_t s0 = (size_t)(off[ri.x & 0xff] + (ri.y & 0xffff)), s1 = (size_t)(off[(ri.x >> 8) & 0xff] + ((ri.y >> 16) & 0xffff));
        const int b = row / SEQ;
        const float* g2 = p.miscf + MF_MOD + b * 6144 + 5120;
        f32x4* xo = (f32x4*)(p.out + (size_t)row * DM) + lane;
        const v2u* y0 = (const v2u*)(p.Y + s0 * 1024) + lane; const v2u* y1 = (const v2u*)(p.Y + s1 * 1024) + lane;
#pragma unroll
        for (int j = 0; j < 4; ++j) { const int c = (64 * j + lane) * 4; const f32x4 g = *(const f32x4*)(g2 + c); f32x4 v = xo[64 * j]; const v2u a = y0[64 * j], d = y1[64 * j];
            v.x += g.x * (bflo(a.x) + bflo(d.x)); v.y += g.y * (bfhi(a.x) + bfhi(d.x)); v.z += g.z * (bflo(a.y) + bflo(d.y)); v.w += g.w * (bfhi(a.y) + bfhi(d.y)); xo[64 * j] = v; }
    }
}

constexpr int N_PHASES = 11;
__global__ void __launch_bounds__(NTHR, 2) mega_fwd(Args args) {
    extern __shared__ __attribute__((aligned(16))) unsigned char lds[];
    P p;
    p.x = args.in[0]; p.c = args.in[1]; p.rel_bias = args.in[2]; p.ada_w = args.in[3]; p.ada_b = args.in[4]; p.norm1_g = args.in[5]; p.w_in = args.in[6]; p.q_norm_g = args.in[7]; p.k_norm_g = args.in[8];
    p.lq1 = args.in[9]; p.lk1 = args.in[10]; p.lq2 = args.in[11]; p.lk2 = args.in[12]; p.subln_g = args.in[13]; p.wba = args.in[14]; p.pool_w = args.in[15]; p.pool_scale = args.in[16]; p.wbp = args.in[17];
    p.w_out = args.in[18]; p.norm2_g = args.in[19]; p.rgw = args.in[20]; p.rgb = args.in[21]; p.rew = args.in[22]; p.reb = args.in[23]; p.wgate = args.in[24]; p.wup = args.in[25]; p.wdown = args.in[26];
    p.out = args.out; p.ws = args.ws;
    unsigned char* ws = args.ws;
    p.ctl = (unsigned*)(ws + WS_CTL); p.miscf = (float*)(ws + WS_MISC); p.list = (unsigned*)(ws + WS_LIST); p.route = (int*)(ws + WS_ROUTE);
    p.WIN = (bf16*)(ws + WS_WIN); p.WBR = (bf16*)(ws + WS_WBR); p.WOUT = (bf16*)(ws + WS_WOUT); p.W1 = (bf16*)(ws + WS_W1); p.W2 = (bf16*)(ws + WS_W2);
    p.XN = (bf16*)(ws + WS_XN); p.Q = (bf16*)(ws + WS_Q); p.K = (bf16*)(ws + WS_K); p.V = (bf16*)(ws + WS_V); p.U = (bf16*)(ws + WS_U); p.GA = (bf16*)(ws + WS_GA); p.GP = (bf16*)(ws + WS_GP);
    p.AB = (bf16*)(ws + WS_AB); p.HID = (bf16*)(ws + WS_HID); p.Y = (bf16*)(ws + WS_Y);
    const int bid = blockIdx.x, nb = gridDim.x;
    const int lo = args.ph_lo, hi = args.ph_hi;
    volatile LAS unsigned* MISC = (volatile LAS unsigned*)((LAS unsigned char*)lds + LDS_BYTES - 64);
    XcdBarrier bar; bar.bar = p.ctl + CW_BAR; bar.x = 0; bar.st = nullptr;
    if (hi - lo > 1) {
        if (threadIdx.x < 2) MISC[threadIdx.x] = 0u;
        __syncthreads();
        bar = xcd_barrier_post(p.ctl + CW_BAR, MISC);
    }
#ifndef PHASE_MASK
#define PHASE_MASK 0xFFFF
#endif
#define IN(k) (((PHASE_MASK >> (k)) & 1) && lo <= (k) && (k) < hi)
#define SEAM(k) do { if (IN(k) && IN((k) + 1)) xcd_barrier(bar); } while (0)
    if (IN(0)) { ph_prologue(p, lds, bid, nb); } SEAM(0);
    if (IN(1)) { ph_norm1(p, lds, bid, nb); } SEAM(1);
    if (IN(2)) { ph_inproj_naive(p, lds, bid, nb); } SEAM(2);
    if (IN(3)) { ph_qknorm_naive(p, bid, nb); } SEAM(3);
    if (IN(4)) { ph_attn_naive(p, lds, bid, nb); __syncthreads(); ph_pool_naive(p, lds, bid, nb); } SEAM(4);
    if (IN(5)) { ph_branch_naive(p, lds, bid, nb); } SEAM(5);
    if (IN(6)) { ph_wout_naive(p, lds, bid, nb); } SEAM(6);
    if (IN(7)) { ph_norm2_route(p, lds, bid, nb); } SEAM(7);
    if (IN(8)) { ph_moe1_naive(p, lds, bid, nb); } SEAM(8);
    if (IN(9)) { ph_moe2_naive(p, lds, bid, nb); } SEAM(9);
    if (IN(10)) { ph_combine(p, lds, bid, nb); }
#undef IN
#undef SEAM
}

extern "C" void kernel_launch(void* const* d_in, const int* in_sizes, int n_in, void* d_out, int out_size, void* d_ws, size_t ws_size, hipStream_t stream) {
    static int grid = 0;
    if (grid == 0) {
        if (n_in != 27 || in_sizes[0] != MTOK * DM || out_size != MTOK * DM || ws_size < WS_END) {
            fprintf(stderr, "kernel_launch: unexpected shapes: n_in %d in0 %d out %d ws %zu; nothing launched\n", n_in, n_in > 0 ? in_sizes[0] : -1, out_size, ws_size); grid = -1; return; }
        int dev = 0, cus = 0;
        if (hipGetDevice(&dev) != hipSuccess || hipDeviceGetAttribute(&cus, hipDeviceAttributeMultiprocessorCount, dev) != hipSuccess) { grid = -1; return; }
        if (hipFuncSetAttribute((const void*)mega_fwd, hipFuncAttributeMaxDynamicSharedMemorySize, LDS_BYTES) != hipSuccess) { fprintf(stderr, "kernel_launch: hipFuncSetAttribute failed\n"); grid = -1; return; }
        int per_cu = 0;
        if (hipOccupancyMaxActiveBlocksPerMultiprocessor(&per_cu, (const void*)mega_fwd, NTHR, LDS_BYTES) != hipSuccess || per_cu < 1)
            fprintf(stderr, "kernel_launch: note: occupancy query reports %d workgroups per CU\n", per_cu);
        (void)hipGetLastError();
        grid = cus;
    }
    if (grid < 0) return;
    (void)hipMemsetAsync((char*)d_ws + WS_CTL, 0, CTL_ZERO_BYTES, stream);
    Args a{};
    for (int i = 0; i < 27; ++i) a.in[i] = (const float*)d_in[i];
    a.out = (float*)d_out; a.ws = (unsigned char*)d_ws;
    if (MK_N_LAUNCHES == 1) {
        a.ph_lo = 0; a.ph_hi = N_PHASES;
        hipLaunchKernelGGL(mega_fwd, dim3(grid), dim3(NTHR), LDS_BYTES, stream, a);
    } else {
        for (int k = 0; k < N_PHASES; ++k) { a.ph_lo = k; a.ph_hi = k + 1; hipLaunchKernelGGL(mega_fwd, dim3(grid), dim3(NTHR), LDS_BYTES, stream, a); }
    }
}
```

```cpp
#include <hip/hip_runtime.h>
#include <cstdio>
#include <cstdint>
#include <cmath>

#define FAST_INPROJ 1
#define FAST_BRANCH 1
#define FAST_WOUT 1
#define FAST_MOE 1
#define FAST_ATTN 1
#ifndef MK_N_LAUNCHES
#define MK_N_LAUNCHES 1
#endif

#define GAS __attribute__((address_space(1)))
#define LAS __attribute__((address_space(3)))
typedef unsigned short bf16;
typedef unsigned v4u __attribute__((ext_vector_type(4)));
typedef unsigned v2u __attribute__((ext_vector_type(2)));
typedef float f32x4 __attribute__((ext_vector_type(4)));

constexpr int NB = 2, SEQ = 8192, DM = 1024, MTOK = NB * SEQ, DIN = 4096, DATT = 512, DPOOL = 512, NEXP = 16, DEXP = 512;
constexpr int NHEAD = 4, HD = 64;
constexpr float RMS_EPS = 1e-6f;
constexpr float LOG2E = 1.4426950408889634f;
constexpr float LAMBDA_INIT = 0.2f;
constexpr int NWAVES = 8, NTHR = 512;
constexpr int LDS_BYTES = 147456;
constexpr int MOE_ROWS = 36864;

constexpr size_t MiB = 1u << 20;
constexpr size_t WS_CTL = 0, CTL_ZERO_BYTES = 1 * MiB;
constexpr size_t WS_MISC = 1 * MiB;
constexpr size_t WS_LIST = 2 * MiB;
constexpr size_t WS_ROUTE = WS_MISC + 512 * 1024;
constexpr size_t WS_WIN = 4 * MiB, WS_WBR = 12 * MiB, WS_WOUT = 14 * MiB, WS_W1 = 16 * MiB, WS_W2 = 48 * MiB;
constexpr size_t WS_XN = 64 * MiB;
constexpr size_t WS_Q = 96 * MiB, WS_K = 112 * MiB, WS_V = 128 * MiB, WS_U = 144 * MiB, WS_GA = 160 * MiB, WS_GP = 192 * MiB;
constexpr size_t WS_AB = 224 * MiB;
constexpr size_t WS_HID = 96 * MiB, WS_Y = 132 * MiB;
constexpr size_t WS_END = 256 * MiB;
constexpr int MF_LAM = 0, MF_BIAS = 64  , MF_MOD = 2048  , MF_MODP = 16384  ;
constexpr int MOD_SPLITS = 8;
constexpr int CW_CNT = 64;
constexpr int CW_BAR = 4096;

struct Args { const float* in[27]; float* out; unsigned char* ws; int ph_lo, ph_hi; };

struct P {
    const float *x, *c, *rel_bias, *ada_w, *ada_b, *norm1_g, *w_in, *q_norm_g, *k_norm_g, *lq1, *lk1, *lq2, *lk2, *subln_g, *wba, *pool_w, *pool_scale, *wbp, *w_out, *norm2_g,
        *rgw, *rgb, *rew, *reb, *wgate, *wup, *wdown;
    float* out; unsigned char* ws;
    unsigned* ctl; float* miscf; unsigned* list; int* route;
    bf16 *WIN, *WBR, *WOUT, *W1, *W2, *XN, *Q, *K, *V, *U, *GA, *GP, *AB, *HID, *Y;
};

__device__ __forceinline__ unsigned f2bf(float f) { unsigned u = __float_as_uint(f); return (u + 0x7fffu + ((u >> 16) & 1u)) >> 16; }
__device__ __forceinline__ unsigned pk2(float lo, float hi) { return f2bf(lo) | (f2bf(hi) << 16); }
__device__ __forceinline__ float bf2f(unsigned h) { return __uint_as_float(h << 16); }
__device__ __forceinline__ float bflo(unsigned w) { return __uint_as_float(w << 16); }
__device__ __forceinline__ float bfhi(unsigned w) { return __uint_as_float(w & 0xffff0000u); }
__device__ __forceinline__ float wave_sum(float v) {
#pragma unroll
    for (int o = 1; o < 64; o <<= 1) v += __shfl_xor(v, o);
    return v;
}
__device__ __forceinline__ float wave_max(float v) {
#pragma unroll
    for (int o = 1; o < 64; o <<= 1) v = fmaxf(v, __shfl_xor(v, o));
    return v;
}
__device__ __forceinline__ float sigmoidf_(float v) { return 1.0f / (1.0f + __expf(-v)); }
__device__ __forceinline__ float siluf_(float v) { return v / (1.0f + __expf(-v)); }
__device__ __forceinline__ int t5_bucket(int rel) {
    int n = rel < 0 ? -rel : rel;
    int b;
    if (n < 8) b = n; else if (n < 12) b = 8; else if (n < 16) b = 9; else if (n < 23) b = 10; else if (n < 32) b = 11; else if (n < 46) b = 12; else if (n < 64) b = 13; else if (n < 91) b = 14; else b = 15;
    return b + (rel > 0 ? 16 : 0);
}

#define XB_TMO      128
#define XB_XCNT(j)  (256  + 64 * (j))
#define XB_XSUB(j)  (1280 + 64 * (j))
#define XB_XGEN(j)  (2304 + 64 * (j))
#define XB_TOP      3328
#define XB_TOPGEN   3392
#define XCD_BAR_WORDS 3456
#define XB_SPIN_CAP (1u << 18)
__device__ __forceinline__ unsigned xb_ld(unsigned* p)              { return __hip_atomic_load(p, __ATOMIC_RELAXED, __HIP_MEMORY_SCOPE_AGENT); }
__device__ __forceinline__ unsigned xb_add(unsigned* p, unsigned v) { return __hip_atomic_fetch_add(p, v, __ATOMIC_RELAXED, __HIP_MEMORY_SCOPE_AGENT); }
__device__ __forceinline__ unsigned xb_xcc_id() { return (unsigned)__builtin_amdgcn_s_getreg((3 << 11) | 20) & 0xFu; }
#define XB_SPIN(cond, bar) do { unsigned _sp = 0; while (cond) { __builtin_amdgcn_s_sleep(1); \
    if ((++_sp & 255u) == 0u) { if (xb_ld(&(bar)[XB_TMO])) break; if (_sp > XB_SPIN_CAP) { atomicAdd(&(bar)[XB_TMO], 1u); break; } } } } while (0)
struct XcdBarrier { unsigned* bar; unsigned x; volatile LAS unsigned* st; };
__device__ __forceinline__ XcdBarrier xcd_barrier_post(unsigned* bar, volatile LAS unsigned* st) {
    XcdBarrier b; b.bar = bar; b.x = xb_xcc_id(); b.st = st;
    if (threadIdx.x == 0) (void)xb_add(&bar[XB_XCNT(b.x)], 1u);
    return b;
}
__device__ __forceinline__ void xcd_barrier_complete(unsigned* bar, unsigned x, unsigned& nloc, unsigned& nx) {
    const unsigned G = gridDim.x * gridDim.y * gridDim.z;
    unsigned sum, cnt, mine, sp = 0u;
    for (;;) {
        sum = 0u; cnt = 0u; mine = 0u;
#pragma unroll
        for (unsigned j = 0; j < 16; ++j) { const unsigned c = xb_ld(&bar[XB_XCNT(j)]); sum += c; cnt += (c > 0u) ? 1u : 0u; mine = (j == x) ? c : mine; }
        if (sum == G) break;
        __builtin_amdgcn_s_sleep(1);
        if ((++sp & 255u) == 0u) { if (xb_ld(&bar[XB_TMO])) break; if (sp > XB_SPIN_CAP) { atomicAdd(&bar[XB_TMO], 1u); break; } }
    }
    nloc = mine > 0u ? mine : 1u; nx = cnt > 0u ? cnt : 1u;
}
__device__ __forceinline__ void xcd_barrier(const XcdBarrier& b) {
    asm volatile("s_waitcnt vmcnt(0)" ::: "memory");
    __syncthreads();
    if (threadIdx.x == 0) {
        unsigned* bar = b.bar;
        __builtin_amdgcn_s_waitcnt(0);
        unsigned nloc = b.st[0], nx = b.st[1];
        if (nloc == 0u) { xcd_barrier_complete(bar, b.x, nloc, nx); b.st[0] = nloc; b.st[1] = nx; }
        const unsigned old = xb_add(&bar[XB_XSUB(b.x)], 1u);
        const unsigned gen = old / nloc;
        if (old + 1u == (gen + 1u) * nloc) {
            __builtin_amdgcn_fence(__ATOMIC_RELEASE, "agent");
            asm volatile("s_waitcnt vmcnt(0)" ::: "memory");
            const unsigned og = xb_add(&bar[XB_TOP], 1u);
            const unsigned tg = og / nx;
            if (og + 1u == (tg + 1u) * nx) xb_add(&bar[XB_TOPGEN], 1u);
            else XB_SPIN(xb_ld(&bar[XB_TOPGEN]) == tg, bar);
            __builtin_amdgcn_fence(__ATOMIC_ACQUIRE, "agent");
            xb_add(&bar[XB_XGEN(b.x)], 1u);
            asm volatile("s_waitcnt vmcnt(0)" ::: "memory");
        } else {
            XB_SPIN(xb_ld(&bar[XB_XGEN(b.x)]) == gen, bar);
            __builtin_amdgcn_fence(__ATOMIC_ACQUIRE, "agent");
            asm volatile("s_waitcnt vmcnt(0)" ::: "memory");
        }
    }
    __syncthreads();
}


namespace pg8 {
#define PG8_LAS __attribute__((address_space(3)))
typedef unsigned short bf16_t;
typedef short bf16x8 __attribute__((ext_vector_type(8)));
typedef float f32x4 __attribute__((ext_vector_type(4)));
typedef unsigned u32x4 __attribute__((ext_vector_type(4)));
constexpr int BM = 256, BK = 64, HALF = 128, HTB = HALF * BK * 2, STAGE_BYTES = 8 * HTB, NXCD = 8, WGM = 8;
__host__ __device__ __forceinline__ int lds_byte(int r, int c) { const int st = (r >> 4) * 2 + (c >> 5), rr = r & 15, cc = c & 31, ob = rr * 64 + cc * 2; return st * 1024 + (ob ^ (((ob >> 9) & 1) << 5)); }
__host__ __device__ __forceinline__ void stage_rc(int b, int& R, int& C) { const int st = b / 1024, sb = b % 1024, swz = sb ^ (((sb >> 9) & 1) << 5); R = (st >> 1) * 16 + swz / 64; C = (st & 1) * 32 + (swz % 64) / 2; }
__host__ __device__ __forceinline__ int perm32(int rho) { const int n = rho >> 4, i = rho & 15; return 8 * (i >> 2) + 4 * n + (i & 3); }

struct Unit { int pm, pn, aux, n, pos0; unsigned a_off, b_off; };
struct Gemm { const bf16_t* A; const bf16_t* Bt; int lda, ldb, nt; };

struct StaticOrder {
    int nM, nN, nwg, G, c; unsigned tA, tB;
    __device__ void init(int M, int N, int lda, int ldb, int G_, int c_) { nM = M / BM; nN = N / BM; nwg = nM * nN; G = G_; c = c_; tA = (unsigned)(BM * lda * 2); tB = (unsigned)(BM * ldb * 2); }
    __device__ bool tile(long L, Unit& u) const {
        if (L >= nwg) return false;
        int wgid = (int)L; { const int q = nwg / NXCD, r = nwg % NXCD, xcd = wgid % NXCD, off = wgid / NXCD; wgid = (xcd < r ? xcd * (q + 1) : r * (q + 1) + (xcd - r) * q) + off; }
        const int nig = WGM * nN, gid = wgid / nig, fm = gid * WGM, gsz = (nM - fm) < WGM ? (nM - fm) : WGM;
        u.pm = fm + ((wgid % nig) % gsz); u.pn = (wgid % nig) / gsz; u.aux = 0; u.n = 0; u.pos0 = 0; u.a_off = (unsigned)u.pm * tA; u.b_off = (unsigned)u.pn * tB; return true;
    }
    __device__ bool next(int i, Unit& u) const { return tile((long)i * G + c, u); }
    __device__ unsigned row_off(const Unit&, int) const { return 0u; }
};

typedef float f32x2_t __attribute__((ext_vector_type(2))); typedef __bf16 bf16x2_t __attribute__((ext_vector_type(2)));
__device__ __forceinline__ unsigned cvt_pk_bf16(float lo, float hi) { f32x2_t v = {lo, hi}; bf16x2_t b = __builtin_convertvector(v, bf16x2_t); return __builtin_bit_cast(unsigned, b); }
__device__ __forceinline__ float bflo_(unsigned w) { return __uint_as_float(w << 16); }
__device__ __forceinline__ float bfhi_(unsigned w) { return __uint_as_float(w & 0xffff0000u); }
__device__ __forceinline__ float sigm(float v) { return __builtin_amdgcn_rcpf(1.0f + __builtin_amdgcn_exp2f(-1.4426950408889634f * v)); }
__device__ __forceinline__ u32x4 pack8(const f32x4 v0, const f32x4 v1) { u32x4 w; w.x = cvt_pk_bf16(v0[0], v0[1]); w.y = cvt_pk_bf16(v0[2], v0[3]); w.z = cvt_pk_bf16(v1[0], v1[1]); w.w = cvt_pk_bf16(v1[2], v1[3]); return w; }


struct EpiIn {
    static constexpr bool PERM = true;
    bf16_t *Q, *K, *V, *U, *GA, *GP; const float *qg, *kg;
    __device__ __forceinline__ void operator()(const f32x4 (&acc)[2][2][4][2], const Unit& u, int wr, int wc, int fr, int fq) const {
        const int row0 = u.pm * BM + wr * 64 + fr, pn = u.pn;
#ifdef EPI_MASK
        if (!((EPI_MASK >> pn) & 1)) return;
#endif
        if (pn < 4) {
            const bool isq = pn < 2; bf16_t* base = (isq ? Q : K) + 256 * (pn & 1) + 64 * wc + 8 * fq; const float* gp = isq ? qg : kg; const float sc = isq ? 0.125f * 1.4426950408889634f : 1.0f;
            f32x4 gv[2][2];
#pragma unroll
            for (int bj = 0; bj < 2; ++bj)
#pragma unroll
                for (int n = 0; n < 2; ++n) gv[bj][n] = *(const f32x4*)(gp + 32 * bj + 8 * fq + 4 * n) * sc;
#pragma unroll
            for (int ai = 0; ai < 2; ++ai)
#pragma unroll
                for (int m = 0; m < 4; ++m) {
                    float ss = 0.f;
#pragma unroll
                    for (int bj = 0; bj < 2; ++bj)
#pragma unroll
                        for (int n = 0; n < 2; ++n) { const f32x4 x = acc[ai][bj][m][n]; ss += (x[0] * x[0] + x[1] * x[1]) + (x[2] * x[2] + x[3] * x[3]); }
                    ss += __shfl_xor(ss, 16); ss += __shfl_xor(ss, 32);
                    const float rstd = __builtin_amdgcn_rsqf(ss * (1.0f / 64.0f) + 1e-6f);
                    bf16_t* rowp = base + (size_t)(row0 + ai * HALF + m * 16) * 512;
#pragma unroll
                    for (int bj = 0; bj < 2; ++bj) *(u32x4*)(rowp + 32 * bj) = pack8(acc[ai][bj][m][0] * rstd * gv[bj][0], acc[ai][bj][m][1] * rstd * gv[bj][1]);
                }
        } else if (pn < 8) {
            bf16_t* base = (pn < 6 ? V : U) + 256 * (pn & 1) + 32 * wc + 8 * fq;
#pragma unroll
            for (int ai = 0; ai < 2; ++ai)
#pragma unroll
                for (int m = 0; m < 4; ++m) { bf16_t* rowp = base + (size_t)(row0 + ai * HALF + m * 16) * 512;
#pragma unroll
                    for (int bj = 0; bj < 2; ++bj) *(u32x4*)(rowp + bj * HALF) = pack8(acc[ai][bj][m][0], acc[ai][bj][m][1]); }
        } else {
            bf16_t* base = (pn < 12 ? GA : GP) + 256 * ((pn - 8) & 3) + 32 * wc + 8 * fq;
#pragma unroll
            for (int ai = 0; ai < 2; ++ai)
#pragma unroll
                for (int m = 0; m < 4; ++m) { bf16_t* rowp = base + (size_t)(row0 + ai * HALF + m * 16) * 1024;
#pragma unroll
                    for (int bj = 0; bj < 2; ++bj) { f32x4 v0 = acc[ai][bj][m][0], v1 = acc[ai][bj][m][1];
#pragma unroll
                        for (int e = 0; e < 4; ++e) { v0[e] = sigm(v0[e]); v1[e] = sigm(v1[e]); }
                        *(u32x4*)(rowp + bj * HALF) = pack8(v0, v1); } }
        }
    }
};
struct EpiBranch {
    static constexpr bool PERM = true;
    bf16_t* MG; const bf16_t *GA, *GP;
    __device__ __forceinline__ void operator()(const f32x4 (&acc)[2][2][4][2], const Unit& u, int wr, int wc, int fr, int fq) const {
        const int row0 = u.pm * BM + wr * 64 + fr; const size_t col0 = (size_t)u.pn * BM + wc * 32 + 8 * fq; const bool second = u.aux != 0; const bf16_t* G = second ? GP : GA;
#pragma unroll
        for (int ai = 0; ai < 2; ++ai)
#pragma unroll
            for (int m = 0; m < 4; ++m) { const size_t ro = (size_t)(row0 + ai * HALF + m * 16) * 1024 + col0;
#pragma unroll
                for (int bj = 0; bj < 2; ++bj) { const u32x4 g = *(const u32x4*)(G + ro + bj * HALF); f32x4 v0 = acc[ai][bj][m][0], v1 = acc[ai][bj][m][1];
                    v0[0] *= bflo_(g.x); v0[1] *= bfhi_(g.x); v0[2] *= bflo_(g.y); v0[3] *= bfhi_(g.y); v1[0] *= bflo_(g.z); v1[1] *= bfhi_(g.z); v1[2] *= bflo_(g.w); v1[3] *= bfhi_(g.w);
                    if (second) { const u32x4 o = *(const u32x4*)(MG + ro + bj * HALF);
                        v0[0] += bflo_(o.x); v0[1] += bfhi_(o.x); v0[2] += bflo_(o.y); v0[3] += bfhi_(o.y); v1[0] += bflo_(o.z); v1[1] += bfhi_(o.z); v1[2] += bflo_(o.w); v1[3] += bfhi_(o.w); }
                    *(u32x4*)(MG + ro + bj * HALF) = pack8(v0, v1); } }
    }
};
struct EpiOut {
    static constexpr bool PERM = false;
    const float* x; const float* mod; float* out;
    __device__ __forceinline__ void operator()(const f32x4 (&acc)[2][2][4][2], const Unit& u, int wr, int wc, int fr, int fq) const {
        const int row0 = u.pm * BM + wr * 64 + fr, col0 = u.pn * BM + wc * 32 + 4 * fq; const float* g1 = mod + (u.pm >> 5) * 6144 + 2048 + col0;
        f32x4 gv[2][2];
#pragma unroll
        for (int bj = 0; bj < 2; ++bj)
#pragma unroll
            for (int n = 0; n < 2; ++n) gv[bj][n] = *(const f32x4*)(g1 + bj * HALF + n * 16);
#pragma unroll
        for (int ai = 0; ai < 2; ++ai)
#pragma unroll
            for (int m = 0; m < 4; ++m) { const size_t off = (size_t)(row0 + ai * HALF + m * 16) * 1024 + col0;
#pragma unroll
                for (int bj = 0; bj < 2; ++bj)
#pragma unroll
                    for (int n = 0; n < 2; ++n) { const f32x4 xv = *(const f32x4*)(x + off + bj * HALF + n * 16); *(f32x4*)(out + off + bj * HALF + n * 16) = xv + gv[bj][n] * acc[ai][bj][m][n]; } }
    }
};
struct EpiMoe1 {
    static constexpr bool PERM = true;
    bf16_t* HID;
    __device__ __forceinline__ void operator()(const f32x4 (&acc)[2][2][4][2], const Unit& u, int wr, int wc, int fr, int fq) const {
        const int row0 = u.pm * BM + wr * 64 + fr; bf16_t* base = HID + 128 * u.pn + 32 * wc + 8 * fq;
#pragma unroll
        for (int ai = 0; ai < 2; ++ai)
#pragma unroll
            for (int m = 0; m < 4; ++m) { f32x4 v0 = acc[ai][0][m][0], v1 = acc[ai][0][m][1]; const f32x4 u0 = acc[ai][1][m][0], u1 = acc[ai][1][m][1];
#pragma unroll
                for (int e = 0; e < 4; ++e) { v0[e] = v0[e] * sigm(v0[e]) * u0[e]; v1[e] = v1[e] * sigm(v1[e]) * u1[e]; }
                *(u32x4*)(base + (size_t)(row0 + ai * HALF + m * 16) * 512) = pack8(v0, v1); }
    }
};
struct EpiMoe2 {
    static constexpr bool PERM = true;
    bf16_t* Y; const unsigned* list;
    __device__ __forceinline__ void operator()(const f32x4 (&acc)[2][2][4][2], const Unit& u, int wr, int wc, int fr, int fq) const {
        const int row0 = u.pm * BM + wr * 64 + fr; bf16_t* base = Y + (size_t)u.pn * BM + 32 * wc + 8 * fq;
#pragma unroll
        for (int ai = 0; ai < 2; ++ai)
#pragma unroll
            for (int m = 0; m < 4; ++m) { int pos = u.pos0 + ai * HALF + wr * 64 + m * 16 + fr; pos = pos < u.n ? pos : u.n - 1;
                const float w = __uint_as_float(list[((size_t)u.aux * 16384 + pos) * 2 + 1]);
                bf16_t* rowp = base + (size_t)(row0 + ai * HALF + m * 16) * 1024;
#pragma unroll
                for (int bj = 0; bj < 2; ++bj) *(u32x4*)(rowp + bj * HALF) = pack8(acc[ai][bj][m][0] * w, acc[ai][bj][m][1] * w); }
    }
};

template <class Epi, class Sched, bool GATHER>
__device__ __forceinline__ void gemm_phase(PG8_LAS unsigned char* lds, const Gemm g, const Sched& S, const Epi& E) {
    const int tid = threadIdx.x, wid = __builtin_amdgcn_readfirstlane(tid >> 6), lane = tid & 63, wr = wid >> 2, wc = wid & 3, fr = lane & 15, fq = lane >> 4;
    const int nt = g.nt;
    unsigned voffA[2], voffB[2]; int RA[2]; unsigned CA[2];
#pragma unroll
    for (int i = 0; i < 2; ++i) { int R, C; stage_rc(tid * 16 + i * 8192, R, C); const int Rb = Epi::PERM ? ((R & ~31) + perm32(R & 31)) : R;
        voffA[i] = (unsigned)(R * g.lda + C) * 2u; voffB[i] = (unsigned)(Rb * g.ldb + C) * 2u; RA[i] = R; CA[i] = (unsigned)C * 2u; }
    const size_t kstep = (size_t)(BK * 2);
    const size_t hstepA = (size_t)HALF * g.lda * 2, hstepB = (size_t)HALF * g.ldb * 2;
    const unsigned ldsw = (unsigned)wid * 1024u;
    const int aoff = lds_byte(wr * 64 + fr, fq * 8), boff = lds_byte(wc * 32 + fr, fq * 8);
#define PG8_SA(b, h) (((b) * 2 + (h)) * HTB)
#define PG8_SB(b, h) ((4 + (b) * 2 + (h)) * HTB)
#define PG8_STAGE2(bufoff, gbase, v0, v1) do { \
        __builtin_amdgcn_global_load_lds((const unsigned*)((const char*)(gbase) + (v0)), (PG8_LAS unsigned*)(lds + (bufoff) + ldsw), 16, 0, 0); \
        __builtin_amdgcn_global_load_lds((const unsigned*)((const char*)(gbase) + (v1)), (PG8_LAS unsigned*)(lds + (bufoff) + ldsw + 8192), 16, 0, 0); } while (0)
#define PG8_STAGEB(bufoff, gbase) PG8_STAGE2(bufoff, gbase, voffB[0], voffB[1])
#define PG8_STAGEA(bufoff, ptrN, ptrG, vg0, vg1) do { if constexpr (GATHER) { PG8_STAGE2(bufoff, ptrG, vg0, vg1); } else { PG8_STAGE2(bufoff, ptrN, voffA[0], voffA[1]); } } while (0)
#define PG8_LDA(dst, b, h) do { _Pragma("unroll") for (int m = 0; m < 4; ++m) _Pragma("unroll") for (int k = 0; k < 2; ++k) dst[m][k] = *(const PG8_LAS bf16x8*)(lds + PG8_SA(b, h) + aoff + m * 2048 + k * 1024); } while (0)
#define PG8_LDB(dst, b, h) do { _Pragma("unroll") for (int n = 0; n < 2; ++n) _Pragma("unroll") for (int k = 0; k < 2; ++k) dst[n][k] = *(const PG8_LAS bf16x8*)(lds + PG8_SB(b, h) + boff + n * 2048 + k * 1024); } while (0)
#define PG8_MMA(ai, bj, At, Bt) do { __builtin_amdgcn_s_setprio(1); _Pragma("unroll") for (int m = 0; m < 4; ++m) _Pragma("unroll") for (int n = 0; n < 2; ++n) _Pragma("unroll") for (int k = 0; k < 2; ++k) \
        acc[ai][bj][m][n] = __builtin_amdgcn_mfma_f32_16x16x32_bf16(Bt[n][k], At[m][k], acc[ai][bj][m][n], 0, 0, 0); __builtin_amdgcn_s_setprio(0); } while (0)
#define PG8_WAIT_V(n) asm volatile("s_waitcnt vmcnt(" #n ")" ::: "memory")
#define PG8_WAIT_L(n) asm volatile("s_waitcnt lgkmcnt(" #n ")" ::: "memory")
#define PG8_BAR __builtin_amdgcn_s_barrier()
#define PG8_SCHED __builtin_amdgcn_sched_barrier(0)
    Unit cur, nxt; int ui = 0;
    if (!S.next(0, cur)) return;
    f32x4 acc[2][2][4][2];
#pragma unroll
    for (int a = 0; a < 2; ++a)
#pragma unroll
        for (int b = 0; b < 2; ++b)
#pragma unroll
            for (int m = 0; m < 4; ++m)
#pragma unroll
                for (int n = 0; n < 2; ++n) acc[a][b][m][n] = (f32x4){0.f, 0.f, 0.f, 0.f};
    bf16x8 At[4][2], B0[2][2], B1[2][2];
    const char* cA = (const char*)g.A + cur.a_off; const char* cB = (const char*)g.Bt + cur.b_off;
    unsigned vc00 = 0, vc01 = 0, vc10 = 0, vc11 = 0, vn00 = 0, vn01 = 0, vn10 = 0, vn11 = 0;
    if constexpr (GATHER) { vc00 = S.row_off(cur, RA[0]) + CA[0]; vc01 = S.row_off(cur, RA[1]) + CA[1]; vc10 = S.row_off(cur, HALF + RA[0]) + CA[0]; vc11 = S.row_off(cur, HALF + RA[1]) + CA[1]; }
    const char* gA = (const char*)g.A;
    PG8_STAGEB(PG8_SB(0, 0), cB); PG8_STAGEB(PG8_SB(0, 1), cB + hstepB); PG8_STAGEA(PG8_SA(0, 0), cA, gA, vc00, vc01); PG8_STAGEA(PG8_SA(0, 1), cA + hstepA, gA, vc10, vc11);
    if (wr == 1) PG8_BAR;
    PG8_WAIT_V(2); PG8_BAR;
    PG8_STAGEB(PG8_SB(1, 0), cB + kstep); PG8_STAGEA(PG8_SA(1, 0), cA + kstep, gA + kstep, vc00, vc01); PG8_STAGEB(PG8_SB(1, 1), cB + hstepB + kstep);
    PG8_WAIT_V(6); PG8_BAR;
    for (;;) {
        const bool has_next = S.next(ui + 1, nxt);
        const char* nA = has_next ? (const char*)g.A + nxt.a_off : cA; const char* nB = has_next ? (const char*)g.Bt + nxt.b_off : cB;
        if constexpr (GATHER) {
            if (has_next) { vn00 = S.row_off(nxt, RA[0]) + CA[0]; vn01 = S.row_off(nxt, RA[1]) + CA[1]; vn10 = S.row_off(nxt, HALF + RA[0]) + CA[0]; vn11 = S.row_off(nxt, HALF + RA[1]) + CA[1]; }
            else { vn00 = vc00; vn01 = vc01; vn10 = vc10; vn11 = vc11; }
        }
        for (int t = 0; t < nt; t += 2) {
            const bool last = (t == nt - 2);
            const char* a1 = cA + (size_t)(t + 1) * kstep;
            const char* a2 = last ? nA : cA + (size_t)(t + 2) * kstep; const char* b2 = last ? nB : cB + (size_t)(t + 2) * kstep;
            const char* a3 = a2 + kstep; const char* b3 = b2 + kstep;
            const char* g1 = gA + (size_t)(t + 1) * kstep; const char* g2 = last ? gA : gA + (size_t)(t + 2) * kstep; const char* g3 = g2 + kstep;
            const unsigned w00 = last ? vn00 : vc00, w01 = last ? vn01 : vc01, w10 = last ? vn10 : vc10, w11 = last ? vn11 : vc11;
            PG8_LDB(B0, 0, 0); PG8_LDB(B1, 0, 1); PG8_SCHED; PG8_LDA(At, 0, 0); PG8_STAGEA(PG8_SA(1, 1), a1 + hstepA, g1, vc10, vc11);
            PG8_WAIT_V(8); PG8_WAIT_L(0); PG8_BAR; PG8_MMA(0, 0, At, B0); PG8_MMA(0, 1, At, B1); PG8_BAR; PG8_SCHED;
            PG8_LDA(At, 0, 1); PG8_STAGEB(PG8_SB(0, 0), b2); PG8_STAGEB(PG8_SB(0, 1), b2 + hstepB); PG8_STAGEA(PG8_SA(0, 0), a2, g2, w00, w01);
            PG8_WAIT_V(8); PG8_WAIT_L(0); PG8_BAR; PG8_MMA(1, 0, At, B0); PG8_MMA(1, 1, At, B1); PG8_BAR; PG8_SCHED;
            PG8_LDB(B0, 1, 0); PG8_LDB(B1, 1, 1); PG8_SCHED; PG8_LDA(At, 1, 0); PG8_STAGEA(PG8_SA(0, 1), a2 + hstepA, g2, w10, w11);
            PG8_WAIT_V(8); PG8_WAIT_L(0); PG8_BAR; PG8_MMA(0, 0, At, B0); PG8_MMA(0, 1, At, B1); PG8_BAR; PG8_SCHED;
            PG8_LDA(At, 1, 1); PG8_STAGEB(PG8_SB(1, 0), b3); PG8_STAGEB(PG8_SB(1, 1), b3 + hstepB); PG8_STAGEA(PG8_SA(1, 0), a3, g3, w00, w01);
            PG8_WAIT_V(8); PG8_WAIT_L(0); PG8_BAR; PG8_MMA(1, 0, At, B0); PG8_MMA(1, 1, At, B1); PG8_BAR; PG8_SCHED;
        }
        if (wr == 0) PG8_BAR;
        PG8_WAIT_V(0);
        E(acc, cur, wr, wc, fr, fq);
        if (!has_next) break;
#pragma unroll
        for (int a = 0; a < 2; ++a)
#pragma unroll
            for (int b = 0; b < 2; ++b)
#pragma unroll
                for (int m = 0; m < 4; ++m)
#pragma unroll
                    for (int n = 0; n < 2; ++n) acc[a][b][m][n] = (f32x4){0.f, 0.f, 0.f, 0.f};
        cur = nxt; cA = nA; cB = nB; ++ui;
        if constexpr (GATHER) { vc00 = vn00; vc01 = vn01; vc10 = vn10; vc11 = vn11; }
        if (wr == 1) PG8_BAR;
    }
    PG8_WAIT_V(0);
    PG8_BAR;
#undef PG8_SA
#undef PG8_SB
#undef PG8_STAGE2
#undef PG8_STAGEB
#undef PG8_STAGEA
#undef PG8_LDA
#undef PG8_LDB
#undef PG8_MMA
#undef PG8_WAIT_V
#undef PG8_WAIT_L
#undef PG8_BAR
#undef PG8_SCHED
}
}

__device__ __forceinline__ void transpose_item(const float* W, int N, bf16* dst, int dpitch, int drow0, int dk0, float* scr, int k0, int n0, int lane) {
#pragma unroll 8
    for (int i = 0; i < 32; ++i) { const int kk = 2 * i + (lane >> 5); scr[kk * 33 + (lane & 31)] = W[(size_t)(k0 + kk) * N + n0 + (lane & 31)]; }
    __builtin_amdgcn_s_waitcnt(0xC07F); asm volatile("" ::: "memory");
    const int c = lane & 7;
#pragma unroll
    for (int j = 0; j < 4; ++j) { const int n = (lane >> 3) + 8 * j; const float* s = scr + (8 * c) * 33 + n;
        v4u o; o.x = pk2(s[0 * 33], s[1 * 33]); o.y = pk2(s[2 * 33], s[3 * 33]); o.z = pk2(s[4 * 33], s[5 * 33]); o.w = pk2(s[6 * 33], s[7 * 33]);
        *(v4u*)(dst + (size_t)(drow0 + n) * dpitch + dk0 + k0 + 8 * c) = o; }
    __builtin_amdgcn_s_waitcnt(0xC07F); asm volatile("" ::: "memory");
}
__device__ __forceinline__ int win_rowmap(int n0) {
    if (n0 >= 1024) return n0;
    const int t = n0 >> 8, rem = n0 & 255, wc = rem >> 6, bj = (rem & 63) >> 5;
    return 256 * t + 128 * bj + 32 * wc;
}
__device__ __forceinline__ int win_colmap_inv(int np) {
    if (np >= 1024) return np;
    const int t = np >> 8, rem = np & 255, bj = rem >> 7, wc = (rem & 127) >> 5, j = rem & 31;
    return 256 * t + 64 * wc + 32 * bj + j;
}
__device__ __forceinline__ void ph_prologue(const P& p, unsigned char* ldsb, int bid, int nb) {
    const int tid = threadIdx.x, lane = tid & 63, wave = tid >> 6;
    float* scr = (float*)(ldsb + wave * 16384);
    const int gw = bid * NWAVES + wave, NGW = nb * NWAVES;
    constexpr int I_IN = 16 * 128, I_BA = 8 * 32, I_BP = 8 * 32, I_OUT = 16 * 32, I_G = 16 * 256, I_U = 16 * 256, I_D = 16 * 256, I_MOD = 96 * MOD_SPLITS;
    constexpr int NITEMS = I_MOD + I_IN + I_BA + I_BP + I_OUT + I_G + I_U + I_D;
    for (int it = gw; it < NITEMS; it += NGW) {
        int r = it;
        if (r < I_MOD) {
            const int ch = r % 96, sp = r / 96, j = ch * 64 + lane;
            float a0 = 0.f, a1 = 0.f;
#pragma unroll 1
            for (int kc = 0; kc < 2; ++kc) { const int k0 = sp * 128 + kc * 64;
                const float s0 = siluf_(p.c[k0 + lane]), s1 = siluf_(p.c[DM + k0 + lane]);
#pragma unroll 8
                for (int kk = 0; kk < 64; ++kk) { const float w = p.ada_w[(size_t)(k0 + kk) * 6144 + j]; a0 += __shfl(s0, kk) * w; a1 += __shfl(s1, kk) * w; } }
            p.miscf[MF_MODP + (sp * 2 + 0) * 6144 + j] = a0; p.miscf[MF_MODP + (sp * 2 + 1) * 6144 + j] = a1;
            continue;
        }
        r -= I_MOD;
        if (r < I_IN) { const int kb = r / 128, nbk = r % 128; transpose_item(p.w_in, DIN, p.WIN, DM, win_rowmap(nbk * 32), 0, scr, kb * 64, nbk * 32, lane); continue; } r -= I_IN;
        if (r < I_BA) { const int kb = r / 32, nbk = r % 32; transpose_item(p.wba, DM, p.WBR, DM, nbk * 32, 0, scr, kb * 64, nbk * 32, lane); continue; } r -= I_BA;
        if (r < I_BP) { const int kb = r / 32, nbk = r % 32; transpose_item(p.wbp, DM, p.WBR, DM, nbk * 32, 512, scr, kb * 64, nbk * 32, lane); continue; } r -= I_BP;
        if (r < I_OUT) { const int kb = r / 32, nbk = r % 32; transpose_item(p.w_out, DM, p.WOUT, DM, nbk * 32, 0, scr, kb * 64, nbk * 32, lane); continue; } r -= I_OUT;
        if (r < I_G) { const int e = r / 256, q = r % 256, kb = q / 16, nbk = q % 16, n0 = nbk * 32;
            transpose_item(p.wgate + (size_t)e * DM * DEXP, DEXP, p.W1 + (size_t)e * 1024 * 1024, DM, 256 * (n0 >> 7) + (n0 & 127), 0, scr, kb * 64, n0, lane); continue; } r -= I_G;
        if (r < I_U) { const int e = r / 256, q = r % 256, kb = q / 16, nbk = q % 16, n0 = nbk * 32;
            transpose_item(p.wup + (size_t)e * DM * DEXP, DEXP, p.W1 + (size_t)e * 1024 * 1024, DM, 256 * (n0 >> 7) + 128 + (n0 & 127), 0, scr, kb * 64, n0, lane); continue; } r -= I_U;
        { const int e = r / 256, q = r % 256, kb = q / 32, nbk = q % 32;
            transpose_item(p.wdown + (size_t)e * DEXP * DM, DM, p.W2 + (size_t)e * 1024 * 512, DEXP, nbk * 32, 0, scr, kb * 64, nbk * 32, lane); }
    }
    if (bid == 0 && wave == 0) {
        float a = p.lq1[lane] * p.lk1[lane], b2 = p.lq2[lane] * p.lk2[lane];
        a = wave_sum(a); b2 = wave_sum(b2);
        const float lam = __expf(a) - __expf(b2) + LAMBDA_INIT;
        const float gq = wave_max(fabsf(p.q_norm_g[lane])), gk = wave_max(fabsf(p.k_norm_g[lane]));
        if (lane == 0) p.miscf[MF_LAM] = lam;
        for (int h = 0; h < NHEAD; ++h) {
            float bm = lane < 32 ? fabsf(p.rel_bias[lane * 4 + h]) : 0.f; bm = wave_max(bm);
            const float shift = 8.0f * gq * gk + bm;
            for (int i = lane; i < 384; i += 64) { const int rel = i - 256; p.miscf[MF_BIAS + h * 384 + i] = (p.rel_bias[t5_bucket(rel) * 4 + h] - shift) * LOG2E; }
        }
    }
}

__device__ __forceinline__ float mod_sum(const P& p, int b, int j) {
    float s = p.ada_b[j];
#pragma unroll
    for (int sp = 0; sp < MOD_SPLITS; ++sp) s += p.miscf[MF_MODP + (sp * 2 + b) * 6144 + j];
    return s;
}
__device__ __forceinline__ void ph_norm1(const P& p, unsigned char* ldsb, int bid, int nb) {
    const int tid = threadIdx.x, lane = tid & 63, wave = tid >> 6;
    float* la = (float*)ldsb; float* ls = la + 1024;
    for (int rb = bid; rb < 256; rb += nb) {
        const int b = rb / 128;
        __syncthreads();
        for (int c = tid; c < 1024; c += NTHR) { la[c] = p.norm1_g[c] * (1.0f + mod_sum(p, b, 1024 + c)); ls[c] = mod_sum(p, b, c); }
        if (tid < 48) { const int j = rb * 48 + tid; p.miscf[MF_MOD + j] = mod_sum(p, j / 6144, j % 6144); }
        __syncthreads();
        for (int i = 0; i < 8; ++i) {
            const int row = rb * 64 + wave * 8 + i;
            const f32x4* xr = (const f32x4*)(p.x + (size_t)row * DM) + lane;
            f32x4 v[4]; float ss = 0.f;
#pragma unroll
            for (int j = 0; j < 4; ++j) { v[j] = xr[64 * j]; ss += v[j].x * v[j].x + v[j].y * v[j].y + v[j].z * v[j].z + v[j].w * v[j].w; }
            const float rstd = rsqrtf(wave_sum(ss) * (1.0f / DM) + RMS_EPS);
            v2u* o = (v2u*)(p.XN + (size_t)row * DM) + lane;
#pragma unroll
            for (int j = 0; j < 4; ++j) { const int c = (64 * j + lane) * 4; const f32x4 a = *(const f32x4*)(la + c), s = *(const f32x4*)(ls + c);
                v2u w; w.x = pk2(v[j].x * rstd * a.x + s.x, v[j].y * rstd * a.y + s.y); w.y = pk2(v[j].z * rstd * a.z + s.z, v[j].w * rstd * a.w + s.w); o[64 * j] = w; }
        }
    }
}

template <class Epi>
__device__ __forceinline__ void gemm_nt_naive(const bf16* A, int lda, const bf16* Bt, int ldb, int M, int N, int K, const Epi& epi, unsigned char* ldsb, int bid, int nb) {
    float* As = (float*)ldsb;
    float* Bs = As + 32 * 68;
    const int tid = threadIdx.x, tm = tid >> 5, tn = tid & 31;
    const int ntn = N / 128, nt = (M / 64) * ntn;
    for (int t = bid; t < nt; t += nb) {
        const int m0 = (t / ntn) * 64, n0 = (t % ntn) * 128;
        float acc[4][4];
#pragma unroll
        for (int i = 0; i < 4; ++i)
#pragma unroll
            for (int j = 0; j < 4; ++j) acc[i][j] = 0.f;
        for (int k0 = 0; k0 < K; k0 += 32) {
            __syncthreads();
            { const int r = tid >> 3, kq = (tid & 7) * 4; const v2u v = *(const v2u*)(A + (size_t)(m0 + r) * lda + k0 + kq);
              As[(kq + 0) * 68 + r] = bflo(v.x); As[(kq + 1) * 68 + r] = bfhi(v.x); As[(kq + 2) * 68 + r] = bflo(v.y); As[(kq + 3) * 68 + r] = bfhi(v.y); }
            { const int r = tid >> 2, kq = (tid & 3) * 8; const v4u v = *(const v4u*)(Bt + (size_t)(n0 + r) * ldb + k0 + kq);
              Bs[(kq + 0) * 132 + r] = bflo(v.x); Bs[(kq + 1) * 132 + r] = bfhi(v.x); Bs[(kq + 2) * 132 + r] = bflo(v.y); Bs[(kq + 3) * 132 + r] = bfhi(v.y);
              Bs[(kq + 4) * 132 + r] = bflo(v.z); Bs[(kq + 5) * 132 + r] = bfhi(v.z); Bs[(kq + 6) * 132 + r] = bflo(v.w); Bs[(kq + 7) * 132 + r] = bfhi(v.w); }
            __syncthreads();
#pragma unroll 8
            for (int k = 0; k < 32; ++k) {
                const f32x4 a = *(const f32x4*)(As + k * 68 + tm * 4), b = *(const f32x4*)(Bs + k * 132 + tn * 4);
#pragma unroll
                for (int i = 0; i < 4; ++i)
#pragma unroll
                    for (int j = 0; j < 4; ++j) acc[i][j] += a[i] * b[j];
            }
        }
#pragma unroll
        for (int i = 0; i < 4; ++i)
#pragma unroll
            for (int j = 0; j < 4; ++j) epi(m0 + tm * 4 + i, n0 + tn * 4 + j, acc[i][j]);
    }
}

struct EpiInNaive {
    float* qkraw; bf16 *V, *U, *GA, *GP;
    __device__ __forceinline__ void operator()(int r, int np, float v) const {
        const int c = win_colmap_inv(np);
        if (c < 1024) qkraw[(size_t)r * 1024 + c] = v;
        else if (c < 1536) V[(size_t)r * 512 + c - 1024] = (bf16)f2bf(v);
        else if (c < 2048) U[(size_t)r * 512 + c - 1536] = (bf16)f2bf(v);
        else if (c < 3072) GA[(size_t)r * 1024 + c - 2048] = (bf16)f2bf(sigmoidf_(v));
        else GP[(size_t)r * 1024 + c - 3072] = (bf16)f2bf(sigmoidf_(v));
    }
};
__device__ __forceinline__ void ph_inproj_naive(const P& p, unsigned char* ldsb, int bid, int nb) {
    EpiInNaive e{p.out, p.V, p.U, p.GA, p.GP};
    gemm_nt_naive(p.XN, DM, p.WIN, DM, MTOK, DIN, DM, e, ldsb, bid, nb);
}
__device__ __forceinline__ void ph_qknorm_naive(const P& p, int bid, int nb) {
    const int tid = threadIdx.x, lane = tid & 63, wave = tid >> 6;
    for (int row = bid * NWAVES + wave; row < MTOK; row += nb * NWAVES) {
        const float* src = p.out + (size_t)row * 1024 + lane * 16;
        float v[16]; float ss = 0.f;
#pragma unroll
        for (int i = 0; i < 16; ++i) { v[i] = src[i]; ss += v[i] * v[i]; }
        ss += __shfl_xor(ss, 1); ss += __shfl_xor(ss, 2);
        const float rstd = rsqrtf(ss * (1.0f / 64.0f) + RMS_EPS);
        const bool isq = lane < 32; const int d0 = (lane & 3) * 16;
        bf16* dst = (isq ? p.Q : p.K) + (size_t)row * 512 + (lane & 31) * 16;
#pragma unroll
        for (int i = 0; i < 16; ++i) { const float g = isq ? p.q_norm_g[d0 + i] * (0.125f * LOG2E) : p.k_norm_g[d0 + i]; dst[i] = (bf16)f2bf(v[i] * rstd * g); }
    }
}

__device__ __forceinline__ float block_max(float v, float* red, int tid) {
    v = wave_max(v); __syncthreads(); if ((tid & 63) == 0) red[tid >> 6] = v; __syncthreads();
    float r = red[0];
#pragma unroll
    for (int i = 1; i < 8; ++i) r = fmaxf(r, red[i]);
    return r;
}
__device__ __forceinline__ float block_sum(float v, float* red, int tid) {
    v = wave_sum(v); __syncthreads(); if ((tid & 63) == 0) red[tid >> 6] = v; __syncthreads();
    float r = 0.f;
#pragma unroll
    for (int i = 0; i < 8; ++i) r += red[i];
    return r;
}
__device__ __forceinline__ void ph_attn_naive(const P& p, unsigned char* ldsb, int bid, int nb) {
    float* sc1 = (float*)ldsb; float* sc2 = sc1 + 8192; float* qs = sc2 + 8192; float* red = qs + 128; float* po = red + 32;
    const int tid = threadIdx.x;
    const float lam = p.miscf[MF_LAM];
    for (int item = bid; item < NB * NHEAD * SEQ; item += nb) {
        const int q = item % SEQ, bh = item / SEQ, h = bh % NHEAD, b = bh / NHEAD;
        const int nk = 64 * (q / 64 + 1);
        const size_t rowq = (size_t)b * SEQ + q;
        __syncthreads();
        if (tid < 128) qs[tid] = bf2f(p.Q[rowq * 512 + h * 128 + tid]);
        __syncthreads();
        float mx1 = -INFINITY, mx2 = -INFINITY;
        for (int j = tid; j < nk; j += NTHR) {
            const bf16* kr = p.K + ((size_t)b * SEQ + j) * 512 + h * 128;
            float s1 = 0.f, s2 = 0.f;
#pragma unroll
            for (int d = 0; d < 64; d += 8) {
                const v4u a = *(const v4u*)(kr + d), c = *(const v4u*)(kr + 64 + d);
                s1 += qs[d] * bflo(a.x) + qs[d + 1] * bfhi(a.x) + qs[d + 2] * bflo(a.y) + qs[d + 3] * bfhi(a.y) + qs[d + 4] * bflo(a.z) + qs[d + 5] * bfhi(a.z) + qs[d + 6] * bflo(a.w) + qs[d + 7] * bfhi(a.w);
                s2 += qs[64 + d] * bflo(c.x) + qs[65 + d] * bfhi(c.x) + qs[66 + d] * bflo(c.y) + qs[67 + d] * bfhi(c.y) + qs[68 + d] * bflo(c.z) + qs[69 + d] * bfhi(c.z) + qs[70 + d] * bflo(c.w) + qs[71 + d] * bfhi(c.w);
            }
            int rel = j - q; if (rel < -256) rel = -256;
            const float bv = p.miscf[MF_BIAS + h * 384 + rel + 256];
            s1 += bv; s2 += bv; sc1[j] = s1; sc2[j] = s2; mx1 = fmaxf(mx1, s1); mx2 = fmaxf(mx2, s2);
        }
        mx1 = block_max(mx1, red, tid); mx2 = block_max(mx2, red, tid);
        float l1 = 0.f, l2 = 0.f;
        for (int j = tid; j < nk; j += NTHR) { const float p1 = exp2f(sc1[j] - mx1), p2 = exp2f(sc2[j] - mx2); sc1[j] = p1; sc2[j] = p2; l1 += p1; l2 += p2; }
        l1 = block_sum(l1, red, tid); l2 = block_sum(l2, red, tid);
        const float i1 = 1.0f / l1, i2 = lam / l2;
        const int d = tid & 127, kq = tid >> 7;
        float o = 0.f;
        const bf16* vb = p.V + (size_t)b * SEQ * 512 + h * 128 + d;
        for (int j = kq; j < nk; j += 4) o += (sc1[j] * i1 - sc2[j] * i2) * bf2f(vb[(size_t)j * 512]);
        po[kq * 128 + d] = o;
        __syncthreads();
        float ov = 0.f, ss = 0.f;
        if (tid < 128) { ov = po[tid] + po[128 + tid] + po[256 + tid] + po[384 + tid]; ss = ov * ov; }
        ss = block_sum(ss, red, tid);
        if (tid < 128) { const float r = rsqrtf(ss * (1.0f / 128.0f) + RMS_EPS); p.AB[rowq * 1024 + h * 128 + tid] = (bf16)f2bf(ov * r * p.subln_g[tid] * (1.0f - LAMBDA_INIT)); }
    }
}
__device__ __forceinline__ void ph_pool_naive(const P& p, unsigned char* ldsb, int bid, int nb) {
    float* mt = (float*)ldsb;
    const int tid = threadIdx.x, i = tid >> 5, c4 = (tid & 31) * 4;
    for (int item = bid; item < (MTOK / 16) * 4; item += nb) {
        const int rb = item >> 2, g = item & 3, w = 2 << g;
        const int r = rb * 16 + i, t = r % SEQ;
        __syncthreads();
#pragma unroll
        for (int cc = 0; cc < 4; ++cc) { const int c = c4 + cc; float s = 0.f;
            for (int jj = 0; jj < w; ++jj) if (t - jj >= 0) s += bf2f(p.U[(size_t)(r - jj) * 512 + g * 128 + c]);
            const float cnt = (float)(t + 1 < w ? t + 1 : w);
            mt[i * 128 + c] = s / cnt - bf2f(p.U[(size_t)r * 512 + g * 128 + c]); }
        __syncthreads();
#pragma unroll
        for (int dd = 0; dd < 4; ++dd) { const int d = c4 + dd; float a = 0.f;
            for (int c = 0; c < 128; ++c) a += mt[i * 128 + c] * p.pool_w[(size_t)(g * 128 + c) * 128 + d];
            p.AB[(size_t)r * 1024 + 512 + g * 128 + d] = (bf16)f2bf(a * p.pool_scale[g * 128 + d]); }
    }
}

struct EpiBrA { bf16* MG; const bf16* GA; __device__ __forceinline__ void operator()(int r, int c, float v) const { MG[(size_t)r * 1024 + c] = (bf16)f2bf(bf2f(GA[(size_t)r * 1024 + c]) * v); } };
struct EpiBrB { bf16* MG; const bf16* GP; __device__ __forceinline__ void operator()(int r, int c, float v) const { MG[(size_t)r * 1024 + c] = (bf16)f2bf(bf2f(MG[(size_t)r * 1024 + c]) + bf2f(GP[(size_t)r * 1024 + c]) * v); } };
__device__ __forceinline__ void ph_branch_naive(const P& p, unsigned char* ldsb, int bid, int nb) {
    EpiBrA ea{p.XN, p.GA}; gemm_nt_naive(p.AB, 1024, p.WBR, 1024, MTOK, DM, 512, ea, ldsb, bid, nb);
    __syncthreads();
    EpiBrB eb{p.XN, p.GP}; gemm_nt_naive(p.AB + 512, 1024, p.WBR + 512, 1024, MTOK, DM, 512, eb, ldsb, bid, nb);
}
struct EpiOutNaive { const float* x; const float* mod; float* out; __device__ __forceinline__ void operator()(int r, int c, float v) const {
    const int b = r / SEQ; out[(size_t)r * 1024 + c] = x[(size_t)r * 1024 + c] + mod[b * 6144 + 2048 + c] * v; } };
__device__ __forceinline__ void ph_wout_naive(const P& p, unsigned char* ldsb, int bid, int nb) {
    EpiOutNaive e{p.x, p.miscf + MF_MOD, p.out}; gemm_nt_naive(p.XN, 1024, p.WOUT, 1024, MTOK, DM, DM, e, ldsb, bid, nb);
}

__device__ __forceinline__ void ph_norm2_route(const P& p, unsigned char* ldsb, int bid, int nb) {
    const int tid = threadIdx.x, lane = tid & 63, wave = tid >> 6;
    float* la = (float*)ldsb; float* ls = la + 1024; float* wr = ls + 1024;
    for (int i = tid; i < 1024 * 20; i += NTHR) { const int o = i / 1024, c = i % 1024; wr[i] = o < 4 ? p.rgw[c * 4 + o] : p.rew[c * 16 + o - 4]; }
    for (int rb = bid; rb < 256; rb += nb) {
        const int b = rb / 128;
        __syncthreads();
        for (int c = tid; c < 1024; c += NTHR) { la[c] = p.norm2_g[c] * (1.0f + p.miscf[MF_MOD + b * 6144 + 4096 + c]); ls[c] = p.miscf[MF_MOD + b * 6144 + 3072 + c]; }
        __syncthreads();
#pragma unroll 1
        for (int i = 0; i < 8; ++i) {
            const int row = rb * 64 + wave * 8 + i;
            const f32x4* xr = (const f32x4*)(p.out + (size_t)row * DM) + lane;
            f32x4 v[4]; float ss = 0.f;
#pragma unroll
            for (int j = 0; j < 4; ++j) { v[j] = xr[64 * j]; ss += v[j].x * v[j].x + v[j].y * v[j].y + v[j].z * v[j].z + v[j].w * v[j].w; }
            const float rstd = rsqrtf(wave_sum(ss) * (1.0f / DM) + RMS_EPS);
            v2u* o = (v2u*)(p.XN + (size_t)row * DM) + lane;
#pragma unroll
            for (int j = 0; j < 4; ++j) { const int c = (64 * j + lane) * 4; const f32x4 a = *(const f32x4*)(la + c), s = *(const f32x4*)(ls + c);
                f32x4 hh; hh.x = v[j].x * rstd * a.x + s.x; hh.y = v[j].y * rstd * a.y + s.y; hh.z = v[j].z * rstd * a.z + s.z; hh.w = v[j].w * rstd * a.w + s.w;
                v2u w; w.x = pk2(hh.x, hh.y); w.y = pk2(hh.z, hh.w); o[64 * j] = w; v[j] = hh; }
            float mylg = 0.f;
#pragma unroll 1
            for (int oo = 0; oo < 20; ++oo) { float s = 0.f;
#pragma unroll
                for (int j = 0; j < 4; ++j) { const f32x4 w = *(const f32x4*)(wr + oo * 1024 + (64 * j + lane) * 4); s += v[j].x * w.x + v[j].y * w.y + v[j].z * w.z + v[j].w * w.w; }
                s = wave_sum(s); mylg = (lane == oo) ? s : mylg; }
            float lg[20];
#pragma unroll
            for (int k = 0; k < 20; ++k) lg[k] = __shfl(mylg, k);
            if (lane == 0) {
                const float g0 = lg[0] + p.rgb[0], g1 = lg[1] + p.rgb[1], g2 = lg[2] + p.rgb[2], g3 = lg[3] + p.rgb[3];
                int gi = 0; float gm = g0;
                if (g1 > gm) { gm = g1; gi = 1; } if (g2 > gm) { gm = g2; gi = 2; } if (g3 > gm) { gm = g3; gi = 3; }
                const float gval = 1.0f / (__expf(g0 - gm) + __expf(g1 - gm) + __expf(g2 - gm) + __expf(g3 - gm));
                float el[4];
#pragma unroll
                for (int k = 0; k < 4; ++k) { float t = 0.f;
#pragma unroll
                    for (int gg = 0; gg < 4; ++gg) t = (gg == gi) ? lg[4 + gg * 4 + k] + p.reb[gg * 4 + k] : t;
                    el[k] = t; }
                int i0 = 0; float m0 = el[0];
#pragma unroll
                for (int k = 1; k < 4; ++k) if (el[k] > m0) { m0 = el[k]; i0 = k; }
                int i1 = 0; float m1 = -INFINITY;
#pragma unroll
                for (int k = 0; k < 4; ++k) if (k != i0 && el[k] > m1) { m1 = el[k]; i1 = k; }
                const float e1 = __expf(m1 - m0);
                const float w0 = gval / (1.0f + e1), w1 = gval * e1 / (1.0f + e1);
                const int x0 = gi * 4 + i0, x1 = gi * 4 + i1;
                const unsigned p0 = atomicAdd(p.ctl + CW_CNT + x0, 1u), p1 = atomicAdd(p.ctl + CW_CNT + x1, 1u);
                { uint2 l0; l0.x = (unsigned)row; l0.y = __float_as_uint(w0); *(uint2*)(p.list + ((size_t)x0 * MTOK + p0) * 2) = l0; uint2 l1; l1.x = (unsigned)row; l1.y = __float_as_uint(w1); *(uint2*)(p.list + ((size_t)x1 * MTOK + p1) * 2) = l1; }
                int4 ri; ri.x = x0 | (x1 << 8); ri.y = (int)(p0 | (p1 << 16)); ri.z = __float_as_int(w0); ri.w = __float_as_int(w1); *(int4*)(p.route + (size_t)row * 4) = ri;
            }
        }
    }
}

__device__ __forceinline__ void moe_offsets(const P& p, int* arr) {
    __syncthreads();
    if (threadIdx.x == 0) { int o = 0;
        for (int e = 0; e < NEXP; ++e) { const int n = (int)__hip_atomic_load(p.ctl + CW_CNT + e, __ATOMIC_RELAXED, __HIP_MEMORY_SCOPE_AGENT); arr[e] = n; arr[16 + e] = o; arr[33 + e] = o >> 8; o += (n + 255) & ~255; }
        arr[32] = o; arr[33 + 16] = o >> 8; }
    __syncthreads();
}
__device__ __forceinline__ void ph_moe1_naive(const P& p, unsigned char* ldsb, int bid, int nb) {
    float* hs = (float*)ldsb;
    const int tid = threadIdx.x;
    int* cnt = (int*)(ldsb + 65536); int* off = cnt + 16; moe_offsets(p, cnt);
#pragma unroll 1
    for (int e = 0; e < NEXP; ++e) {
        const int n = cnt[e];
#pragma unroll 1
        for (int pb = bid; pb * 8 < n; pb += nb) {
            __syncthreads();
            for (int idx = tid; idx < 8 * 128; idx += NTHR) { const int s = idx >> 7, ch = idx & 127, pos = pb * 8 + s;
                if (pos < n) { const unsigned tok = p.list[((size_t)e * MTOK + pos) * 2]; const v4u v = *(const v4u*)(p.XN + (size_t)tok * 1024 + ch * 8);
                    float* d = hs + s * 1024 + ch * 8; d[0] = bflo(v.x); d[1] = bfhi(v.x); d[2] = bflo(v.y); d[3] = bfhi(v.y); d[4] = bflo(v.z); d[5] = bfhi(v.z); d[6] = bflo(v.w); d[7] = bfhi(v.w); }
                else { float* d = hs + s * 1024 + ch * 8;
#pragma unroll
                    for (int q = 0; q < 8; ++q) d[q] = 0.f; } }
            __syncthreads();
            const int j = tid;
            const bf16* gr = p.W1 + (size_t)e * 1024 * 1024 + (size_t)(256 * (j >> 7) + (j & 127)) * 1024; const bf16* ur = gr + 128 * 1024;
            float ag[8], au[8];
#pragma unroll
            for (int s = 0; s < 8; ++s) { ag[s] = 0.f; au[s] = 0.f; }
            for (int k = 0; k < 1024; k += 8) {
                const v4u g = *(const v4u*)(gr + k), u = *(const v4u*)(ur + k);
                const float gf[8] = {bflo(g.x), bfhi(g.x), bflo(g.y), bfhi(g.y), bflo(g.z), bfhi(g.z), bflo(g.w), bfhi(g.w)};
                const float uf[8] = {bflo(u.x), bfhi(u.x), bflo(u.y), bfhi(u.y), bflo(u.z), bfhi(u.z), bflo(u.w), bfhi(u.w)};
#pragma unroll
                for (int s = 0; s < 8; ++s) {
#pragma unroll
                    for (int q = 0; q < 8; ++q) { const float hv = hs[s * 1024 + k + q]; ag[s] += hv * gf[q]; au[s] += hv * uf[q]; } }
            }
#pragma unroll
            for (int s = 0; s < 8; ++s) { const int pos = pb * 8 + s; if (pos < n) p.HID[(size_t)(off[e] + pos) * 512 + j] = (bf16)f2bf(siluf_(ag[s]) * au[s]); }
        }
    }
}
__device__ __forceinline__ void ph_moe2_naive(const P& p, unsigned char* ldsb, int bid, int nb) {
    float* hs = (float*)ldsb;
    const int tid = threadIdx.x;
    int* cnt = (int*)(ldsb + 65536); int* off = cnt + 16; moe_offsets(p, cnt);
#pragma unroll 1
    for (int e = 0; e < NEXP; ++e) {
        const int n = cnt[e];
#pragma unroll 1
        for (int pb = bid; pb * 8 < n; pb += nb) {
            __syncthreads();
            { const int s = tid >> 6, ch = tid & 63, pos = pb * 8 + s; float* d = hs + s * 512 + ch * 8;
                if (pos < n) { const v4u v = *(const v4u*)(p.HID + (size_t)(off[e] + pos) * 512 + ch * 8);
                    d[0] = bflo(v.x); d[1] = bfhi(v.x); d[2] = bflo(v.y); d[3] = bfhi(v.y); d[4] = bflo(v.z); d[5] = bfhi(v.z); d[6] = bflo(v.w); d[7] = bfhi(v.w); }
                else {
#pragma unroll
                    for (int q = 0; q < 8; ++q) d[q] = 0.f; } }
            __syncthreads();
#pragma unroll 1
            for (int half = 0; half < 2; ++half) {
                const int nn = tid + half * 512;
                const bf16* wr = p.W2 + (size_t)e * 1024 * 512 + (size_t)nn * 512;
                float a[8];
#pragma unroll
                for (int s = 0; s < 8; ++s) a[s] = 0.f;
                for (int k = 0; k < 512; k += 8) {
                    const v4u g = *(const v4u*)(wr + k);
                    const float gf[8] = {bflo(g.x), bfhi(g.x), bflo(g.y), bfhi(g.y), bflo(g.z), bfhi(g.z), bflo(g.w), bfhi(g.w)};
#pragma unroll
                    for (int s = 0; s < 8; ++s) {
#pragma unroll
                        for (int q = 0; q < 8; ++q) a[s] += hs[s * 512 + k + q] * gf[q]; }
                }
#pragma unroll
                for (int s = 0; s < 8; ++s) { const int pos = pb * 8 + s; if (pos < n) { const float w = __uint_as_float(p.list[((size_t)e * MTOK + pos) * 2 + 1]);
                    p.Y[(size_t)(off[e] + pos) * 1024 + nn] = (bf16)f2bf(a[s] * w); } }
            }
        }
    }
}
__device__ __forceinline__ void ph_combine(const P& p, unsigned char* ldsb, int bid, int nb) {
    const int tid = threadIdx.x, lane = tid & 63, wave = tid >> 6;
    int* cnt = (int*)ldsb; int* off = cnt + 16; moe_offsets(p, cnt);
    for (int row = bid * NWAVES + wave; row < MTOK; row += nb * NWAVES) {
        const int4 ri = *(const int4*)(p.route + (size_t)row * 4);
        const size_t s0 = (size_t)(off[ri.x & 0xff] + (ri.y & 0xffff)), s1 = (size_t)(off[(ri.x >> 8) & 0xff] + ((ri.y >> 16) & 0xffff));
        const int b = row / SEQ;
        const float* g2 = p.miscf + MF_MOD + b * 6144 + 5120;
        f32x4* xo = (f32x4*)(p.out + (size_t)row * DM) + lane;
        const v2u* y0 = (const v2u*)(p.Y + s0 * 1024) + lane; const v2u* y1 = (const v2u*)(p.Y + s1 * 1024) + lane;
#pragma unroll
        for (int j = 0; j < 4; ++j) { const int c = (64 * j + lane) * 4; const f32x4 g = *(const f32x4*)(g2 + c); f32x4 v = xo[64 * j]; const v2u a = y0[64 * j], d = y1[64 * j];
            v.x += g.x * (bflo(a.x) + bflo(d.x)); v.y += g.y * (bfhi(a.x) + bfhi(d.x)); v.z += g.z * (bflo(a.y) + bflo(d.y)); v.w += g.w * (bfhi(a.y) + bfhi(d.y)); xo[64 * j] = v; }
    }
}


namespace att {
typedef short bf16x8 __attribute__((ext_vector_type(8)));
typedef short s16x4 __attribute__((ext_vector_type(4)));
typedef float f32x16 __attribute__((ext_vector_type(16)));
typedef unsigned u32x4 __attribute__((ext_vector_type(4)));
constexpr int NSLOT = 3, SLOTB = 16384;
constexpr int LDS_K = 0, LDS_V = NSLOT * SLOTB, LDS_BT = 2 * NSLOT * SLOTB, LDS_WS = LDS_BT + 1536, LDS_END = LDS_WS + 8 * 256;
constexpr int XROW = 132;
__device__ __forceinline__ int crow(int r, int hi) { return (r & 3) + 8 * (r >> 2) + 4 * hi; }
__device__ __forceinline__ s16x4 vtr(const LAS unsigned char* p) { typedef short v4i16_t __attribute__((ext_vector_type(4))); return __builtin_bit_cast(s16x4, __builtin_amdgcn_ds_read_tr16_b64_v4i16((LAS v4i16_t*)p)); }
#define ATT_WAIT_BAR(N) asm volatile("s_waitcnt vmcnt(" #N ") lgkmcnt(0)\n\ts_barrier" ::: "memory")

__device__ __forceinline__ void attn_unit(const P& p, LAS unsigned char* lds, int b, int h, int qb) {
    const int tid = threadIdx.x, lane = tid & 63, r32 = lane & 31, hi = lane >> 5;
    const int wid = __builtin_amdgcn_readfirstlane(tid >> 6), qg = wid & 3, mp = wid >> 2;
    const size_t rowbase = (size_t)b * SEQ;
    const int q0w = qb * 128 + qg * 32;
    const int NT = 2 * qb + 2, myNT = NT - (qg < 2 ? 1 : 0);
    LAS float* bt = (LAS float*)(lds + LDS_BT);
    for (int i = tid; i < 384; i += NTHR) bt[i] = p.miscf[MF_BIAS + h * 384 + i];
    const float cfar = p.miscf[MF_BIAS + h * 384];
    bf16x8 qr[4];
    { const bf16* Qw = p.Q + (rowbase + q0w + r32) * 512 + h * 128 + mp * 64 + hi * 8;
#pragma unroll
      for (int d0 = 0; d0 < 4; ++d0) qr[d0] = *(const bf16x8*)(Qw + d0 * 16); }
    const bf16* ksrc = p.K + (rowbase + lane) * 512 + h * 128 + (2 * wid) * 8;
    const bf16* vsrc = p.V + (rowbase + 16 * (wid & 3) + (lane >> 2)) * 512 + h * 128 + (wid >> 2) * 32 + (lane & 3) * 8;
    const unsigned kdst = LDS_K + (2 * wid) * 1024, vdst = LDS_V + (wid >> 2) * 4096 + (wid & 3) * 1024;
#define ATT_ISSUE(t, so) do { const size_t go_ = (size_t)(t) * 64 * 512; const unsigned so_ = (unsigned)__builtin_amdgcn_readfirstlane(so); \
        __builtin_amdgcn_global_load_lds((const unsigned*)(ksrc + go_), (LAS unsigned*)(lds + kdst + so_), 16, 0, 0); \
        __builtin_amdgcn_global_load_lds((const unsigned*)(ksrc + go_ + 8), (LAS unsigned*)(lds + kdst + 1024 + so_), 16, 0, 0); \
        __builtin_amdgcn_global_load_lds((const unsigned*)(vsrc + go_), (LAS unsigned*)(lds + vdst + so_), 16, 0, 0); \
        __builtin_amdgcn_global_load_lds((const unsigned*)(vsrc + go_ + 64), (LAS unsigned*)(lds + vdst + 8192 + so_), 16, 0, 0); } while (0)
    ATT_ISSUE(0, 0); ATT_ISSUE(1, SLOTB);
    f32x16 o[4];
#pragma unroll
    for (int d0 = 0; d0 < 4; ++d0) o[d0] = (f32x16){0.f, 0.f, 0.f, 0.f, 0.f, 0.f, 0.f, 0.f, 0.f, 0.f, 0.f, 0.f, 0.f, 0.f, 0.f, 0.f};
    float l_reg = 0.f;
    const LAS unsigned char* kp0 = lds + LDS_K + mp * 8192 + hi * 1024 + r32 * 16;
    const LAS unsigned char* vp0 = lds + LDS_V + ((lane >> 4) & 1) * 32 + (lane & 3) * 8 + (4 * hi + ((lane & 15) >> 2)) * 64;
    int slot = 0;
#pragma unroll 1
    for (int t = 0; t < NT; ++t) {
        if (t + 1 < NT) { ATT_WAIT_BAR(4); } else { ATT_WAIT_BAR(0); }
        { const int s2 = slot == 0 ? 2 * SLOTB : slot - SLOTB;
          if (t + 2 < NT) ATT_ISSUE(t + 2, s2); }
        if (t < myNT) {
            const LAS unsigned char* kp = kp0 + slot; const LAS unsigned char* vp = vp0 + slot;
            const bool nearb = (t * 64 + 63 - q0w) > -91;
            const float ci = nearb ? 0.f : cfar;
            f32x16 c0, c1;
#pragma unroll
            for (int r = 0; r < 16; ++r) { c0[r] = ci; c1[r] = ci; }
#pragma unroll
            for (int d0 = 0; d0 < 4; ++d0) {
                const bf16x8 k0 = *(const LAS bf16x8*)(kp + d0 * 2048), k1 = *(const LAS bf16x8*)(kp + d0 * 2048 + 512);
                c0 = __builtin_amdgcn_mfma_f32_32x32x16_bf16(k0, qr[d0], c0, 0, 0, 0);
                c1 = __builtin_amdgcn_mfma_f32_32x32x16_bf16(k1, qr[d0], c1, 0, 0, 0);
            }
            if (nearb) {
                const LAS float* bp = bt + (t * 64 - q0w - r32 + 256 + 4 * hi);
#pragma unroll
                for (int r = 0; r < 16; ++r) { const int cr = (r & 3) + 8 * (r >> 2); c0[r] += bp[cr]; c1[r] += bp[cr + 32]; }
            }
            float sacc = 0.f;
#pragma unroll
            for (int r = 0; r < 16; ++r) { c0[r] = __builtin_amdgcn_exp2f(c0[r]); c1[r] = __builtin_amdgcn_exp2f(c1[r]); sacc += c0[r] + c1[r]; }
            l_reg += sacc;
            u32x4 pw[4];
#pragma unroll
            for (int j = 0; j < 4; ++j) { pw[0][j] = pg8::cvt_pk_bf16(c0[2 * j], c0[2 * j + 1]); pw[1][j] = pg8::cvt_pk_bf16(c0[8 + 2 * j], c0[9 + 2 * j]);
                                          pw[2][j] = pg8::cvt_pk_bf16(c1[2 * j], c1[2 * j + 1]); pw[3][j] = pg8::cvt_pk_bf16(c1[8 + 2 * j], c1[9 + 2 * j]); }
#pragma unroll
            for (int d0 = 0; d0 < 4; ++d0)
#pragma unroll
                for (int ks = 0; ks < 4; ++ks) {
                    const s16x4 lo = vtr(vp + d0 * 4096 + ks * 1024), hh = vtr(vp + d0 * 4096 + ks * 1024 + 512);
                    const bf16x8 vf = (bf16x8){lo[0], lo[1], lo[2], lo[3], hh[0], hh[1], hh[2], hh[3]};
                    o[d0] = __builtin_amdgcn_mfma_f32_32x32x16_bf16(__builtin_bit_cast(bf16x8, pw[ks]), vf, o[d0], 0, 0, 0);
                }
        }
        slot = slot == 2 * SLOTB ? 0 : slot + SLOTB;
    }
#undef ATT_ISSUE
    l_reg += __shfl_xor(l_reg, 32);
    LAS float* wsf = (LAS float*)(lds + LDS_WS) + wid * 64;
    { const float lam = p.miscf[MF_LAM]; if (hi == 0) wsf[r32] = (mp == 0 ? 1.0f : lam) / l_reg; }
    asm volatile("s_waitcnt lgkmcnt(0)" ::: "memory");
#pragma unroll
    for (int r = 0; r < 16; ++r) { const float f = wsf[crow(r, hi)];
#pragma unroll
        for (int d0 = 0; d0 < 4; ++d0) o[d0][r] *= f; }
    ATT_WAIT_BAR(0);
    LAS float* X = (LAS float*)lds + qg * 32 * XROW;
    if (mp == 1) {
#pragma unroll
        for (int d0 = 0; d0 < 4; ++d0)
#pragma unroll
            for (int r = 0; r < 16; ++r) X[crow(r, hi) * XROW + d0 * 32 + r32] = o[d0][r];
    }
    ATT_WAIT_BAR(0);
    if (mp == 0) {
#pragma unroll
        for (int d0 = 0; d0 < 4; ++d0)
#pragma unroll
            for (int r = 0; r < 16; ++r) { LAS float* xp = X + crow(r, hi) * XROW + d0 * 32 + r32; *xp = o[d0][r] - *xp; }
        asm volatile("s_waitcnt lgkmcnt(0)" ::: "memory");
        const int row = lane >> 1, half = lane & 1;
        const LAS float* xr = X + row * XROW + half * 64;
        f32x4 v[16]; float ss = 0.f;
#pragma unroll
        for (int i = 0; i < 16; ++i) { v[i] = *(const LAS f32x4*)(xr + 4 * i); ss += v[i].x * v[i].x + v[i].y * v[i].y + v[i].z * v[i].z + v[i].w * v[i].w; }
        ss += __shfl_xor(ss, 1);
        const float rs = __builtin_amdgcn_rsqf(ss * (1.0f / 128.0f) + RMS_EPS) * (1.0f - LAMBDA_INIT);
        const float* gp = p.subln_g + half * 64;
        bf16* op = p.AB + (rowbase + q0w + row) * 1024 + h * 128 + half * 64;
#pragma unroll
        for (int i = 0; i < 8; ++i) { const f32x4 g0 = *(const f32x4*)(gp + 8 * i), g1 = *(const f32x4*)(gp + 8 * i + 4); const f32x4 a = v[2 * i] * rs * g0, c = v[2 * i + 1] * rs * g1;
            u32x4 w; w.x = pg8::cvt_pk_bf16(a.x, a.y); w.y = pg8::cvt_pk_bf16(a.z, a.w); w.z = pg8::cvt_pk_bf16(c.x, c.y); w.w = pg8::cvt_pk_bf16(c.z, c.w); *(u32x4*)(op + 8 * i) = w; }
    }
    ATT_WAIT_BAR(0);
}
#undef ATT_WAIT_BAR
}
__device__ __forceinline__ void ph_attn(const P& p, LAS unsigned char* lds, int bid, int nb) {
    const int vcu = (bid % 8) * (nb / 8) + bid / 8;
    for (int v = vcu; v < 256; v += nb) {
        const int bh = v >> 5, s = v & 31;
        att::attn_unit(p, lds, bh >> 2, bh & 3, 63 - s);
        att::attn_unit(p, lds, bh >> 2, bh & 3, s);
    }
}

struct BranchOrder {
    pg8::StaticOrder so;
    __device__ bool next(int i, pg8::Unit& u) const { if (!so.tile((long)(i >> 1) * so.G + so.c, u)) return false; u.aux = i & 1; u.a_off += (unsigned)(i & 1) * 1024u; u.b_off += (unsigned)(i & 1) * 1024u; return true; }
    __device__ unsigned row_off(const pg8::Unit&, int) const { return 0u; }
};
__device__ __forceinline__ void ph_inproj(const P& p, LAS unsigned char* lds, int bid, int nb) {
    pg8::Gemm g{p.XN, p.WIN, 1024, 1024, 16};
    pg8::StaticOrder S; S.init(MTOK, DIN, 1024, 1024, nb, bid);
    pg8::EpiIn E{p.Q, p.K, p.V, p.U, p.GA, p.GP, p.q_norm_g, p.k_norm_g};
    pg8::gemm_phase<pg8::EpiIn, pg8::StaticOrder, false>(lds, g, S, E);
}
__device__ __forceinline__ void ph_branch(const P& p, LAS unsigned char* lds, int bid, int nb) {
    pg8::Gemm g{p.AB, p.WBR, 1024, 1024, 8};
    BranchOrder S; S.so.init(MTOK, DM, 1024, 1024, nb, bid);
    pg8::EpiBranch E{p.XN, p.GA, p.GP};
    pg8::gemm_phase<pg8::EpiBranch, BranchOrder, false>(lds, g, S, E);
}
__device__ __forceinline__ void ph_wout(const P& p, LAS unsigned char* lds, int bid, int nb) {
    pg8::Gemm g{p.XN, p.WOUT, 1024, 1024, 16};
    pg8::StaticOrder S; S.init(MTOK, DM, 1024, 1024, nb, bid);
    pg8::EpiOut E{p.x, p.miscf + MF_MOD, p.out};
    pg8::gemm_phase<pg8::EpiOut, pg8::StaticOrder, false>(lds, g, S, E);
}


struct MoeOrder {
    const LAS int* arr; const unsigned* list; int G, vcu, npn; unsigned bstride, tB, tA;
    __device__ bool next(int i, pg8::Unit& u) const {
        const int L = i * G + vcu, T = arr[33 + 16]; if (L >= T * npn) return false;
        const int tile = L / npn, pn = L % npn; int e = 0;
#pragma unroll
        for (int k = 1; k < 16; ++k) e += (arr[33 + k] <= tile) ? 1 : 0;
        const int mt = tile - arr[33 + e];
        u.aux = e; u.pn = pn; u.pm = tile; u.n = arr[e]; u.pos0 = mt * 256; u.a_off = (unsigned)tile * tA; u.b_off = (unsigned)e * bstride + (unsigned)pn * tB; return true;
    }
    __device__ unsigned row_off(const pg8::Unit& u, int r) const { int pos = u.pos0 + r; pos = pos < u.n ? pos : u.n - 1; return list[((size_t)u.aux * 16384 + pos) * 2] * 2048u; }
};
__device__ __forceinline__ void ph_moe1(const P& p, LAS unsigned char* lds, unsigned char* ldsg, int bid, int nb) {
    int* arr = (int*)(ldsg + 131072); moe_offsets(p, arr);
    pg8::Gemm g{p.XN, p.W1, 1024, 1024, 16};
    MoeOrder S{(const LAS int*)(lds + 131072), p.list, nb, (bid % 8) * (nb / 8) + bid / 8, 4, 1024u * 1024u * 2u, 256u * 1024u * 2u, 0u};
    pg8::EpiMoe1 E{p.HID};
    pg8::gemm_phase<pg8::EpiMoe1, MoeOrder, true>(lds, g, S, E);
}
__device__ __forceinline__ void ph_moe2(const P& p, LAS unsigned char* lds, unsigned char* ldsg, int bid, int nb) {
    int* arr = (int*)(ldsg + 131072); moe_offsets(p, arr);
    pg8::Gemm g{p.HID, p.W2, 512, 512, 8};
    MoeOrder S{(const LAS int*)(lds + 131072), p.list, nb, (bid % 8) * (nb / 8) + bid / 8, 4, 1024u * 512u * 2u, 256u * 512u * 2u, 256u * 512u * 2u};
    pg8::EpiMoe2 E{p.Y, p.list};
    pg8::gemm_phase<pg8::EpiMoe2, MoeOrder, false>(lds, g, S, E);
}

constexpr int N_PHASES = 11;
__global__ void __launch_bounds__(NTHR, 2) mega_fwd(Args args) {
    extern __shared__ __attribute__((aligned(16))) unsigned char lds[];
    P p;
    p.x = args.in[0]; p.c = args.in[1]; p.rel_bias = args.in[2]; p.ada_w = args.in[3]; p.ada_b = args.in[4]; p.norm1_g = args.in[5]; p.w_in = args.in[6]; p.q_norm_g = args.in[7]; p.k_norm_g = args.in[8];
    p.lq1 = args.in[9]; p.lk1 = args.in[10]; p.lq2 = args.in[11]; p.lk2 = args.in[12]; p.subln_g = args.in[13]; p.wba = args.in[14]; p.pool_w = args.in[15]; p.pool_scale = args.in[16]; p.wbp = args.in[17];
    p.w_out = args.in[18]; p.norm2_g = args.in[19]; p.rgw = args.in[20]; p.rgb = args.in[21]; p.rew = args.in[22]; p.reb = args.in[23]; p.wgate = args.in[24]; p.wup = args.in[25]; p.wdown = args.in[26];
    p.out = args.out; p.ws = args.ws;
    unsigned char* ws = args.ws;
    p.ctl = (unsigned*)(ws + WS_CTL); p.miscf = (float*)(ws + WS_MISC); p.list = (unsigned*)(ws + WS_LIST); p.route = (int*)(ws + WS_ROUTE);
    p.WIN = (bf16*)(ws + WS_WIN); p.WBR = (bf16*)(ws + WS_WBR); p.WOUT = (bf16*)(ws + WS_WOUT); p.W1 = (bf16*)(ws + WS_W1); p.W2 = (bf16*)(ws + WS_W2);
    p.XN = (bf16*)(ws + WS_XN); p.Q = (bf16*)(ws + WS_Q); p.K = (bf16*)(ws + WS_K); p.V = (bf16*)(ws + WS_V); p.U = (bf16*)(ws + WS_U); p.GA = (bf16*)(ws + WS_GA); p.GP = (bf16*)(ws + WS_GP);
    p.AB = (bf16*)(ws + WS_AB); p.HID = (bf16*)(ws + WS_HID); p.Y = (bf16*)(ws + WS_Y);
    const int bid = blockIdx.x, nb = gridDim.x;
    const int lo = args.ph_lo, hi = args.ph_hi;
    volatile LAS unsigned* MISC = (volatile LAS unsigned*)((LAS unsigned char*)lds + LDS_BYTES - 64);
    XcdBarrier bar; bar.bar = p.ctl + CW_BAR; bar.x = 0; bar.st = nullptr;
    if (hi - lo > 1) {
        if (threadIdx.x < 2) MISC[threadIdx.x] = 0u;
        __syncthreads();
        bar = xcd_barrier_post(p.ctl + CW_BAR, MISC);
    }
#ifndef PHASE_MASK
#define PHASE_MASK 0xFFFF
#endif
#define IN(k) (((PHASE_MASK >> (k)) & 1) && lo <= (k) && (k) < hi)
#define SEAM(k) do { if (IN(k) && IN((k) + 1)) xcd_barrier(bar); } while (0)
    if (IN(0)) { ph_prologue(p, lds, bid, nb); } SEAM(0);
    if (IN(1)) { ph_norm1(p, lds, bid, nb); } SEAM(1);
#if FAST_INPROJ == 2
    if (IN(2)) { ph_inproj_naive(p, lds, bid, nb); } SEAM(2);
    if (IN(3)) { ph_qknorm_naive(p, bid, nb); __syncthreads(); ph_inproj(p, (LAS unsigned char*)lds, bid, nb); } SEAM(3);
#elif FAST_INPROJ
    if (IN(2)) { ph_inproj(p, (LAS unsigned char*)lds, bid, nb); } SEAM(2);
#else
    if (IN(2)) { ph_inproj_naive(p, lds, bid, nb); } SEAM(2);
    if (IN(3)) { ph_qknorm_naive(p, bid, nb); } SEAM(3);
#endif
#if FAST_ATTN
    if (IN(4)) { ph_attn(p, (LAS unsigned char*)lds, bid, nb); __syncthreads(); ph_pool_naive(p, lds, bid, nb); } SEAM(4);
#else
    if (IN(4)) { ph_attn_naive(p, lds, bid, nb); __syncthreads(); ph_pool_naive(p, lds, bid, nb); } SEAM(4);
#endif
#if FAST_BRANCH
    if (IN(5)) { ph_branch(p, (LAS unsigned char*)lds, bid, nb); } SEAM(5);
#else
    if (IN(5)) { ph_branch_naive(p, lds, bid, nb); } SEAM(5);
#endif
#if FAST_WOUT
    if (IN(6)) { ph_wout(p, (LAS unsigned char*)lds, bid, nb); } SEAM(6);
#else
    if (IN(6)) { ph_wout_naive(p, lds, bid, nb); } SEAM(6);
#endif
    if (IN(7)) { ph_norm2_route(p, lds, bid, nb); } SEAM(7);
#if FAST_MOE
    if (IN(8)) { ph_moe1(p, (LAS unsigned char*)lds, lds, bid, nb); } SEAM(8);
    if (IN(9)) { ph_moe2(p, (LAS unsigned char*)lds, lds, bid, nb); } SEAM(9);
#else
    if (IN(8)) { ph_moe1_naive(p, lds, bid, nb); } SEAM(8);
    if (IN(9)) { ph_moe2_naive(p, lds, bid, nb); } SEAM(9);
#endif
    if (IN(10)) { ph_combine(p, lds, bid, nb); }
#undef IN
#undef SEAM
}

extern "C" void kernel_launch(void* const* d_in, const int* in_sizes, int n_in, void* d_out, int out_size, void* d_ws, size_t ws_size, hipStream_t stream) {
    static int grid = 0;
    if (grid == 0) {
        if (n_in != 27 || in_sizes[0] != MTOK * DM || out_size != MTOK * DM || ws_size < WS_END) {
            fprintf(stderr, "kernel_launch: unexpected shapes: n_in %d in0 %d out %d ws %zu; nothing launched\n", n_in, n_in > 0 ? in_sizes[0] : -1, out_size, ws_size); grid = -1; return; }
        int dev = 0, cus = 0;
        if (hipGetDevice(&dev) != hipSuccess || hipDeviceGetAttribute(&cus, hipDeviceAttributeMultiprocessorCount, dev) != hipSuccess) { grid = -1; return; }
        if (hipFuncSetAttribute((const void*)mega_fwd, hipFuncAttributeMaxDynamicSharedMemorySize, LDS_BYTES) != hipSuccess) { fprintf(stderr, "kernel_launch: hipFuncSetAttribute failed\n"); grid = -1; return; }
        int per_cu = 0;
        if (hipOccupancyMaxActiveBlocksPerMultiprocessor(&per_cu, (const void*)mega_fwd, NTHR, LDS_BYTES) != hipSuccess || per_cu < 1)
            fprintf(stderr, "kernel_launch: note: occupancy query reports %d workgroups per CU\n", per_cu);
        (void)hipGetLastError();
        grid = cus;
    }
    if (grid < 0) return;
    (void)hipMemsetAsync((char*)d_ws + WS_CTL, 0, CTL_ZERO_BYTES, stream);
    Args a{};
    for (int i = 0; i < 27; ++i) a.in[i] = (const float*)d_in[i];
    a.out = (float*)d_out; a.ws = (unsigned char*)d_ws;
    if (MK_N_LAUNCHES == 1) {
        a.ph_lo = 0; a.ph_hi = N_PHASES;
        hipLaunchKernelGGL(mega_fwd, dim3(grid), dim3(NTHR), LDS_BYTES, stream, a);
    } else {
        for (int k = 0; k < N_PHASES; ++k) { a.ph_lo = k; a.ph_hi = k + 1; hipLaunchKernelGGL(mega_fwd, dim3(grid), dim3(NTHR), LDS_BYTES, stream, a); }
    }
}
```

```cpp
#include <hip/hip_runtime.h>
#include <cstdio>
#include <cstdint>
#include <cmath>

#define FAST_INPROJ 1
#define FAST_BRANCH 1
#define FAST_WOUT 1
#define FAST_MOE 1
#define FAST_ATTN 1
#ifndef REP_PHASE
#define REP_PHASE -1
#endif
#define NREP(k) ((REP_PHASE) == (k) ? 2 : 1)
#ifndef MK_N_LAUNCHES
#define MK_N_LAUNCHES 1
#endif

#define GAS __attribute__((address_space(1)))
#define LAS __attribute__((address_space(3)))
typedef unsigned short bf16;
typedef unsigned v4u __attribute__((ext_vector_type(4)));
typedef unsigned v2u __attribute__((ext_vector_type(2)));
typedef float f32x4 __attribute__((ext_vector_type(4)));

constexpr int NB = 2, SEQ = 8192, DM = 1024, MTOK = NB * SEQ, DIN = 4096, DATT = 512, DPOOL = 512, NEXP = 16, DEXP = 512;
constexpr int NHEAD = 4, HD = 64;
constexpr float RMS_EPS = 1e-6f;
constexpr float LOG2E = 1.4426950408889634f;
constexpr float LAMBDA_INIT = 0.2f;
constexpr int NWAVES = 8, NTHR = 512;
constexpr int LDS_BYTES = 147456;
constexpr int MOE_ROWS = 36864;

constexpr size_t MiB = 1u << 20;
constexpr size_t WS_CTL = 0, CTL_ZERO_BYTES = 1 * MiB;
constexpr size_t WS_MISC = 1 * MiB;
constexpr size_t WS_LIST = 2 * MiB;
constexpr size_t WS_ROUTE = WS_MISC + 512 * 1024;
constexpr size_t WS_WIN = 4 * MiB, WS_WBR = 12 * MiB, WS_WOUT = 14 * MiB, WS_W1 = 16 * MiB, WS_W2 = 48 * MiB;
constexpr size_t WS_XN = 64 * MiB;
constexpr size_t WS_Q = 96 * MiB, WS_K = 112 * MiB, WS_V = 128 * MiB, WS_U = 144 * MiB, WS_GA = 160 * MiB, WS_GP = 192 * MiB;
constexpr size_t WS_AB = 224 * MiB;
constexpr size_t WS_HID = 96 * MiB, WS_Y = 132 * MiB;
constexpr size_t WS_END = 256 * MiB;
constexpr int MF_LAM = 0, MF_BIAS = 64  , MF_MOD = 2048  , MF_MODP = 16384  ;
constexpr int MOD_SPLITS = 8;
constexpr int CW_CNT = 64;
constexpr int CW_BAR = 4096;

struct Args { const float* in[27]; float* out; unsigned char* ws; int ph_lo, ph_hi; };

struct P {
    const float *x, *c, *rel_bias, *ada_w, *ada_b, *norm1_g, *w_in, *q_norm_g, *k_norm_g, *lq1, *lk1, *lq2, *lk2, *subln_g, *wba, *pool_w, *pool_scale, *wbp, *w_out, *norm2_g,
        *rgw, *rgb, *rew, *reb, *wgate, *wup, *wdown;
    float* out; unsigned char* ws;
    unsigned* ctl; float* miscf; unsigned* list; int* route;
    bf16 *WIN, *WBR, *WOUT, *W1, *W2, *XN, *Q, *K, *V, *U, *GA, *GP, *AB, *HID, *Y;
};

__device__ __forceinline__ unsigned f2bf(float f) { unsigned u = __float_as_uint(f); return (u + 0x7fffu + ((u >> 16) & 1u)) >> 16; }
__device__ __forceinline__ unsigned pk2(float lo, float hi) { return f2bf(lo) | (f2bf(hi) << 16); }
__device__ __forceinline__ float bf2f(unsigned h) { return __uint_as_float(h << 16); }
__device__ __forceinline__ float bflo(unsigned w) { return __uint_as_float(w << 16); }
__device__ __forceinline__ float bfhi(unsigned w) { return __uint_as_float(w & 0xffff0000u); }
__device__ __forceinline__ float wave_sum(float v) {
#pragma unroll
    for (int o = 1; o < 64; o <<= 1) v += __shfl_xor(v, o);
    return v;
}
__device__ __forceinline__ float wave_max(float v) {
#pragma unroll
    for (int o = 1; o < 64; o <<= 1) v = fmaxf(v, __shfl_xor(v, o));
    return v;
}
__device__ __forceinline__ float sigmoidf_(float v) { return 1.0f / (1.0f + __expf(-v)); }
__device__ __forceinline__ float siluf_(float v) { return v / (1.0f + __expf(-v)); }
__device__ __forceinline__ int t5_bucket(int rel) {
    int n = rel < 0 ? -rel : rel;
    int b;
    if (n < 8) b = n; else if (n < 12) b = 8; else if (n < 16) b = 9; else if (n < 23) b = 10; else if (n < 32) b = 11; else if (n < 46) b = 12; else if (n < 64) b = 13; else if (n < 91) b = 14; else b = 15;
    return b + (rel > 0 ? 16 : 0);
}

#define XB_TMO      128
#define XB_XCNT(j)  (256  + 64 * (j))
#define XB_XSUB(j)  (1280 + 64 * (j))
#define XB_XGEN(j)  (2304 + 64 * (j))
#define XB_TOP      3328
#define XB_TOPGEN   3392
#define XCD_BAR_WORDS 3456
#define XB_SPIN_CAP (1u << 18)
__device__ __forceinline__ unsigned xb_ld(unsigned* p)              { return __hip_atomic_load(p, __ATOMIC_RELAXED, __HIP_MEMORY_SCOPE_AGENT); }
__device__ __forceinline__ unsigned xb_add(unsigned* p, unsigned v) { return __hip_atomic_fetch_add(p, v, __ATOMIC_RELAXED, __HIP_MEMORY_SCOPE_AGENT); }
__device__ __forceinline__ unsigned xb_xcc_id() { return (unsigned)__builtin_amdgcn_s_getreg((3 << 11) | 20) & 0xFu; }
#define XB_SPIN(cond, bar) do { unsigned _sp = 0; while (cond) { __builtin_amdgcn_s_sleep(1); \
    if ((++_sp & 255u) == 0u) { if (xb_ld(&(bar)[XB_TMO])) break; if (_sp > XB_SPIN_CAP) { atomicAdd(&(bar)[XB_TMO], 1u); break; } } } } while (0)
struct XcdBarrier { unsigned* bar; unsigned x; volatile LAS unsigned* st; };
__device__ __forceinline__ XcdBarrier xcd_barrier_post(unsigned* bar, volatile LAS unsigned* st) {
    XcdBarrier b; b.bar = bar; b.x = xb_xcc_id(); b.st = st;
    if (threadIdx.x == 0) (void)xb_add(&bar[XB_XCNT(b.x)], 1u);
    return b;
}
__device__ __forceinline__ void xcd_barrier_complete(unsigned* bar, unsigned x, unsigned& nloc, unsigned& nx) {
    const unsigned G = gridDim.x * gridDim.y * gridDim.z;
    unsigned sum, cnt, mine, sp = 0u;
    for (;;) {
        sum = 0u; cnt = 0u; mine = 0u;
#pragma unroll
        for (unsigned j = 0; j < 16; ++j) { const unsigned c = xb_ld(&bar[XB_XCNT(j)]); sum += c; cnt += (c > 0u) ? 1u : 0u; mine = (j == x) ? c : mine; }
        if (sum == G) break;
        __builtin_amdgcn_s_sleep(1);
        if ((++sp & 255u) == 0u) { if (xb_ld(&bar[XB_TMO])) break; if (sp > XB_SPIN_CAP) { atomicAdd(&bar[XB_TMO], 1u); break; } }
    }
    nloc = mine > 0u ? mine : 1u; nx = cnt > 0u ? cnt : 1u;
}
__device__ __forceinline__ void xcd_barrier(const XcdBarrier& b) {
    asm volatile("s_waitcnt vmcnt(0)" ::: "memory");
    __syncthreads();
    if (threadIdx.x == 0) {
        unsigned* bar = b.bar;
        __builtin_amdgcn_s_waitcnt(0);
        unsigned nloc = b.st[0], nx = b.st[1];
        if (nloc == 0u) { xcd_barrier_complete(bar, b.x, nloc, nx); b.st[0] = nloc; b.st[1] = nx; }
        const unsigned old = xb_add(&bar[XB_XSUB(b.x)], 1u);
        const unsigned gen = old / nloc;
        if (old + 1u == (gen + 1u) * nloc) {
            __builtin_amdgcn_fence(__ATOMIC_RELEASE, "agent");
            asm volatile("s_waitcnt vmcnt(0)" ::: "memory");
            const unsigned og = xb_add(&bar[XB_TOP], 1u);
            const unsigned tg = og / nx;
            if (og + 1u == (tg + 1u) * nx) xb_add(&bar[XB_TOPGEN], 1u);
            else XB_SPIN(xb_ld(&bar[XB_TOPGEN]) == tg, bar);
            __builtin_amdgcn_fence(__ATOMIC_ACQUIRE, "agent");
            xb_add(&bar[XB_XGEN(b.x)], 1u);
            asm volatile("s_waitcnt vmcnt(0)" ::: "memory");
        } else {
            XB_SPIN(xb_ld(&bar[XB_XGEN(b.x)]) == gen, bar);
            __builtin_amdgcn_fence(__ATOMIC_ACQUIRE, "agent");
            asm volatile("s_waitcnt vmcnt(0)" ::: "memory");
        }
    }
    __syncthreads();
}


namespace pg8 {
#define PG8_LAS __attribute__((address_space(3)))
typedef unsigned short bf16_t;
typedef short bf16x8 __attribute__((ext_vector_type(8)));
typedef float f32x4 __attribute__((ext_vector_type(4)));
typedef unsigned u32x4 __attribute__((ext_vector_type(4)));
constexpr int BM = 256, BK = 64, HALF = 128, HTB = HALF * BK * 2, STAGE_BYTES = 8 * HTB, NXCD = 8, WGM = 8;
__host__ __device__ __forceinline__ int lds_byte(int r, int c) { const int st = (r >> 4) * 2 + (c >> 5), rr = r & 15, cc = c & 31, ob = rr * 64 + cc * 2; return st * 1024 + (ob ^ (((ob >> 9) & 1) << 5)); }
__host__ __device__ __forceinline__ void stage_rc(int b, int& R, int& C) { const int st = b / 1024, sb = b % 1024, swz = sb ^ (((sb >> 9) & 1) << 5); R = (st >> 1) * 16 + swz / 64; C = (st & 1) * 32 + (swz % 64) / 2; }
__host__ __device__ __forceinline__ int perm32(int rho) { const int n = rho >> 4, i = rho & 15; return 8 * (i >> 2) + 4 * n + (i & 3); }

struct Unit { int pm, pn, aux, n, pos0; unsigned a_off, b_off; };
struct Gemm { const bf16_t* A; const bf16_t* Bt; int lda, ldb, nt; };

struct StaticOrder {
    int nM, nN, nwg, G, c; unsigned tA, tB;
    __device__ void init(int M, int N, int lda, int ldb, int G_, int c_) { nM = M / BM; nN = N / BM; nwg = nM * nN; G = G_; c = c_; tA = (unsigned)(BM * lda * 2); tB = (unsigned)(BM * ldb * 2); }
    __device__ bool tile(long L, Unit& u) const {
        if (L >= nwg) return false;
        int wgid = (int)L; { const int q = nwg / NXCD, r = nwg % NXCD, xcd = wgid % NXCD, off = wgid / NXCD; wgid = (xcd < r ? xcd * (q + 1) : r * (q + 1) + (xcd - r) * q) + off; }
        const int nig = WGM * nN, gid = wgid / nig, fm = gid * WGM, gsz = (nM - fm) < WGM ? (nM - fm) : WGM;
        u.pm = fm + ((wgid % nig) % gsz); u.pn = (wgid % nig) / gsz; u.aux = 0; u.n = 0; u.pos0 = 0; u.a_off = (unsigned)u.pm * tA; u.b_off = (unsigned)u.pn * tB; return true;
    }
    __device__ bool next(int i, Unit& u) const { return tile((long)i * G + c, u); }
    __device__ unsigned row_off(const Unit&, int) const { return 0u; }
};

typedef float f32x2_t __attribute__((ext_vector_type(2))); typedef __bf16 bf16x2_t __attribute__((ext_vector_type(2)));
__device__ __forceinline__ unsigned cvt_pk_bf16(float lo, float hi) { f32x2_t v = {lo, hi}; bf16x2_t b = __builtin_convertvector(v, bf16x2_t); return __builtin_bit_cast(unsigned, b); }
__device__ __forceinline__ float bflo_(unsigned w) { return __uint_as_float(w << 16); }
__device__ __forceinline__ float bfhi_(unsigned w) { return __uint_as_float(w & 0xffff0000u); }
__device__ __forceinline__ float sigm(float v) { return __builtin_amdgcn_rcpf(1.0f + __builtin_amdgcn_exp2f(-1.4426950408889634f * v)); }
__device__ __forceinline__ u32x4 pack8(const f32x4 v0, const f32x4 v1) { u32x4 w; w.x = cvt_pk_bf16(v0[0], v0[1]); w.y = cvt_pk_bf16(v0[2], v0[3]); w.z = cvt_pk_bf16(v1[0], v1[1]); w.w = cvt_pk_bf16(v1[2], v1[3]); return w; }


struct EpiIn {
    static constexpr bool PERM = true;
    bf16_t *Q, *K, *V, *U, *GA, *GP; const float *qg, *kg;
    __device__ __forceinline__ void operator()(const f32x4 (&acc)[2][2][4][2], const Unit& u, int wr, int wc, int fr, int fq) const {
        const int row0 = u.pm * BM + wr * 64 + fr, pn = u.pn;
#ifdef EPI_MASK
        if (!((EPI_MASK >> pn) & 1)) return;
#endif
        if (pn < 4) {
            const bool isq = pn < 2; bf16_t* base = (isq ? Q : K) + 256 * (pn & 1) + 64 * wc + 8 * fq; const float* gp = isq ? qg : kg; const float sc = isq ? 0.125f * 1.4426950408889634f : 1.0f;
            f32x4 gv[2][2];
#pragma unroll
            for (int bj = 0; bj < 2; ++bj)
#pragma unroll
                for (int n = 0; n < 2; ++n) gv[bj][n] = *(const f32x4*)(gp + 32 * bj + 8 * fq + 4 * n) * sc;
#pragma unroll
            for (int ai = 0; ai < 2; ++ai)
#pragma unroll
                for (int m = 0; m < 4; ++m) {
                    float ss = 0.f;
#pragma unroll
                    for (int bj = 0; bj < 2; ++bj)
#pragma unroll
                        for (int n = 0; n < 2; ++n) { const f32x4 x = acc[ai][bj][m][n]; ss += (x[0] * x[0] + x[1] * x[1]) + (x[2] * x[2] + x[3] * x[3]); }
                    ss += __shfl_xor(ss, 16); ss += __shfl_xor(ss, 32);
                    const float rstd = __builtin_amdgcn_rsqf(ss * (1.0f / 64.0f) + 1e-6f);
                    bf16_t* rowp = base + (size_t)(row0 + ai * HALF + m * 16) * 512;
#pragma unroll
                    for (int bj = 0; bj < 2; ++bj) *(u32x4*)(rowp + 32 * bj) = pack8(acc[ai][bj][m][0] * rstd * gv[bj][0], acc[ai][bj][m][1] * rstd * gv[bj][1]);
                }
        } else if (pn < 8) {
            bf16_t* base = (pn < 6 ? V : U) + 256 * (pn & 1) + 32 * wc + 8 * fq;
#pragma unroll
            for (int ai = 0; ai < 2; ++ai)
#pragma unroll
                for (int m = 0; m < 4; ++m) { bf16_t* rowp = base + (size_t)(row0 + ai * HALF + m * 16) * 512;
#pragma unroll
                    for (int bj = 0; bj < 2; ++bj) *(u32x4*)(rowp + bj * HALF) = pack8(acc[ai][bj][m][0], acc[ai][bj][m][1]); }
        } else {
            bf16_t* base = (pn < 12 ? GA : GP) + 256 * ((pn - 8) & 3) + 32 * wc + 8 * fq;
#pragma unroll
            for (int ai = 0; ai < 2; ++ai)
#pragma unroll
                for (int m = 0; m < 4; ++m) { bf16_t* rowp = base + (size_t)(row0 + ai * HALF + m * 16) * 1024;
#pragma unroll
                    for (int bj = 0; bj < 2; ++bj) { f32x4 v0 = acc[ai][bj][m][0], v1 = acc[ai][bj][m][1];
#pragma unroll
                        for (int e = 0; e < 4; ++e) { v0[e] = sigm(v0[e]); v1[e] = sigm(v1[e]); }
                        *(u32x4*)(rowp + bj * HALF) = pack8(v0, v1); } }
        }
    }
};
struct EpiBranch {
    static constexpr bool PERM = true;
    bf16_t* MG; const bf16_t *GA, *GP;
    __device__ __forceinline__ void operator()(const f32x4 (&acc)[2][2][4][2], const Unit& u, int wr, int wc, int fr, int fq) const {
        const int row0 = u.pm * BM + wr * 64 + fr; const size_t col0 = (size_t)u.pn * BM + wc * 32 + 8 * fq; const bool second = u.aux != 0; const bf16_t* G = second ? GP : GA;
#pragma unroll
        for (int ai = 0; ai < 2; ++ai)
#pragma unroll
            for (int m = 0; m < 4; ++m) { const size_t ro = (size_t)(row0 + ai * HALF + m * 16) * 1024 + col0;
#pragma unroll
                for (int bj = 0; bj < 2; ++bj) { const u32x4 g = *(const u32x4*)(G + ro + bj * HALF); f32x4 v0 = acc[ai][bj][m][0], v1 = acc[ai][bj][m][1];
                    v0[0] *= bflo_(g.x); v0[1] *= bfhi_(g.x); v0[2] *= bflo_(g.y); v0[3] *= bfhi_(g.y); v1[0] *= bflo_(g.z); v1[1] *= bfhi_(g.z); v1[2] *= bflo_(g.w); v1[3] *= bfhi_(g.w);
                    if (second) { const u32x4 o = *(const u32x4*)(MG + ro + bj * HALF);
                        v0[0] += bflo_(o.x); v0[1] += bfhi_(o.x); v0[2] += bflo_(o.y); v0[3] += bfhi_(o.y); v1[0] += bflo_(o.z); v1[1] += bfhi_(o.z); v1[2] += bflo_(o.w); v1[3] += bfhi_(o.w); }
                    *(u32x4*)(MG + ro + bj * HALF) = pack8(v0, v1); } }
    }
};
struct EpiOut {
    static constexpr bool PERM = false;
    const float* x; const float* mod; float* out;
    __device__ __forceinline__ void operator()(const f32x4 (&acc)[2][2][4][2], const Unit& u, int wr, int wc, int fr, int fq) const {
        const int row0 = u.pm * BM + wr * 64 + fr, col0 = u.pn * BM + wc * 32 + 4 * fq; const float* g1 = mod + (u.pm >> 5) * 6144 + 2048 + col0;
        f32x4 gv[2][2];
#pragma unroll
        for (int bj = 0; bj < 2; ++bj)
#pragma unroll
            for (int n = 0; n < 2; ++n) gv[bj][n] = *(const f32x4*)(g1 + bj * HALF + n * 16);
#pragma unroll
        for (int ai = 0; ai < 2; ++ai)
#pragma unroll
            for (int m = 0; m < 4; ++m) { const size_t off = (size_t)(row0 + ai * HALF + m * 16) * 1024 + col0;
#pragma unroll
                for (int bj = 0; bj < 2; ++bj)
#pragma unroll
                    for (int n = 0; n < 2; ++n) { const f32x4 xv = *(const f32x4*)(x + off + bj * HALF + n * 16); *(f32x4*)(out + off + bj * HALF + n * 16) = xv + gv[bj][n] * acc[ai][bj][m][n]; } }
    }
};
struct EpiMoe1 {
    static constexpr bool PERM = true;
    bf16_t* HID;
    __device__ __forceinline__ void operator()(const f32x4 (&acc)[2][2][4][2], const Unit& u, int wr, int wc, int fr, int fq) const {
        const int row0 = u.pm * BM + wr * 64 + fr; bf16_t* base = HID + 128 * u.pn + 32 * wc + 8 * fq;
#pragma unroll
        for (int ai = 0; ai < 2; ++ai)
#pragma unroll
            for (int m = 0; m < 4; ++m) { f32x4 v0 = acc[ai][0][m][0], v1 = acc[ai][0][m][1]; const f32x4 u0 = acc[ai][1][m][0], u1 = acc[ai][1][m][1];
#pragma unroll
                for (int e = 0; e < 4; ++e) { v0[e] = v0[e] * sigm(v0[e]) * u0[e]; v1[e] = v1[e] * sigm(v1[e]) * u1[e]; }
                *(u32x4*)(base + (size_t)(row0 + ai * HALF + m * 16) * 512) = pack8(v0, v1); }
    }
};
struct EpiMoe2 {
    static constexpr bool PERM = true;
    bf16_t* Y; const unsigned* list;
    __device__ __forceinline__ void operator()(const f32x4 (&acc)[2][2][4][2], const Unit& u, int wr, int wc, int fr, int fq) const {
        const int row0 = u.pm * BM + wr * 64 + fr; bf16_t* base = Y + (size_t)u.pn * BM + 32 * wc + 8 * fq;
#pragma unroll
        for (int ai = 0; ai < 2; ++ai)
#pragma unroll
            for (int m = 0; m < 4; ++m) { int pos = u.pos0 + ai * HALF + wr * 64 + m * 16 + fr; pos = pos < u.n ? pos : u.n - 1;
                const float w = __uint_as_float(list[((size_t)u.aux * 16384 + pos) * 2 + 1]);
                bf16_t* rowp = base + (size_t)(row0 + ai * HALF + m * 16) * 1024;
#pragma unroll
                for (int bj = 0; bj < 2; ++bj) *(u32x4*)(rowp + bj * HALF) = pack8(acc[ai][bj][m][0] * w, acc[ai][bj][m][1] * w); }
    }
};

template <class Epi, class Sched, bool GATHER>
__device__ __forceinline__ void gemm_phase(PG8_LAS unsigned char* lds, const Gemm g, const Sched& S, const Epi& E) {
    const int tid = threadIdx.x, wid = __builtin_amdgcn_readfirstlane(tid >> 6), lane = tid & 63, wr = wid >> 2, wc = wid & 3, fr = lane & 15, fq = lane >> 4;
    const int nt = g.nt;
    unsigned voffA[2], voffB[2]; int RA[2]; unsigned CA[2];
#pragma unroll
    for (int i = 0; i < 2; ++i) { int R, C; stage_rc(tid * 16 + i * 8192, R, C); const int Rb = Epi::PERM ? ((R & ~31) + perm32(R & 31)) : R;
        voffA[i] = (unsigned)(R * g.lda + C) * 2u; voffB[i] = (unsigned)(Rb * g.ldb + C) * 2u; RA[i] = R; CA[i] = (unsigned)C * 2u; }
    const size_t kstep = (size_t)(BK * 2);
    const size_t hstepA = (size_t)HALF * g.lda * 2, hstepB = (size_t)HALF * g.ldb * 2;
    const unsigned ldsw = (unsigned)wid * 1024u;
    const int aoff = lds_byte(wr * 64 + fr, fq * 8), boff = lds_byte(wc * 32 + fr, fq * 8);
#define PG8_SA(b, h) (((b) * 2 + (h)) * HTB)
#define PG8_SB(b, h) ((4 + (b) * 2 + (h)) * HTB)
#define PG8_STAGE2(bufoff, gbase, v0, v1) do { \
        __builtin_amdgcn_global_load_lds((const unsigned*)((const char*)(gbase) + (v0)), (PG8_LAS unsigned*)(lds + (bufoff) + ldsw), 16, 0, 0); \
        __builtin_amdgcn_global_load_lds((const unsigned*)((const char*)(gbase) + (v1)), (PG8_LAS unsigned*)(lds + (bufoff) + ldsw + 8192), 16, 0, 0); } while (0)
#define PG8_STAGEB(bufoff, gbase) PG8_STAGE2(bufoff, gbase, voffB[0], voffB[1])
#define PG8_STAGEA(bufoff, ptrN, ptrG, vg0, vg1) do { if constexpr (GATHER) { PG8_STAGE2(bufoff, ptrG, vg0, vg1); } else { PG8_STAGE2(bufoff, ptrN, voffA[0], voffA[1]); } } while (0)
#define PG8_LDA(dst, b, h) do { _Pragma("unroll") for (int m = 0; m < 4; ++m) _Pragma("unroll") for (int k = 0; k < 2; ++k) dst[m][k] = *(const PG8_LAS bf16x8*)(lds + PG8_SA(b, h) + aoff + m * 2048 + k * 1024); } while (0)
#define PG8_LDB(dst, b, h) do { _Pragma("unroll") for (int n = 0; n < 2; ++n) _Pragma("unroll") for (int k = 0; k < 2; ++k) dst[n][k] = *(const PG8_LAS bf16x8*)(lds + PG8_SB(b, h) + boff + n * 2048 + k * 1024); } while (0)
#define PG8_MMA(ai, bj, At, Bt) do { __builtin_amdgcn_s_setprio(1); _Pragma("unroll") for (int m = 0; m < 4; ++m) _Pragma("unroll") for (int n = 0; n < 2; ++n) _Pragma("unroll") for (int k = 0; k < 2; ++k) \
        acc[ai][bj][m][n] = __builtin_amdgcn_mfma_f32_16x16x32_bf16(Bt[n][k], At[m][k], acc[ai][bj][m][n], 0, 0, 0); __builtin_amdgcn_s_setprio(0); } while (0)
#define PG8_WAIT_V(n) asm volatile("s_waitcnt vmcnt(" #n ")" ::: "memory")
#define PG8_WAIT_L(n) asm volatile("s_waitcnt lgkmcnt(" #n ")" ::: "memory")
#define PG8_BAR __builtin_amdgcn_s_barrier()
#define PG8_SCHED __builtin_amdgcn_sched_barrier(0)
    Unit cur, nxt; int ui = 0;
    if (!S.next(0, cur)) return;
    f32x4 acc[2][2][4][2];
#pragma unroll
    for (int a = 0; a < 2; ++a)
#pragma unroll
        for (int b = 0; b < 2; ++b)
#pragma unroll
            for (int m = 0; m < 4; ++m)
#pragma unroll
                for (int n = 0; n < 2; ++n) acc[a][b][m][n] = (f32x4){0.f, 0.f, 0.f, 0.f};
    bf16x8 At[4][2], B0[2][2], B1[2][2];
    const char* cA = (const char*)g.A + cur.a_off; const char* cB = (const char*)g.Bt + cur.b_off;
    unsigned vc00 = 0, vc01 = 0, vc10 = 0, vc11 = 0, vn00 = 0, vn01 = 0, vn10 = 0, vn11 = 0;
    if constexpr (GATHER) { vc00 = S.row_off(cur, RA[0]) + CA[0]; vc01 = S.row_off(cur, RA[1]) + CA[1]; vc10 = S.row_off(cur, HALF + RA[0]) + CA[0]; vc11 = S.row_off(cur, HALF + RA[1]) + CA[1]; }
    const char* gA = (const char*)g.A;
    PG8_STAGEB(PG8_SB(0, 0), cB); PG8_STAGEB(PG8_SB(0, 1), cB + hstepB); PG8_STAGEA(PG8_SA(0, 0), cA, gA, vc00, vc01); PG8_STAGEA(PG8_SA(0, 1), cA + hstepA, gA, vc10, vc11);
    if (wr == 1) PG8_BAR;
    PG8_WAIT_V(2); PG8_BAR;
    PG8_STAGEB(PG8_SB(1, 0), cB + kstep); PG8_STAGEA(PG8_SA(1, 0), cA + kstep, gA + kstep, vc00, vc01); PG8_STAGEB(PG8_SB(1, 1), cB + hstepB + kstep);
    PG8_WAIT_V(6); PG8_BAR;
    for (;;) {
        const bool has_next = S.next(ui + 1, nxt);
        const char* nA = has_next ? (const char*)g.A + nxt.a_off : cA; const char* nB = has_next ? (const char*)g.Bt + nxt.b_off : cB;
        if constexpr (GATHER) {
            if (has_next) { vn00 = S.row_off(nxt, RA[0]) + CA[0]; vn01 = S.row_off(nxt, RA[1]) + CA[1]; vn10 = S.row_off(nxt, HALF + RA[0]) + CA[0]; vn11 = S.row_off(nxt, HALF + RA[1]) + CA[1]; }
            else { vn00 = vc00; vn01 = vc01; vn10 = vc10; vn11 = vc11; }
        }
        for (int t = 0; t < nt; t += 2) {
            const bool last = (t == nt - 2);
            const char* a1 = cA + (size_t)(t + 1) * kstep;
            const char* a2 = last ? nA : cA + (size_t)(t + 2) * kstep; const char* b2 = last ? nB : cB + (size_t)(t + 2) * kstep;
            const char* a3 = a2 + kstep; const char* b3 = b2 + kstep;
            const char* g1 = gA + (size_t)(t + 1) * kstep; const char* g2 = last ? gA : gA + (size_t)(t + 2) * kstep; const char* g3 = g2 + kstep;
            const unsigned w00 = last ? vn00 : vc00, w01 = last ? vn01 : vc01, w10 = last ? vn10 : vc10, w11 = last ? vn11 : vc11;
            PG8_LDB(B0, 0, 0); PG8_LDB(B1, 0, 1); PG8_SCHED; PG8_LDA(At, 0, 0); PG8_STAGEA(PG8_SA(1, 1), a1 + hstepA, g1, vc10, vc11);
            PG8_WAIT_V(8); PG8_WAIT_L(0); PG8_BAR; PG8_MMA(0, 0, At, B0); PG8_MMA(0, 1, At, B1); PG8_BAR; PG8_SCHED;
            PG8_LDA(At, 0, 1); PG8_STAGEB(PG8_SB(0, 0), b2); PG8_STAGEB(PG8_SB(0, 1), b2 + hstepB); PG8_STAGEA(PG8_SA(0, 0), a2, g2, w00, w01);
            PG8_WAIT_V(8); PG8_WAIT_L(0); PG8_BAR; PG8_MMA(1, 0, At, B0); PG8_MMA(1, 1, At, B1); PG8_BAR; PG8_SCHED;
            PG8_LDB(B0, 1, 0); PG8_LDB(B1, 1, 1); PG8_SCHED; PG8_LDA(At, 1, 0); PG8_STAGEA(PG8_SA(0, 1), a2 + hstepA, g2, w10, w11);
            PG8_WAIT_V(8); PG8_WAIT_L(0); PG8_BAR; PG8_MMA(0, 0, At, B0); PG8_MMA(0, 1, At, B1); PG8_BAR; PG8_SCHED;
            PG8_LDA(At, 1, 1); PG8_STAGEB(PG8_SB(1, 0), b3); PG8_STAGEB(PG8_SB(1, 1), b3 + hstepB); PG8_STAGEA(PG8_SA(1, 0), a3, g3, w00, w01);
            PG8_WAIT_V(8); PG8_WAIT_L(0); PG8_BAR; PG8_MMA(1, 0, At, B0); PG8_MMA(1, 1, At, B1); PG8_BAR; PG8_SCHED;
        }
        if (wr == 0) PG8_BAR;
        PG8_WAIT_V(0);
        E(acc, cur, wr, wc, fr, fq);
        if (!has_next) break;
#pragma unroll
        for (int a = 0; a < 2; ++a)
#pragma unroll
            for (int b = 0; b < 2; ++b)
#pragma unroll
                for (int m = 0; m < 4; ++m)
#pragma unroll
                    for (int n = 0; n < 2; ++n) acc[a][b][m][n] = (f32x4){0.f, 0.f, 0.f, 0.f};
        cur = nxt; cA = nA; cB = nB; ++ui;
        if constexpr (GATHER) { vc00 = vn00; vc01 = vn01; vc10 = vn10; vc11 = vn11; }
        if (wr == 1) PG8_BAR;
    }
    PG8_WAIT_V(0);
    PG8_BAR;
#undef PG8_SA
#undef PG8_SB
#undef PG8_STAGE2
#undef PG8_STAGEB
#undef PG8_STAGEA
#undef PG8_LDA
#undef PG8_LDB
#undef PG8_MMA
#undef PG8_WAIT_V
#undef PG8_WAIT_L
#undef PG8_BAR
#undef PG8_SCHED
}
}

__device__ __forceinline__ void transpose_item(const float* W, int N, bf16* dst, int dpitch, int drow0, int dk0, float* scr, int k0, int n0, int lane) {
#pragma unroll 8
    for (int i = 0; i < 32; ++i) { const int kk = 2 * i + (lane >> 5); scr[kk * 33 + (lane & 31)] = W[(size_t)(k0 + kk) * N + n0 + (lane & 31)]; }
    __builtin_amdgcn_s_waitcnt(0xC07F); asm volatile("" ::: "memory");
    const int c = lane & 7;
#pragma unroll
    for (int j = 0; j < 4; ++j) { const int n = (lane >> 3) + 8 * j; const float* s = scr + (8 * c) * 33 + n;
        v4u o; o.x = pk2(s[0 * 33], s[1 * 33]); o.y = pk2(s[2 * 33], s[3 * 33]); o.z = pk2(s[4 * 33], s[5 * 33]); o.w = pk2(s[6 * 33], s[7 * 33]);
        *(v4u*)(dst + (size_t)(drow0 + n) * dpitch + dk0 + k0 + 8 * c) = o; }
    __builtin_amdgcn_s_waitcnt(0xC07F); asm volatile("" ::: "memory");
}
__device__ __forceinline__ int win_rowmap(int n0) {
    if (n0 >= 1024) return n0;
    const int t = n0 >> 8, rem = n0 & 255, wc = rem >> 6, bj = (rem & 63) >> 5;
    return 256 * t + 128 * bj + 32 * wc;
}
__device__ __forceinline__ int win_colmap_inv(int np) {
    if (np >= 1024) return np;
    const int t = np >> 8, rem = np & 255, bj = rem >> 7, wc = (rem & 127) >> 5, j = rem & 31;
    return 256 * t + 64 * wc + 32 * bj + j;
}
__device__ __forceinline__ void ph_prologue(const P& p, unsigned char* ldsb, int bid, int nb) {
    const int tid = threadIdx.x, lane = tid & 63, wave = tid >> 6;
    float* scr = (float*)(ldsb + wave * 16384);
    const int gw = bid * NWAVES + wave, NGW = nb * NWAVES;
    constexpr int I_IN = 16 * 128, I_BA = 8 * 32, I_BP = 4 * 16 * 16, I_OUT = 16 * 32, I_G = 16 * 256, I_U = 16 * 256, I_D = 16 * 256, I_MOD = 96 * MOD_SPLITS;
    constexpr int NITEMS = I_MOD + I_IN + I_BA + I_BP + I_OUT + I_G + I_U + I_D;
    for (int it = gw; it < NITEMS; it += NGW) {
        int r = it;
        if (r < I_MOD) {
            const int ch = r % 96, sp = r / 96, j = ch * 64 + lane;
            float a0 = 0.f, a1 = 0.f;
#pragma unroll 1
            for (int kc = 0; kc < 2; ++kc) { const int k0 = sp * 128 + kc * 64;
                const float s0 = siluf_(p.c[k0 + lane]), s1 = siluf_(p.c[DM + k0 + lane]);
#pragma unroll 8
                for (int kk = 0; kk < 64; ++kk) { const float w = p.ada_w[(size_t)(k0 + kk) * 6144 + j]; a0 += __shfl(s0, kk) * w; a1 += __shfl(s1, kk) * w; } }
            p.miscf[MF_MODP + (sp * 2 + 0) * 6144 + j] = a0; p.miscf[MF_MODP + (sp * 2 + 1) * 6144 + j] = a1;
            continue;
        }
        r -= I_MOD;
        if (r < I_IN) { const int kb = r / 128, nbk = r % 128; transpose_item(p.w_in, DIN, p.WIN, DM, win_rowmap(nbk * 32), 0, scr, kb * 64, nbk * 32, lane); continue; } r -= I_IN;
        if (r < I_BA) { const int kb = r / 32, nbk = r % 32; transpose_item(p.wba, DM, p.WBR, DM, nbk * 32, 0, scr, kb * 64, nbk * 32, lane); continue; } r -= I_BA;
        if (r < I_BP) {
            const int g = r >> 8, cb = (r >> 4) & 15, n = (r & 15) * 64 + lane;
            float a[8];
#pragma unroll
            for (int q = 0; q < 8; ++q) a[q] = 0.f;
            const float* pw = p.pool_w + (size_t)(g * 128 + cb * 8) * 128;
#pragma unroll 4
            for (int j = 0; j < 128; ++j) { const float w = p.wbp[(size_t)(g * 128 + j) * DM + n] * p.pool_scale[g * 128 + j];
#pragma unroll
                for (int q = 0; q < 8; ++q) a[q] += pw[q * 128 + j] * w; }
            v4u o; o.x = pk2(a[0], a[1]); o.y = pk2(a[2], a[3]); o.z = pk2(a[4], a[5]); o.w = pk2(a[6], a[7]);
            *(v4u*)(p.WBR + (size_t)n * DM + 512 + g * 128 + cb * 8) = o;
            continue; } r -= I_BP;
        if (r < I_OUT) { const int kb = r / 32, nbk = r % 32; transpose_item(p.w_out, DM, p.WOUT, DM, nbk * 32, 0, scr, kb * 64, nbk * 32, lane); continue; } r -= I_OUT;
        if (r < I_G) { const int e = r / 256, q = r % 256, kb = q / 16, nbk = q % 16, n0 = nbk * 32;
            transpose_item(p.wgate + (size_t)e * DM * DEXP, DEXP, p.W1 + (size_t)e * 1024 * 1024, DM, 256 * (n0 >> 7) + (n0 & 127), 0, scr, kb * 64, n0, lane); continue; } r -= I_G;
        if (r < I_U) { const int e = r / 256, q = r % 256, kb = q / 16, nbk = q % 16, n0 = nbk * 32;
            transpose_item(p.wup + (size_t)e * DM * DEXP, DEXP, p.W1 + (size_t)e * 1024 * 1024, DM, 256 * (n0 >> 7) + 128 + (n0 & 127), 0, scr, kb * 64, n0, lane); continue; } r -= I_U;
        { const int e = r / 256, q = r % 256, kb = q / 32, nbk = q % 32;
            transpose_item(p.wdown + (size_t)e * DEXP * DM, DM, p.W2 + (size_t)e * 1024 * 512, DEXP, nbk * 32, 0, scr, kb * 64, nbk * 32, lane); }
    }
    if (bid == 0 && wave == 0) {
        float a = p.lq1[lane] * p.lk1[lane], b2 = p.lq2[lane] * p.lk2[lane];
        a = wave_sum(a); b2 = wave_sum(b2);
        const float lam = __expf(a) - __expf(b2) + LAMBDA_INIT;
        const float gq = wave_max(fabsf(p.q_norm_g[lane])), gk = wave_max(fabsf(p.k_norm_g[lane]));
        if (lane == 0) p.miscf[MF_LAM] = lam;
        for (int h = 0; h < NHEAD; ++h) {
            float bm = lane < 32 ? fabsf(p.rel_bias[lane * 4 + h]) : 0.f; bm = wave_max(bm);
            const float shift = 8.0f * gq * gk + bm;
            for (int i = lane; i < 384; i += 64) { const int rel = i - 256; p.miscf[MF_BIAS + h * 384 + i] = (p.rel_bias[t5_bucket(rel) * 4 + h] - shift) * LOG2E; }
        }
    }
}

__device__ __forceinline__ float mod_sum(const P& p, int b, int j) {
    float s = p.ada_b[j];
#pragma unroll
    for (int sp = 0; sp < MOD_SPLITS; ++sp) s += p.miscf[MF_MODP + (sp * 2 + b) * 6144 + j];
    return s;
}
__device__ __forceinline__ void ph_norm1(const P& p, unsigned char* ldsb, int bid, int nb) {
    const int tid = threadIdx.x, lane = tid & 63, wave = tid >> 6;
    float* la = (float*)ldsb; float* ls = la + 1024;
    for (int rb = bid; rb < 256; rb += nb) {
        const int b = rb / 128;
        __syncthreads();
        for (int c = tid; c < 1024; c += NTHR) { la[c] = p.norm1_g[c] * (1.0f + mod_sum(p, b, 1024 + c)); ls[c] = mod_sum(p, b, c); }
        if (tid < 48) { const int j = rb * 48 + tid; p.miscf[MF_MOD + j] = mod_sum(p, j / 6144, j % 6144); }
        __syncthreads();
        for (int i = 0; i < 8; ++i) {
            const int row = rb * 64 + wave * 8 + i;
            const f32x4* xr = (const f32x4*)(p.x + (size_t)row * DM) + lane;
            f32x4 v[4]; float ss = 0.f;
#pragma unroll
            for (int j = 0; j < 4; ++j) { v[j] = xr[64 * j]; ss += v[j].x * v[j].x + v[j].y * v[j].y + v[j].z * v[j].z + v[j].w * v[j].w; }
            const float rstd = rsqrtf(wave_sum(ss) * (1.0f / DM) + RMS_EPS);
            v2u* o = (v2u*)(p.XN + (size_t)row * DM) + lane;
#pragma unroll
            for (int j = 0; j < 4; ++j) { const int c = (64 * j + lane) * 4; const f32x4 a = *(const f32x4*)(la + c), s = *(const f32x4*)(ls + c);
                v2u w; w.x = pk2(v[j].x * rstd * a.x + s.x, v[j].y * rstd * a.y + s.y); w.y = pk2(v[j].z * rstd * a.z + s.z, v[j].w * rstd * a.w + s.w); o[64 * j] = w; }
        }
    }
}

template <class Epi>
__device__ __forceinline__ void gemm_nt_naive(const bf16* A, int lda, const bf16* Bt, int ldb, int M, int N, int K, const Epi& epi, unsigned char* ldsb, int bid, int nb) {
    float* As = (float*)ldsb;
    float* Bs = As + 32 * 68;
    const int tid = threadIdx.x, tm = tid >> 5, tn = tid & 31;
    const int ntn = N / 128, nt = (M / 64) * ntn;
    for (int t = bid; t < nt; t += nb) {
        const int m0 = (t / ntn) * 64, n0 = (t % ntn) * 128;
        float acc[4][4];
#pragma unroll
        for (int i = 0; i < 4; ++i)
#pragma unroll
            for (int j = 0; j < 4; ++j) acc[i][j] = 0.f;
        for (int k0 = 0; k0 < K; k0 += 32) {
            __syncthreads();
            { const int r = tid >> 3, kq = (tid & 7) * 4; const v2u v = *(const v2u*)(A + (size_t)(m0 + r) * lda + k0 + kq);
              As[(kq + 0) * 68 + r] = bflo(v.x); As[(kq + 1) * 68 + r] = bfhi(v.x); As[(kq + 2) * 68 + r] = bflo(v.y); As[(kq + 3) * 68 + r] = bfhi(v.y); }
            { const int r = tid >> 2, kq = (tid & 3) * 8; const v4u v = *(const v4u*)(Bt + (size_t)(n0 + r) * ldb + k0 + kq);
              Bs[(kq + 0) * 132 + r] = bflo(v.x); Bs[(kq + 1) * 132 + r] = bfhi(v.x); Bs[(kq + 2) * 132 + r] = bflo(v.y); Bs[(kq + 3) * 132 + r] = bfhi(v.y);
              Bs[(kq + 4) * 132 + r] = bflo(v.z); Bs[(kq + 5) * 132 + r] = bfhi(v.z); Bs[(kq + 6) * 132 + r] = bflo(v.w); Bs[(kq + 7) * 132 + r] = bfhi(v.w); }
            __syncthreads();
#pragma unroll 8
            for (int k = 0; k < 32; ++k) {
                const f32x4 a = *(const f32x4*)(As + k * 68 + tm * 4), b = *(const f32x4*)(Bs + k * 132 + tn * 4);
#pragma unroll
                for (int i = 0; i < 4; ++i)
#pragma unroll
                    for (int j = 0; j < 4; ++j) acc[i][j] += a[i] * b[j];
            }
        }
#pragma unroll
        for (int i = 0; i < 4; ++i)
#pragma unroll
            for (int j = 0; j < 4; ++j) epi(m0 + tm * 4 + i, n0 + tn * 4 + j, acc[i][j]);
    }
}

struct EpiInNaive {
    float* qkraw; bf16 *V, *U, *GA, *GP;
    __device__ __forceinline__ void operator()(int r, int np, float v) const {
        const int c = win_colmap_inv(np);
        if (c < 1024) qkraw[(size_t)r * 1024 + c] = v;
        else if (c < 1536) V[(size_t)r * 512 + c - 1024] = (bf16)f2bf(v);
        else if (c < 2048) U[(size_t)r * 512 + c - 1536] = (bf16)f2bf(v);
        else if (c < 3072) GA[(size_t)r * 1024 + c - 2048] = (bf16)f2bf(sigmoidf_(v));
        else GP[(size_t)r * 1024 + c - 3072] = (bf16)f2bf(sigmoidf_(v));
    }
};
__device__ __forceinline__ void ph_inproj_naive(const P& p, unsigned char* ldsb, int bid, int nb) {
    EpiInNaive e{p.out, p.V, p.U, p.GA, p.GP};
    gemm_nt_naive(p.XN, DM, p.WIN, DM, MTOK, DIN, DM, e, ldsb, bid, nb);
}
__device__ __forceinline__ void ph_qknorm_naive(const P& p, int bid, int nb) {
    const int tid = threadIdx.x, lane = tid & 63, wave = tid >> 6;
    for (int row = bid * NWAVES + wave; row < MTOK; row += nb * NWAVES) {
        const float* src = p.out + (size_t)row * 1024 + lane * 16;
        float v[16]; float ss = 0.f;
#pragma unroll
        for (int i = 0; i < 16; ++i) { v[i] = src[i]; ss += v[i] * v[i]; }
        ss += __shfl_xor(ss, 1); ss += __shfl_xor(ss, 2);
        const float rstd = rsqrtf(ss * (1.0f / 64.0f) + RMS_EPS);
        const bool isq = lane < 32; const int d0 = (lane & 3) * 16;
        bf16* dst = (isq ? p.Q : p.K) + (size_t)row * 512 + (lane & 31) * 16;
#pragma unroll
        for (int i = 0; i < 16; ++i) { const float g = isq ? p.q_norm_g[d0 + i] * (0.125f * LOG2E) : p.k_norm_g[d0 + i]; dst[i] = (bf16)f2bf(v[i] * rstd * g); }
    }
}

__device__ __forceinline__ float block_max(float v, float* red, int tid) {
    v = wave_max(v); __syncthreads(); if ((tid & 63) == 0) red[tid >> 6] = v; __syncthreads();
    float r = red[0];
#pragma unroll
    for (int i = 1; i < 8; ++i) r = fmaxf(r, red[i]);
    return r;
}
__device__ __forceinline__ float block_sum(float v, float* red, int tid) {
    v = wave_sum(v); __syncthreads(); if ((tid & 63) == 0) red[tid >> 6] = v; __syncthreads();
    float r = 0.f;
#pragma unroll
    for (int i = 0; i < 8; ++i) r += red[i];
    return r;
}
__device__ __forceinline__ void ph_attn_naive(const P& p, unsigned char* ldsb, int bid, int nb) {
    float* sc1 = (float*)ldsb; float* sc2 = sc1 + 8192; float* qs = sc2 + 8192; float* red = qs + 128; float* po = red + 32;
    const int tid = threadIdx.x;
    const float lam = p.miscf[MF_LAM];
    for (int item = bid; item < NB * NHEAD * SEQ; item += nb) {
        const int q = item % SEQ, bh = item / SEQ, h = bh % NHEAD, b = bh / NHEAD;
        const int nk = 64 * (q / 64 + 1);
        const size_t rowq = (size_t)b * SEQ + q;
        __syncthreads();
        if (tid < 128) qs[tid] = bf2f(p.Q[rowq * 512 + h * 128 + tid]);
        __syncthreads();
        float mx1 = -INFINITY, mx2 = -INFINITY;
        for (int j = tid; j < nk; j += NTHR) {
            const bf16* kr = p.K + ((size_t)b * SEQ + j) * 512 + h * 128;
            float s1 = 0.f, s2 = 0.f;
#pragma unroll
            for (int d = 0; d < 64; d += 8) {
                const v4u a = *(const v4u*)(kr + d), c = *(const v4u*)(kr + 64 + d);
                s1 += qs[d] * bflo(a.x) + qs[d + 1] * bfhi(a.x) + qs[d + 2] * bflo(a.y) + qs[d + 3] * bfhi(a.y) + qs[d + 4] * bflo(a.z) + qs[d + 5] * bfhi(a.z) + qs[d + 6] * bflo(a.w) + qs[d + 7] * bfhi(a.w);
                s2 += qs[64 + d] * bflo(c.x) + qs[65 + d] * bfhi(c.x) + qs[66 + d] * bflo(c.y) + qs[67 + d] * bfhi(c.y) + qs[68 + d] * bflo(c.z) + qs[69 + d] * bfhi(c.z) + qs[70 + d] * bflo(c.w) + qs[71 + d] * bfhi(c.w);
            }
            int rel = j - q; if (rel < -256) rel = -256;
            const float bv = p.miscf[MF_BIAS + h * 384 + rel + 256];
            s1 += bv; s2 += bv; sc1[j] = s1; sc2[j] = s2; mx1 = fmaxf(mx1, s1); mx2 = fmaxf(mx2, s2);
        }
        mx1 = block_max(mx1, red, tid); mx2 = block_max(mx2, red, tid);
        float l1 = 0.f, l2 = 0.f;
        for (int j = tid; j < nk; j += NTHR) { const float p1 = exp2f(sc1[j] - mx1), p2 = exp2f(sc2[j] - mx2); sc1[j] = p1; sc2[j] = p2; l1 += p1; l2 += p2; }
        l1 = block_sum(l1, red, tid); l2 = block_sum(l2, red, tid);
        const float i1 = 1.0f / l1, i2 = lam / l2;
        const int d = tid & 127, kq = tid >> 7;
        float o = 0.f;
        const bf16* vb = p.V + (size_t)b * SEQ * 512 + h * 128 + d;
        for (int j = kq; j < nk; j += 4) o += (sc1[j] * i1 - sc2[j] * i2) * bf2f(vb[(size_t)j * 512]);
        po[kq * 128 + d] = o;
        __syncthreads();
        float ov = 0.f, ss = 0.f;
        if (tid < 128) { ov = po[tid] + po[128 + tid] + po[256 + tid] + po[384 + tid]; ss = ov * ov; }
        ss = block_sum(ss, red, tid);
        if (tid < 128) { const float r = rsqrtf(ss * (1.0f / 128.0f) + RMS_EPS); p.AB[rowq * 1024 + h * 128 + tid] = (bf16)f2bf(ov * r * p.subln_g[tid] * (1.0f - LAMBDA_INIT)); }
    }
}
__device__ __forceinline__ void ph_pool_naive(const P& p, unsigned char* ldsb, int bid, int nb) {
    float* mt = (float*)ldsb;
    const int tid = threadIdx.x, i = tid >> 5, c4 = (tid & 31) * 4;
    for (int item = bid; item < (MTOK / 16) * 4; item += nb) {
        const int rb = item >> 2, g = item & 3, w = 2 << g;
        const int r = rb * 16 + i, t = r % SEQ;
        __syncthreads();
#pragma unroll
        for (int cc = 0; cc < 4; ++cc) { const int c = c4 + cc; float s = 0.f;
            for (int jj = 0; jj < w; ++jj) if (t - jj >= 0) s += bf2f(p.U[(size_t)(r - jj) * 512 + g * 128 + c]);
            const float cnt = (float)(t + 1 < w ? t + 1 : w);
            mt[i * 128 + c] = s / cnt - bf2f(p.U[(size_t)r * 512 + g * 128 + c]); }
        __syncthreads();
#pragma unroll
        for (int dd = 0; dd < 4; ++dd) { const int d = c4 + dd; float a = 0.f;
            for (int c = 0; c < 128; ++c) a += mt[i * 128 + c] * p.pool_w[(size_t)(g * 128 + c) * 128 + d];
            p.AB[(size_t)r * 1024 + 512 + g * 128 + d] = (bf16)f2bf(a * p.pool_scale[g * 128 + d]); }
    }
}

struct EpiBrA { bf16* MG; const bf16* GA; __device__ __forceinline__ void operator()(int r, int c, float v) const { MG[(size_t)r * 1024 + c] = (bf16)f2bf(bf2f(GA[(size_t)r * 1024 + c]) * v); } };
struct EpiBrB { bf16* MG; const bf16* GP; __device__ __forceinline__ void operator()(int r, int c, float v) const { MG[(size_t)r * 1024 + c] = (bf16)f2bf(bf2f(MG[(size_t)r * 1024 + c]) + bf2f(GP[(size_t)r * 1024 + c]) * v); } };
__device__ __forceinline__ void ph_branch_naive(const P& p, unsigned char* ldsb, int bid, int nb) {
    EpiBrA ea{p.XN, p.GA}; gemm_nt_naive(p.AB, 1024, p.WBR, 1024, MTOK, DM, 512, ea, ldsb, bid, nb);
    __syncthreads();
    EpiBrB eb{p.XN, p.GP}; gemm_nt_naive(p.AB + 512, 1024, p.WBR + 512, 1024, MTOK, DM, 512, eb, ldsb, bid, nb);
}
struct EpiOutNaive { const float* x; const float* mod; float* out; __device__ __forceinline__ void operator()(int r, int c, float v) const {
    const int b = r / SEQ; out[(size_t)r * 1024 + c] = x[(size_t)r * 1024 + c] + mod[b * 6144 + 2048 + c] * v; } };
__device__ __forceinline__ void ph_wout_naive(const P& p, unsigned char* ldsb, int bid, int nb) {
    EpiOutNaive e{p.x, p.miscf + MF_MOD, p.out}; gemm_nt_naive(p.XN, 1024, p.WOUT, 1024, MTOK, DM, DM, e, ldsb, bid, nb);
}

__device__ __forceinline__ void ph_norm2_route(const P& p, unsigned char* ldsb, int bid, int nb) {
    const int tid = threadIdx.x, lane = tid & 63, wave = tid >> 6;
    float* la = (float*)ldsb; float* ls = la + 1024; float* wr = ls + 1024;
    for (int i = tid; i < 1024 * 20; i += NTHR) { const int o = i / 1024, c = i % 1024; wr[i] = o < 4 ? p.rgw[c * 4 + o] : p.rew[c * 16 + o - 4]; }
    for (int rb = bid; rb < 256; rb += nb) {
        const int b = rb / 128;
        __syncthreads();
        for (int c = tid; c < 1024; c += NTHR) { la[c] = p.norm2_g[c] * (1.0f + p.miscf[MF_MOD + b * 6144 + 4096 + c]); ls[c] = p.miscf[MF_MOD + b * 6144 + 3072 + c]; }
        __syncthreads();
#pragma unroll 1
        for (int i = 0; i < 8; ++i) {
            const int row = rb * 64 + wave * 8 + i;
            const f32x4* xr = (const f32x4*)(p.out + (size_t)row * DM) + lane;
            f32x4 v[4]; float ss = 0.f;
#pragma unroll
            for (int j = 0; j < 4; ++j) { v[j] = xr[64 * j]; ss += v[j].x * v[j].x + v[j].y * v[j].y + v[j].z * v[j].z + v[j].w * v[j].w; }
            const float rstd = rsqrtf(wave_sum(ss) * (1.0f / DM) + RMS_EPS);
            v2u* o = (v2u*)(p.XN + (size_t)row * DM) + lane;
#pragma unroll
            for (int j = 0; j < 4; ++j) { const int c = (64 * j + lane) * 4; const f32x4 a = *(const f32x4*)(la + c), s = *(const f32x4*)(ls + c);
                f32x4 hh; hh.x = v[j].x * rstd * a.x + s.x; hh.y = v[j].y * rstd * a.y + s.y; hh.z = v[j].z * rstd * a.z + s.z; hh.w = v[j].w * rstd * a.w + s.w;
                v2u w; w.x = pk2(hh.x, hh.y); w.y = pk2(hh.z, hh.w); o[64 * j] = w; v[j] = hh; }
            float mylg = 0.f;
#pragma unroll 1
            for (int oo = 0; oo < 20; ++oo) { float s = 0.f;
#pragma unroll
                for (int j = 0; j < 4; ++j) { const f32x4 w = *(const f32x4*)(wr + oo * 1024 + (64 * j + lane) * 4); s += v[j].x * w.x + v[j].y * w.y + v[j].z * w.z + v[j].w * w.w; }
                s = wave_sum(s); mylg = (lane == oo) ? s : mylg; }
            float lg[20];
#pragma unroll
            for (int k = 0; k < 20; ++k) lg[k] = __shfl(mylg, k);
            if (lane == 0) {
                const float g0 = lg[0] + p.rgb[0], g1 = lg[1] + p.rgb[1], g2 = lg[2] + p.rgb[2], g3 = lg[3] + p.rgb[3];
                int gi = 0; float gm = g0;
                if (g1 > gm) { gm = g1; gi = 1; } if (g2 > gm) { gm = g2; gi = 2; } if (g3 > gm) { gm = g3; gi = 3; }
                const float gval = 1.0f / (__expf(g0 - gm) + __expf(g1 - gm) + __expf(g2 - gm) + __expf(g3 - gm));
                float el[4];
#pragma unroll
                for (int k = 0; k < 4; ++k) { float t = 0.f;
#pragma unroll
                    for (int gg = 0; gg < 4; ++gg) t = (gg == gi) ? lg[4 + gg * 4 + k] + p.reb[gg * 4 + k] : t;
                    el[k] = t; }
                int i0 = 0; float m0 = el[0];
#pragma unroll
                for (int k = 1; k < 4; ++k) if (el[k] > m0) { m0 = el[k]; i0 = k; }
                int i1 = 0; float m1 = -INFINITY;
#pragma unroll
                for (int k = 0; k < 4; ++k) if (k != i0 && el[k] > m1) { m1 = el[k]; i1 = k; }
                const float e1 = __expf(m1 - m0);
                const float w0 = gval / (1.0f + e1), w1 = gval * e1 / (1.0f + e1);
                const int x0 = gi * 4 + i0, x1 = gi * 4 + i1;
                const unsigned p0 = atomicAdd(p.ctl + CW_CNT + x0, 1u), p1 = atomicAdd(p.ctl + CW_CNT + x1, 1u);
                { uint2 l0; l0.x = (unsigned)row; l0.y = __float_as_uint(w0); *(uint2*)(p.list + ((size_t)x0 * MTOK + p0) * 2) = l0; uint2 l1; l1.x = (unsigned)row; l1.y = __float_as_uint(w1); *(uint2*)(p.list + ((size_t)x1 * MTOK + p1) * 2) = l1; }
                int4 ri; ri.x = x0 | (x1 << 8); ri.y = (int)(p0 | (p1 << 16)); ri.z = __float_as_int(w0); ri.w = __float_as_int(w1); *(int4*)(p.route + (size_t)row * 4) = ri;
            }
        }
    }
}

__device__ __forceinline__ void moe_offsets(const P& p, int* arr) {
    __syncthreads();
    if (threadIdx.x == 0) { int o = 0;
        for (int e = 0; e < NEXP; ++e) { const int n = (int)__hip_atomic_load(p.ctl + CW_CNT + e, __ATOMIC_RELAXED, __HIP_MEMORY_SCOPE_AGENT); arr[e] = n; arr[16 + e] = o; arr[33 + e] = o >> 8; o += (n + 255) & ~255; }
        arr[32] = o; arr[33 + 16] = o >> 8; }
    __syncthreads();
}
__device__ __forceinline__ void ph_moe1_naive(const P& p, unsigned char* ldsb, int bid, int nb) {
    float* hs = (float*)ldsb;
    const int tid = threadIdx.x;
    int* cnt = (int*)(ldsb + 65536); int* off = cnt + 16; moe_offsets(p, cnt);
#pragma unroll 1
    for (int e = 0; e < NEXP; ++e) {
        const int n = cnt[e];
#pragma unroll 1
        for (int pb = bid; pb * 8 < n; pb += nb) {
            __syncthreads();
            for (int idx = tid; idx < 8 * 128; idx += NTHR) { const int s = idx >> 7, ch = idx & 127, pos = pb * 8 + s;
                if (pos < n) { const unsigned tok = p.list[((size_t)e * MTOK + pos) * 2]; const v4u v = *(const v4u*)(p.XN + (size_t)tok * 1024 + ch * 8);
                    float* d = hs + s * 1024 + ch * 8; d[0] = bflo(v.x); d[1] = bfhi(v.x); d[2] = bflo(v.y); d[3] = bfhi(v.y); d[4] = bflo(v.z); d[5] = bfhi(v.z); d[6] = bflo(v.w); d[7] = bfhi(v.w); }
                else { float* d = hs + s * 1024 + ch * 8;
#pragma unroll
                    for (int q = 0; q < 8; ++q) d[q] = 0.f; } }
            __syncthreads();
            const int j = tid;
            const bf16* gr = p.W1 + (size_t)e * 1024 * 1024 + (size_t)(256 * (j >> 7) + (j & 127)) * 1024; const bf16* ur = gr + 128 * 1024;
            float ag[8], au[8];
#pragma unroll
            for (int s = 0; s < 8; ++s) { ag[s] = 0.f; au[s] = 0.f; }
            for (int k = 0; k < 1024; k += 8) {
                const v4u g = *(const v4u*)(gr + k), u = *(const v4u*)(ur + k);
                const float gf[8] = {bflo(g.x), bfhi(g.x), bflo(g.y), bfhi(g.y), bflo(g.z), bfhi(g.z), bflo(g.w), bfhi(g.w)};
                const float uf[8] = {bflo(u.x), bfhi(u.x), bflo(u.y), bfhi(u.y), bflo(u.z), bfhi(u.z), bflo(u.w), bfhi(u.w)};
#pragma unroll
                for (int s = 0; s < 8; ++s) {
#pragma unroll
                    for (int q = 0; q < 8; ++q) { const float hv = hs[s * 1024 + k + q]; ag[s] += hv * gf[q]; au[s] += hv * uf[q]; } }
            }
#pragma unroll
            for (int s = 0; s < 8; ++s) { const int pos = pb * 8 + s; if (pos < n) p.HID[(size_t)(off[e] + pos) * 512 + j] = (bf16)f2bf(siluf_(ag[s]) * au[s]); }
        }
    }
}
__device__ __forceinline__ void ph_moe2_naive(const P& p, unsigned char* ldsb, int bid, int nb) {
    float* hs = (float*)ldsb;
    const int tid = threadIdx.x;
    int* cnt = (int*)(ldsb + 65536); int* off = cnt + 16; moe_offsets(p, cnt);
#pragma unroll 1
    for (int e = 0; e < NEXP; ++e) {
        const int n = cnt[e];
#pragma unroll 1
        for (int pb = bid; pb * 8 < n; pb += nb) {
            __syncthreads();
            { const int s = tid >> 6, ch = tid & 63, pos = pb * 8 + s; float* d = hs + s * 512 + ch * 8;
                if (pos < n) { const v4u v = *(const v4u*)(p.HID + (size_t)(off[e] + pos) * 512 + ch * 8);
                    d[0] = bflo(v.x); d[1] = bfhi(v.x); d[2] = bflo(v.y); d[3] = bfhi(v.y); d[4] = bflo(v.z); d[5] = bfhi(v.z); d[6] = bflo(v.w); d[7] = bfhi(v.w); }
                else {
#pragma unroll
                    for (int q = 0; q < 8; ++q) d[q] = 0.f; } }
            __syncthreads();
#pragma unroll 1
            for (int half = 0; half < 2; ++half) {
                const int nn = tid + half * 512;
                const bf16* wr = p.W2 + (size_t)e * 1024 * 512 + (size_t)nn * 512;
                float a[8];
#pragma unroll
                for (int s = 0; s < 8; ++s) a[s] = 0.f;
                for (int k = 0; k < 512; k += 8) {
                    const v4u g = *(const v4u*)(wr + k);
                    const float gf[8] = {bflo(g.x), bfhi(g.x), bflo(g.y), bfhi(g.y), bflo(g.z), bfhi(g.z), bflo(g.w), bfhi(g.w)};
#pragma unroll
                    for (int s = 0; s < 8; ++s) {
#pragma unroll
                        for (int q = 0; q < 8; ++q) a[s] += hs[s * 512 + k + q] * gf[q]; }
                }
#pragma unroll
                for (int s = 0; s < 8; ++s) { const int pos = pb * 8 + s; if (pos < n) { const float w = __uint_as_float(p.list[((size_t)e * MTOK + pos) * 2 + 1]);
                    p.Y[(size_t)(off[e] + pos) * 1024 + nn] = (bf16)f2bf(a[s] * w); } }
            }
        }
    }
}
__device__ __forceinline__ void ph_combine(const P& p, unsigned char* ldsb, int bid, int nb) {
    const int tid = threadIdx.x, lane = tid & 63, wave = tid >> 6;
    int* cnt = (int*)ldsb; int* off = cnt + 16; moe_offsets(p, cnt);
    for (int row = bid * NWAVES + wave; row < MTOK; row += nb * NWAVES) {
        const int4 ri = *(const int4*)(p.route + (size_t)row * 4);
        const size_t s0 = (size_t)(off[ri.x & 0xff] + (ri.y & 0xffff)), s1 = (size_t)(off[(ri.x >> 8) & 0xff] + ((ri.y >> 16) & 0xffff));
        const int b = row / SEQ;
        const float* g2 = p.miscf + MF_MOD + b * 6144 + 5120;
        f32x4* xo = (f32x4*)(p.out + (size_t)row * DM) + lane;
        const v2u* y0 = (const v2u*)(p.Y + s0 * 1024) + lane; const v2u* y1 = (const v2u*)(p.Y + s1 * 1024) + lane;
#pragma unroll
        for (int j = 0; j < 4; ++j) { const int c = (64 * j + lane) * 4; const f32x4 g = *(const f32x4*)(g2 + c); f32x4 v = xo[64 * j]; const v2u a = y0[64 * j], d = y1[64 * j];
            v.x += g.x * (bflo(a.x) + bflo(d.x)); v.y += g.y * (bfhi(a.x) + bfhi(d.x)); v.z += g.z * (bflo(a.y) + bflo(d.y)); v.w += g.w * (bfhi(a.y) + bfhi(d.y)); xo[64 * j] = v; }
    }
}


namespace att {
typedef short bf16x8 __attribute__((ext_vector_type(8)));
typedef short s16x4 __attribute__((ext_vector_type(4)));
typedef float f32x16 __attribute__((ext_vector_type(16)));
typedef unsigned u32x4 __attribute__((ext_vector_type(4)));
constexpr int NSLOT = 3, SLOTB = 16384;
constexpr int LDS_K = 0, LDS_V = NSLOT * SLOTB, LDS_BT = 2 * NSLOT * SLOTB, LDS_WS = LDS_BT + 1536, LDS_END = LDS_WS + 8 * 256;
constexpr int XROW = 132;
__device__ __forceinline__ int crow(int r, int hi) { return (r & 3) + 8 * (r >> 2) + 4 * hi; }
__device__ __forceinline__ s16x4 vtr(const LAS unsigned char* p) { typedef short v4i16_t __attribute__((ext_vector_type(4))); return __builtin_bit_cast(s16x4, __builtin_amdgcn_ds_read_tr16_b64_v4i16((LAS v4i16_t*)p)); }
#define ATT_WAIT_BAR(N) asm volatile("s_waitcnt vmcnt(" #N ") lgkmcnt(0)\n\ts_barrier" ::: "memory")

__device__ __forceinline__ void attn_unit(const P& p, LAS unsigned char* lds, int b, int h, int qb) {
    const int tid = threadIdx.x, lane = tid & 63, r32 = lane & 31, hi = lane >> 5;
    const int wid = __builtin_amdgcn_readfirstlane(tid >> 6), qg = wid & 3, mp = wid >> 2;
    const size_t rowbase = (size_t)b * SEQ;
    const int q0w = qb * 128 + qg * 32;
    const int NT = 2 * qb + 2, myNT = NT - (qg < 2 ? 1 : 0);
    LAS float* bt = (LAS float*)(lds + LDS_BT);
    for (int i = tid; i < 384; i += NTHR) bt[i] = p.miscf[MF_BIAS + h * 384 + i];
    const float cfar = p.miscf[MF_BIAS + h * 384];
    bf16x8 qr[4];
    { const bf16* Qw = p.Q + (rowbase + q0w + r32) * 512 + h * 128 + mp * 64 + hi * 8;
#pragma unroll
      for (int d0 = 0; d0 < 4; ++d0) qr[d0] = *(const bf16x8*)(Qw + d0 * 16); }
    const bf16* ksrc = p.K + (rowbase + lane) * 512 + h * 128 + (2 * wid) * 8;
    const bf16* vsrc = p.V + (rowbase + 16 * (wid & 3) + (lane >> 2)) * 512 + h * 128 + (wid >> 2) * 32 + (lane & 3) * 8;
    const unsigned kdst = LDS_K + (2 * wid) * 1024, vdst = LDS_V + (wid >> 2) * 4096 + (wid & 3) * 1024;
#define ATT_ISSUE(t, so) do { const size_t go_ = (size_t)(t) * 64 * 512; const unsigned so_ = (unsigned)__builtin_amdgcn_readfirstlane(so); \
        __builtin_amdgcn_global_load_lds((const unsigned*)(ksrc + go_), (LAS unsigned*)(lds + kdst + so_), 16, 0, 0); \
        __builtin_amdgcn_global_load_lds((const unsigned*)(ksrc + go_ + 8), (LAS unsigned*)(lds + kdst + 1024 + so_), 16, 0, 0); \
        __builtin_amdgcn_global_load_lds((const unsigned*)(vsrc + go_), (LAS unsigned*)(lds + vdst + so_), 16, 0, 0); \
        __builtin_amdgcn_global_load_lds((const unsigned*)(vsrc + go_ + 64), (LAS unsigned*)(lds + vdst + 8192 + so_), 16, 0, 0); } while (0)
    ATT_ISSUE(0, 0); ATT_ISSUE(1, SLOTB);
    f32x16 o[4];
#pragma unroll
    for (int d0 = 0; d0 < 4; ++d0) o[d0] = (f32x16){0.f, 0.f, 0.f, 0.f, 0.f, 0.f, 0.f, 0.f, 0.f, 0.f, 0.f, 0.f, 0.f, 0.f, 0.f, 0.f};
    float l_reg = 0.f;
    const LAS unsigned char* kp0 = lds + LDS_K + mp * 8192 + hi * 1024 + r32 * 16;
    const LAS unsigned char* vp0 = lds + LDS_V + ((lane >> 4) & 1) * 32 + (lane & 3) * 8 + (4 * hi + ((lane & 15) >> 2)) * 64;
    int slot = 0;
#pragma unroll 1
    for (int t = 0; t < NT; ++t) {
        if (t + 1 < NT) { ATT_WAIT_BAR(4); } else { ATT_WAIT_BAR(0); }
        { const int s2 = slot == 0 ? 2 * SLOTB : slot - SLOTB;
          if (t + 2 < NT) ATT_ISSUE(t + 2, s2); }
        if (t < myNT) {
            const LAS unsigned char* kp = kp0 + slot; const LAS unsigned char* vp = vp0 + slot;
            const bool nearb = (t * 64 + 63 - q0w) > -91;
            const float ci = nearb ? 0.f : cfar;
            f32x16 c0, c1;
#pragma unroll
            for (int r = 0; r < 16; ++r) { c0[r] = ci; c1[r] = ci; }
#pragma unroll
            for (int d0 = 0; d0 < 4; ++d0) {
                const bf16x8 k0 = *(const LAS bf16x8*)(kp + d0 * 2048), k1 = *(const LAS bf16x8*)(kp + d0 * 2048 + 512);
                c0 = __builtin_amdgcn_mfma_f32_32x32x16_bf16(k0, qr[d0], c0, 0, 0, 0);
                c1 = __builtin_amdgcn_mfma_f32_32x32x16_bf16(k1, qr[d0], c1, 0, 0, 0);
            }
            if (nearb) {
                const LAS float* bp = bt + (t * 64 - q0w - r32 + 256 + 4 * hi);
#pragma unroll
                for (int r = 0; r < 16; ++r) { const int cr = (r & 3) + 8 * (r >> 2); c0[r] += bp[cr]; c1[r] += bp[cr + 32]; }
            }
            float sacc = 0.f;
#pragma unroll
            for (int r = 0; r < 16; ++r) { c0[r] = __builtin_amdgcn_exp2f(c0[r]); c1[r] = __builtin_amdgcn_exp2f(c1[r]); sacc += c0[r] + c1[r]; }
            l_reg += sacc;
            u32x4 pw[4];
#pragma unroll
            for (int j = 0; j < 4; ++j) { pw[0][j] = pg8::cvt_pk_bf16(c0[2 * j], c0[2 * j + 1]); pw[1][j] = pg8::cvt_pk_bf16(c0[8 + 2 * j], c0[9 + 2 * j]);
                                          pw[2][j] = pg8::cvt_pk_bf16(c1[2 * j], c1[2 * j + 1]); pw[3][j] = pg8::cvt_pk_bf16(c1[8 + 2 * j], c1[9 + 2 * j]); }
#pragma unroll
            for (int d0 = 0; d0 < 4; ++d0)
#pragma unroll
                for (int ks = 0; ks < 4; ++ks) {
                    const s16x4 lo = vtr(vp + d0 * 4096 + ks * 1024), hh = vtr(vp + d0 * 4096 + ks * 1024 + 512);
                    const bf16x8 vf = (bf16x8){lo[0], lo[1], lo[2], lo[3], hh[0], hh[1], hh[2], hh[3]};
                    o[d0] = __builtin_amdgcn_mfma_f32_32x32x16_bf16(__builtin_bit_cast(bf16x8, pw[ks]), vf, o[d0], 0, 0, 0);
                }
        }
        slot = slot == 2 * SLOTB ? 0 : slot + SLOTB;
    }
#undef ATT_ISSUE
    l_reg += __shfl_xor(l_reg, 32);
    LAS float* wsf = (LAS float*)(lds + LDS_WS) + wid * 64;
    { const float lam = p.miscf[MF_LAM]; if (hi == 0) wsf[r32] = (mp == 0 ? 1.0f : lam) / l_reg; }
    asm volatile("s_waitcnt lgkmcnt(0)" ::: "memory");
#pragma unroll
    for (int r = 0; r < 16; ++r) { const float f = wsf[crow(r, hi)];
#pragma unroll
        for (int d0 = 0; d0 < 4; ++d0) o[d0][r] *= f; }
    ATT_WAIT_BAR(0);
    LAS float* X = (LAS float*)lds + qg * 32 * XROW;
    if (mp == 1) {
#pragma unroll
        for (int d0 = 0; d0 < 4; ++d0)
#pragma unroll
            for (int r = 0; r < 16; ++r) X[crow(r, hi) * XROW + d0 * 32 + r32] = o[d0][r];
    }
    ATT_WAIT_BAR(0);
    if (mp == 0) {
#pragma unroll
        for (int d0 = 0; d0 < 4; ++d0)
#pragma unroll
            for (int r = 0; r < 16; ++r) { LAS float* xp = X + crow(r, hi) * XROW + d0 * 32 + r32; *xp = o[d0][r] - *xp; }
        asm volatile("s_waitcnt lgkmcnt(0)" ::: "memory");
        const int row = lane >> 1, half = lane & 1;
        const LAS float* xr = X + row * XROW + half * 64;
        f32x4 v[16]; float ss = 0.f;
#pragma unroll
        for (int i = 0; i < 16; ++i) { v[i] = *(const LAS f32x4*)(xr + 4 * i); ss += v[i].x * v[i].x + v[i].y * v[i].y + v[i].z * v[i].z + v[i].w * v[i].w; }
        ss += __shfl_xor(ss, 1);
        const float rs = __builtin_amdgcn_rsqf(ss * (1.0f / 128.0f) + RMS_EPS) * (1.0f - LAMBDA_INIT);
        const float* gp = p.subln_g + half * 64;
        bf16* op = p.AB + (rowbase + q0w + row) * 1024 + h * 128 + half * 64;
#pragma unroll
        for (int i = 0; i < 8; ++i) { const f32x4 g0 = *(const f32x4*)(gp + 8 * i), g1 = *(const f32x4*)(gp + 8 * i + 4); const f32x4 a = v[2 * i] * rs * g0, c = v[2 * i + 1] * rs * g1;
            u32x4 w; w.x = pg8::cvt_pk_bf16(a.x, a.y); w.y = pg8::cvt_pk_bf16(a.z, a.w); w.z = pg8::cvt_pk_bf16(c.x, c.y); w.w = pg8::cvt_pk_bf16(c.z, c.w); *(u32x4*)(op + 8 * i) = w; }
    }
    ATT_WAIT_BAR(0);
}
#undef ATT_WAIT_BAR
}
__device__ __forceinline__ void ph_attn(const P& p, LAS unsigned char* lds, int bid, int nb) {
    const int vcu = (bid % 8) * (nb / 8) + bid / 8;
    for (int v = vcu; v < 256; v += nb) {
        const int bh = v >> 5, s = v & 31;
        att::attn_unit(p, lds, bh >> 2, bh & 3, 63 - s);
        att::attn_unit(p, lds, bh >> 2, bh & 3, s);
    }
}


__device__ __forceinline__ void ph_pool(const P& p, int bid, int nb) {
    const int tid = threadIdx.x, lane = tid & 63, wave = tid >> 6;
    const int g = lane >> 4, w = 2 << g;
    for (int row = bid * NWAVES + wave; row < MTOK; row += nb * NWAVES) {
        const int t = row % SEQ, cnt = t + 1 < w ? t + 1 : w;
        const bf16* up = p.U + (size_t)row * 512 + lane * 8;
        float s[8];
#pragma unroll
        for (int q = 0; q < 8; ++q) s[q] = 0.f;
        v4u cur = *(const v4u*)up;
        for (int jj = 0; jj < cnt; ++jj) { const v4u v = *(const v4u*)(up - (size_t)jj * 512);
            s[0] += bflo(v.x); s[1] += bfhi(v.x); s[2] += bflo(v.y); s[3] += bfhi(v.y); s[4] += bflo(v.z); s[5] += bfhi(v.z); s[6] += bflo(v.w); s[7] += bfhi(v.w); }
        const float ic = 1.0f / (float)cnt;
        v4u o; o.x = pk2(s[0] * ic - bflo(cur.x), s[1] * ic - bfhi(cur.x)); o.y = pk2(s[2] * ic - bflo(cur.y), s[3] * ic - bfhi(cur.y));
        o.z = pk2(s[4] * ic - bflo(cur.z), s[5] * ic - bfhi(cur.z)); o.w = pk2(s[6] * ic - bflo(cur.w), s[7] * ic - bfhi(cur.w));
        *(v4u*)(p.AB + (size_t)row * 1024 + 512 + lane * 8) = o;
    }
}

struct BranchOrder {
    pg8::StaticOrder so;
    __device__ bool next(int i, pg8::Unit& u) const { if (!so.tile((long)(i >> 1) * so.G + so.c, u)) return false; u.aux = i & 1; u.a_off += (unsigned)(i & 1) * 1024u; u.b_off += (unsigned)(i & 1) * 1024u; return true; }
    __device__ unsigned row_off(const pg8::Unit&, int) const { return 0u; }
};
__device__ __forceinline__ void ph_inproj(const P& p, LAS unsigned char* lds, int bid, int nb) {
    pg8::Gemm g{p.XN, p.WIN, 1024, 1024, 16};
    pg8::StaticOrder S; S.init(MTOK, DIN, 1024, 1024, nb, bid);
    pg8::EpiIn E{p.Q, p.K, p.V, p.U, p.GA, p.GP, p.q_norm_g, p.k_norm_g};
    pg8::gemm_phase<pg8::EpiIn, pg8::StaticOrder, false>(lds, g, S, E);
}
__device__ __forceinline__ void ph_branch(const P& p, LAS unsigned char* lds, int bid, int nb) {
    pg8::Gemm g{p.AB, p.WBR, 1024, 1024, 8};
    BranchOrder S; S.so.init(MTOK, DM, 1024, 1024, nb, bid);
    pg8::EpiBranch E{p.XN, p.GA, p.GP};
    pg8::gemm_phase<pg8::EpiBranch, BranchOrder, false>(lds, g, S, E);
}
__device__ __forceinline__ void ph_wout(const P& p, LAS unsigned char* lds, int bid, int nb) {
    pg8::Gemm g{p.XN, p.WOUT, 1024, 1024, 16};
    pg8::StaticOrder S; S.init(MTOK, DM, 1024, 1024, nb, bid);
    pg8::EpiOut E{p.x, p.miscf + MF_MOD, p.out};
    pg8::gemm_phase<pg8::EpiOut, pg8::StaticOrder, false>(lds, g, S, E);
}


struct MoeOrder {
    const LAS int* arr; const unsigned* list; int G, vcu, npn; unsigned bstride, tB, tA;
    __device__ bool next(int i, pg8::Unit& u) const {
        const int L = i * G + vcu, T = arr[33 + 16]; if (L >= T * npn) return false;
        const int tile = L / npn, pn = L % npn; int e = 0;
#pragma unroll
        for (int k = 1; k < 16; ++k) e += (arr[33 + k] <= tile) ? 1 : 0;
        const int mt = tile - arr[33 + e];
        u.aux = e; u.pn = pn; u.pm = tile; u.n = arr[e]; u.pos0 = mt * 256; u.a_off = (unsigned)tile * tA; u.b_off = (unsigned)e * bstride + (unsigned)pn * tB; return true;
    }
    __device__ unsigned row_off(const pg8::Unit& u, int r) const { int pos = u.pos0 + r; pos = pos < u.n ? pos : u.n - 1; return list[((size_t)u.aux * 16384 + pos) * 2] * 2048u; }
};
__device__ __forceinline__ void ph_moe1(const P& p, LAS unsigned char* lds, unsigned char* ldsg, int bid, int nb) {
    int* arr = (int*)(ldsg + 131072); moe_offsets(p, arr);
    pg8::Gemm g{p.XN, p.W1, 1024, 1024, 16};
    MoeOrder S{(const LAS int*)(lds + 131072), p.list, nb, (bid % 8) * (nb / 8) + bid / 8, 4, 1024u * 1024u * 2u, 256u * 1024u * 2u, 0u};
    pg8::EpiMoe1 E{p.HID};
    pg8::gemm_phase<pg8::EpiMoe1, MoeOrder, true>(lds, g, S, E);
}
__device__ __forceinline__ void ph_moe2(const P& p, LAS unsigned char* lds, unsigned char* ldsg, int bid, int nb) {
    int* arr = (int*)(ldsg + 131072); moe_offsets(p, arr);
    pg8::Gemm g{p.HID, p.W2, 512, 512, 8};
    MoeOrder S{(const LAS int*)(lds + 131072), p.list, nb, (bid % 8) * (nb / 8) + bid / 8, 4, 1024u * 512u * 2u, 256u * 512u * 2u, 256u * 512u * 2u};
    pg8::EpiMoe2 E{p.Y, p.list};
    pg8::gemm_phase<pg8::EpiMoe2, MoeOrder, false>(lds, g, S, E);
}

constexpr int N_PHASES = 11;
__global__ void __launch_bounds__(NTHR, 2) mega_fwd(Args args) {
    extern __shared__ __attribute__((aligned(16))) unsigned char lds[];
    P p;
    p.x = args.in[0]; p.c = args.in[1]; p.rel_bias = args.in[2]; p.ada_w = args.in[3]; p.ada_b = args.in[4]; p.norm1_g = args.in[5]; p.w_in = args.in[6]; p.q_norm_g = args.in[7]; p.k_norm_g = args.in[8];
    p.lq1 = args.in[9]; p.lk1 = args.in[10]; p.lq2 = args.in[11]; p.lk2 = args.in[12]; p.subln_g = args.in[13]; p.wba = args.in[14]; p.pool_w = args.in[15]; p.pool_scale = args.in[16]; p.wbp = args.in[17];
    p.w_out = args.in[18]; p.norm2_g = args.in[19]; p.rgw = args.in[20]; p.rgb = args.in[21]; p.rew = args.in[22]; p.reb = args.in[23]; p.wgate = args.in[24]; p.wup = args.in[25]; p.wdown = args.in[26];
    p.out = args.out; p.ws = args.ws;
    unsigned char* ws = args.ws;
    p.ctl = (unsigned*)(ws + WS_CTL); p.miscf = (float*)(ws + WS_MISC); p.list = (unsigned*)(ws + WS_LIST); p.route = (int*)(ws + WS_ROUTE);
    p.WIN = (bf16*)(ws + WS_WIN); p.WBR = (bf16*)(ws + WS_WBR); p.WOUT = (bf16*)(ws + WS_WOUT); p.W1 = (bf16*)(ws + WS_W1); p.W2 = (bf16*)(ws + WS_W2);
    p.XN = (bf16*)(ws + WS_XN); p.Q = (bf16*)(ws + WS_Q); p.K = (bf16*)(ws + WS_K); p.V = (bf16*)(ws + WS_V); p.U = (bf16*)(ws + WS_U); p.GA = (bf16*)(ws + WS_GA); p.GP = (bf16*)(ws + WS_GP);
    p.AB = (bf16*)(ws + WS_AB); p.HID = (bf16*)(ws + WS_HID); p.Y = (bf16*)(ws + WS_Y);
    const int bid = blockIdx.x, nb = gridDim.x;
    const int lo = args.ph_lo, hi = args.ph_hi;
    volatile LAS unsigned* MISC = (volatile LAS unsigned*)((LAS unsigned char*)lds + LDS_BYTES - 64);
    XcdBarrier bar; bar.bar = p.ctl + CW_BAR; bar.x = 0; bar.st = nullptr;
    if (hi - lo > 1) {
        if (threadIdx.x < 2) MISC[threadIdx.x] = 0u;
        __syncthreads();
        bar = xcd_barrier_post(p.ctl + CW_BAR, MISC);
    }
#ifndef PHASE_MASK
#define PHASE_MASK 0xFFFF
#endif
#define IN(k) (((PHASE_MASK >> (k)) & 1) && lo <= (k) && (k) < hi)
#define SEAM(k) do { if (IN(k) && IN((k) + 1)) xcd_barrier(bar); } while (0)
    if (IN(0)) { for (int rp = 0; rp < NREP(0); ++rp) { ph_prologue(p, lds, bid, nb); __syncthreads(); } } SEAM(0);
    if (IN(1)) { for (int rp = 0; rp < NREP(1); ++rp) { ph_norm1(p, lds, bid, nb); __syncthreads(); } } SEAM(1);
#if FAST_INPROJ == 2
    if (IN(2)) { ph_inproj_naive(p, lds, bid, nb); } SEAM(2);
    if (IN(3)) { ph_qknorm_naive(p, bid, nb); __syncthreads(); ph_inproj(p, (LAS unsigned char*)lds, bid, nb); } SEAM(3);
#elif FAST_INPROJ
    if (IN(2)) { for (int rp = 0; rp < NREP(2); ++rp) ph_inproj(p, (LAS unsigned char*)lds, bid, nb); } SEAM(2);
#else
    if (IN(2)) { ph_inproj_naive(p, lds, bid, nb); } SEAM(2);
    if (IN(3)) { ph_qknorm_naive(p, bid, nb); } SEAM(3);
#endif
#if FAST_ATTN
    if (IN(4)) { for (int rp = 0; rp < NREP(4); ++rp) ph_attn(p, (LAS unsigned char*)lds, bid, nb); __syncthreads(); for (int rp = 0; rp < NREP(11); ++rp) { ph_pool(p, bid, nb); } } SEAM(4);
#else
    if (IN(4)) { ph_attn_naive(p, lds, bid, nb); __syncthreads(); ph_pool_naive(p, lds, bid, nb); } SEAM(4);
#endif
#if FAST_BRANCH
    if (IN(5)) { for (int rp = 0; rp < NREP(5); ++rp) ph_branch(p, (LAS unsigned char*)lds, bid, nb); } SEAM(5);
#else
    if (IN(5)) { ph_branch_naive(p, lds, bid, nb); } SEAM(5);
#endif
#if FAST_WOUT
    if (IN(6)) { for (int rp = 0; rp < NREP(6); ++rp) ph_wout(p, (LAS unsigned char*)lds, bid, nb); } SEAM(6);
#else
    if (IN(6)) { ph_wout_naive(p, lds, bid, nb); } SEAM(6);
#endif
    if (IN(7)) { ph_norm2_route(p, lds, bid, nb); } SEAM(7);
#if FAST_MOE
    if (IN(8)) { for (int rp = 0; rp < NREP(8); ++rp) ph_moe1(p, (LAS unsigned char*)lds, lds, bid, nb); } SEAM(8);
    if (IN(9)) { for (int rp = 0; rp < NREP(9); ++rp) ph_moe2(p, (LAS unsigned char*)lds, lds, bid, nb); } SEAM(9);
#else
    if (IN(8)) { ph_moe1_naive(p, lds, bid, nb); } SEAM(8);
    if (IN(9)) { ph_moe2_naive(p, lds, bid, nb); } SEAM(9);
#endif
    if (IN(10)) { ph_combine(p, lds, bid, nb); }
#undef IN
#undef SEAM
}

extern "C" void kernel_launch(void* const* d_in, const int* in_sizes, int n_in, void* d_out, int out_size, void* d_ws, size_t ws_size, hipStream_t stream) {
    static int grid = 0;
    if (grid == 0) {
        if (n_in != 27 || in_sizes[0] != MTOK * DM || out_size != MTOK * DM || ws_size < WS_END) {
            fprintf(stderr, "kernel_launch: unexpected shapes: n_in %d in0 %d out %d ws %zu; nothing launched\n", n_in, n_in > 0 ? in_sizes[0] : -1, out_size, ws_size); grid = -1; return; }
        int dev = 0, cus = 0;
        if (hipGetDevice(&dev) != hipSuccess || hipDeviceGetAttribute(&cus, hipDeviceAttributeMultiprocessorCount, dev) != hipSuccess) { grid = -1; return; }
        if (hipFuncSetAttribute((const void*)mega_fwd, hipFuncAttributeMaxDynamicSharedMemorySize, LDS_BYTES) != hipSuccess) { fprintf(stderr, "kernel_launch: hipFuncSetAttribute failed\n"); grid = -1; return; }
        int per_cu = 0;
        if (hipOccupancyMaxActiveBlocksPerMultiprocessor(&per_cu, (const void*)mega_fwd, NTHR, LDS_BYTES) != hipSuccess || per_cu < 1)
            fprintf(stderr, "kernel_launch: note: occupancy query reports %d workgroups per CU\n", per_cu);
        (void)hipGetLastError();
        grid = cus;
    }
    if (grid < 0) return;
    (void)hipMemsetAsync((char*)d_ws + WS_CTL, 0, CTL_ZERO_BYTES, stream);
    Args a{};
    for (int i = 0; i < 27; ++i) a.in[i] = (const float*)d_in[i];
    a.out = (float*)d_out; a.ws = (unsigned char*)d_ws;
    if (MK_N_LAUNCHES == 1) {
        a.ph_lo = 0; a.ph_hi = N_PHASES;
        hipLaunchKernelGGL(mega_fwd, dim3(grid), dim3(NTHR), LDS_BYTES, stream, a);
    } else {
        for (int k = 0; k < N_PHASES; ++k) { a.ph_lo = k; a.ph_hi = k + 1; hipLaunchKernelGGL(mega_fwd, dim3(grid), dim3(NTHR), LDS_BYTES, stream, a); }
    }
}
```

```cpp
#include <hip/hip_runtime.h>
#include <cstdio>
#include <cstdint>
#include <cmath>

#define FAST_INPROJ 1
#define FAST_BRANCH 1
#define FAST_WOUT 1
#define FAST_MOE 1
#define FAST_ATTN 1
#ifndef REP_PHASE
#define REP_PHASE -1
#endif
#define NREP(k) ((REP_PHASE) == (k) ? 2 : 1)
#ifndef MK_N_LAUNCHES
#define MK_N_LAUNCHES 1
#endif

#define GAS __attribute__((address_space(1)))
#define LAS __attribute__((address_space(3)))
typedef unsigned short bf16;
typedef unsigned v4u __attribute__((ext_vector_type(4)));
typedef unsigned v2u __attribute__((ext_vector_type(2)));
typedef float f32x4 __attribute__((ext_vector_type(4)));

constexpr int NB = 2, SEQ = 8192, DM = 1024, MTOK = NB * SEQ, DIN = 4096, DATT = 512, DPOOL = 512, NEXP = 16, DEXP = 512;
constexpr int NHEAD = 4, HD = 64;
constexpr float RMS_EPS = 1e-6f;
constexpr float LOG2E = 1.4426950408889634f;
constexpr float LAMBDA_INIT = 0.2f;
constexpr int NWAVES = 8, NTHR = 512;
constexpr int LDS_BYTES = 147456;
constexpr int MOE_ROWS = 36864;

constexpr size_t MiB = 1u << 20;
constexpr size_t WS_CTL = 0, CTL_ZERO_BYTES = 1 * MiB;
constexpr size_t WS_MISC = 1 * MiB;
constexpr size_t WS_LIST = 2 * MiB;
constexpr size_t WS_ROUTE = WS_MISC + 512 * 1024;
constexpr size_t WS_WIN = 4 * MiB, WS_WBR = 12 * MiB, WS_WOUT = 14 * MiB, WS_W1 = 16 * MiB, WS_W2 = 48 * MiB;
constexpr size_t WS_XN = 64 * MiB;
constexpr size_t WS_Q = 96 * MiB, WS_K = 112 * MiB, WS_V = 128 * MiB, WS_U = 144 * MiB, WS_GA = 160 * MiB, WS_GP = 192 * MiB;
constexpr size_t WS_AB = 224 * MiB;
constexpr size_t WS_HID = 96 * MiB, WS_Y = 132 * MiB;
constexpr size_t WS_END = 256 * MiB;
constexpr int MF_LAM = 0, MF_BIAS = 64  , MF_MOD = 2048  , MF_MODP = 16384  ;
constexpr int MOD_SPLITS = 8;
constexpr int CW_CNT = 64;
constexpr int CW_BAR = 4096;

struct Args { const float* in[27]; float* out; unsigned char* ws; int ph_lo, ph_hi; };

struct P {
    const float *x, *c, *rel_bias, *ada_w, *ada_b, *norm1_g, *w_in, *q_norm_g, *k_norm_g, *lq1, *lk1, *lq2, *lk2, *subln_g, *wba, *pool_w, *pool_scale, *wbp, *w_out, *norm2_g,
        *rgw, *rgb, *rew, *reb, *wgate, *wup, *wdown;
    float* out; unsigned char* ws;
    unsigned* ctl; float* miscf; unsigned* list; int* route;
    bf16 *WIN, *WBR, *WOUT, *W1, *W2, *XN, *Q, *K, *V, *U, *GA, *GP, *AB, *HID, *Y;
};

__device__ __forceinline__ unsigned f2bf(float f) { unsigned u = __float_as_uint(f); return (u + 0x7fffu + ((u >> 16) & 1u)) >> 16; }
__device__ __forceinline__ unsigned pk2(float lo, float hi) { return f2bf(lo) | (f2bf(hi) << 16); }
__device__ __forceinline__ float bf2f(unsigned h) { return __uint_as_float(h << 16); }
__device__ __forceinline__ float bflo(unsigned w) { return __uint_as_float(w << 16); }
__device__ __forceinline__ float bfhi(unsigned w) { return __uint_as_float(w & 0xffff0000u); }
__device__ __forceinline__ float wave_sum(float v) {
#pragma unroll
    for (int o = 1; o < 64; o <<= 1) v += __shfl_xor(v, o);
    return v;
}
__device__ __forceinline__ float wave_max(float v) {
#pragma unroll
    for (int o = 1; o < 64; o <<= 1) v = fmaxf(v, __shfl_xor(v, o));
    return v;
}
__device__ __forceinline__ float sigmoidf_(float v) { return 1.0f / (1.0f + __expf(-v)); }
__device__ __forceinline__ float siluf_(float v) { return v / (1.0f + __expf(-v)); }
__device__ __forceinline__ int t5_bucket(int rel) {
    int n = rel < 0 ? -rel : rel;
    int b;
    if (n < 8) b = n; else if (n < 12) b = 8; else if (n < 16) b = 9; else if (n < 23) b = 10; else if (n < 32) b = 11; else if (n < 46) b = 12; else if (n < 64) b = 13; else if (n < 91) b = 14; else b = 15;
    return b + (rel > 0 ? 16 : 0);
}

#define XB_TMO      128
#define XB_XCNT(j)  (256  + 64 * (j))
#define XB_XSUB(j)  (1280 + 64 * (j))
#define XB_XGEN(j)  (2304 + 64 * (j))
#define XB_TOP      3328
#define XB_TOPGEN   3392
#define XCD_BAR_WORDS 3456
#define XB_SPIN_CAP (1u << 18)
__device__ __forceinline__ unsigned xb_ld(unsigned* p)              { return __hip_atomic_load(p, __ATOMIC_RELAXED, __HIP_MEMORY_SCOPE_AGENT); }
__device__ __forceinline__ unsigned xb_add(unsigned* p, unsigned v) { return __hip_atomic_fetch_add(p, v, __ATOMIC_RELAXED, __HIP_MEMORY_SCOPE_AGENT); }
__device__ __forceinline__ unsigned xb_xcc_id() { return (unsigned)__builtin_amdgcn_s_getreg((3 << 11) | 20) & 0xFu; }
#define XB_SPIN(cond, bar) do { unsigned _sp = 0; while (cond) { __builtin_amdgcn_s_sleep(1); \
    if ((++_sp & 255u) == 0u) { if (xb_ld(&(bar)[XB_TMO])) break; if (_sp > XB_SPIN_CAP) { atomicAdd(&(bar)[XB_TMO], 1u); break; } } } } while (0)
struct XcdBarrier { unsigned* bar; unsigned x; volatile LAS unsigned* st; };
__device__ __forceinline__ XcdBarrier xcd_barrier_post(unsigned* bar, volatile LAS unsigned* st) {
    XcdBarrier b; b.bar = bar; b.x = xb_xcc_id(); b.st = st;
    if (threadIdx.x == 0) (void)xb_add(&bar[XB_XCNT(b.x)], 1u);
    return b;
}
__device__ __forceinline__ void xcd_barrier_complete(unsigned* bar, unsigned x, unsigned& nloc, unsigned& nx) {
    const unsigned G = gridDim.x * gridDim.y * gridDim.z;
    unsigned sum, cnt, mine, sp = 0u;
    for (;;) {
        sum = 0u; cnt = 0u; mine = 0u;
#pragma unroll
        for (unsigned j = 0; j < 16; ++j) { const unsigned c = xb_ld(&bar[XB_XCNT(j)]); sum += c; cnt += (c > 0u) ? 1u : 0u; mine = (j == x) ? c : mine; }
        if (sum == G) break;
        __builtin_amdgcn_s_sleep(1);
        if ((++sp & 255u) == 0u) { if (xb_ld(&bar[XB_TMO])) break; if (sp > XB_SPIN_CAP) { atomicAdd(&bar[XB_TMO], 1u); break; } }
    }
    nloc = mine > 0u ? mine : 1u; nx = cnt > 0u ? cnt : 1u;
}
__device__ __forceinline__ void xcd_barrier(const XcdBarrier& b) {
    asm volatile("s_waitcnt vmcnt(0)" ::: "memory");
    __syncthreads();
    if (threadIdx.x == 0) {
        unsigned* bar = b.bar;
        __builtin_amdgcn_s_waitcnt(0);
        unsigned nloc = b.st[0], nx = b.st[1];
        if (nloc == 0u) { xcd_barrier_complete(bar, b.x, nloc, nx); b.st[0] = nloc; b.st[1] = nx; }
        const unsigned old = xb_add(&bar[XB_XSUB(b.x)], 1u);
        const unsigned gen = old / nloc;
        if (old + 1u == (gen + 1u) * nloc) {
            __builtin_amdgcn_fence(__ATOMIC_RELEASE, "agent");
            asm volatile("s_waitcnt vmcnt(0)" ::: "memory");
            const unsigned og = xb_add(&bar[XB_TOP], 1u);
            const unsigned tg = og / nx;
            if (og + 1u == (tg + 1u) * nx) xb_add(&bar[XB_TOPGEN], 1u);
            else XB_SPIN(xb_ld(&bar[XB_TOPGEN]) == tg, bar);
            __builtin_amdgcn_fence(__ATOMIC_ACQUIRE, "agent");
            xb_add(&bar[XB_XGEN(b.x)], 1u);
            asm volatile("s_waitcnt vmcnt(0)" ::: "memory");
        } else {
            XB_SPIN(xb_ld(&bar[XB_XGEN(b.x)]) == gen, bar);
            __builtin_amdgcn_fence(__ATOMIC_ACQUIRE, "agent");
            asm volatile("s_waitcnt vmcnt(0)" ::: "memory");
        }
    }
    __syncthreads();
}


namespace pg8 {
#define PG8_LAS __attribute__((address_space(3)))
typedef unsigned short bf16_t;
typedef short bf16x8 __attribute__((ext_vector_type(8)));
typedef float f32x4 __attribute__((ext_vector_type(4)));
typedef unsigned u32x4 __attribute__((ext_vector_type(4)));
constexpr int BM = 256, BK = 64, HALF = 128, HTB = HALF * BK * 2, STAGE_BYTES = 8 * HTB, NXCD = 8, WGM = 8;
__host__ __device__ __forceinline__ int lds_byte(int r, int c) { const int st = (r >> 4) * 2 + (c >> 5), rr = r & 15, cc = c & 31, ob = rr * 64 + cc * 2; return st * 1024 + (ob ^ (((ob >> 9) & 1) << 5)); }
__host__ __device__ __forceinline__ void stage_rc(int b, int& R, int& C) { const int st = b / 1024, sb = b % 1024, swz = sb ^ (((sb >> 9) & 1) << 5); R = (st >> 1) * 16 + swz / 64; C = (st & 1) * 32 + (swz % 64) / 2; }
__host__ __device__ __forceinline__ int perm32(int rho) { const int n = rho >> 4, i = rho & 15; return 8 * (i >> 2) + 4 * n + (i & 3); }

struct Unit { int pm, pn, aux, n, pos0; unsigned a_off, b_off; };
struct Gemm { const bf16_t* A; const bf16_t* Bt; int lda, ldb, nt; };

struct StaticOrder {
    int nM, nN, nwg, G, c; unsigned tA, tB;
    __device__ void init(int M, int N, int lda, int ldb, int G_, int c_) { nM = M / BM; nN = N / BM; nwg = nM * nN; G = G_; c = c_; tA = (unsigned)(BM * lda * 2); tB = (unsigned)(BM * ldb * 2); }
    __device__ bool tile(long L, Unit& u) const {
        if (L >= nwg) return false;
        int wgid = (int)L; { const int q = nwg / NXCD, r = nwg % NXCD, xcd = wgid % NXCD, off = wgid / NXCD; wgid = (xcd < r ? xcd * (q + 1) : r * (q + 1) + (xcd - r) * q) + off; }
        const int nig = WGM * nN, gid = wgid / nig, fm = gid * WGM, gsz = (nM - fm) < WGM ? (nM - fm) : WGM;
        u.pm = fm + ((wgid % nig) % gsz); u.pn = (wgid % nig) / gsz; u.aux = 0; u.n = 0; u.pos0 = 0; u.a_off = (unsigned)u.pm * tA; u.b_off = (unsigned)u.pn * tB; return true;
    }
    __device__ bool next(int i, Unit& u) const { return tile((long)i * G + c, u); }
    __device__ unsigned row_off(const Unit&, int) const { return 0u; }
};

typedef float f32x2_t __attribute__((ext_vector_type(2))); typedef __bf16 bf16x2_t __attribute__((ext_vector_type(2)));
__device__ __forceinline__ unsigned cvt_pk_bf16(float lo, float hi) { f32x2_t v = {lo, hi}; bf16x2_t b = __builtin_convertvector(v, bf16x2_t); return __builtin_bit_cast(unsigned, b); }
__device__ __forceinline__ float bflo_(unsigned w) { return __uint_as_float(w << 16); }
__device__ __forceinline__ float bfhi_(unsigned w) { return __uint_as_float(w & 0xffff0000u); }
__device__ __forceinline__ float sigm(float v) { return __builtin_amdgcn_rcpf(1.0f + __builtin_amdgcn_exp2f(-1.4426950408889634f * v)); }
__device__ __forceinline__ u32x4 pack8(const f32x4 v0, const f32x4 v1) { u32x4 w; w.x = cvt_pk_bf16(v0[0], v0[1]); w.y = cvt_pk_bf16(v0[2], v0[3]); w.z = cvt_pk_bf16(v1[0], v1[1]); w.w = cvt_pk_bf16(v1[2], v1[3]); return w; }


struct EpiIn {
    static constexpr bool PERM = true;
    bf16_t *Q, *K, *V, *U, *GA, *GP; const float *qg, *kg;
    __device__ __forceinline__ void operator()(const f32x4 (&acc)[2][2][4][2], const Unit& u, int wr, int wc, int fr, int fq) const {
        const int row0 = u.pm * BM + wr * 64 + fr, pn = u.pn;
#ifdef EPI_MASK
        if (!((EPI_MASK >> pn) & 1)) return;
#endif
        if (pn < 4) {
            const bool isq = pn < 2; bf16_t* base = (isq ? Q : K) + 256 * (pn & 1) + 64 * wc + 8 * fq; const float* gp = isq ? qg : kg; const float sc = isq ? 0.125f * 1.4426950408889634f : 1.0f;
            f32x4 gv[2][2];
#pragma unroll
            for (int bj = 0; bj < 2; ++bj)
#pragma unroll
                for (int n = 0; n < 2; ++n) gv[bj][n] = *(const f32x4*)(gp + 32 * bj + 8 * fq + 4 * n) * sc;
#pragma unroll
            for (int ai = 0; ai < 2; ++ai)
#pragma unroll
                for (int m = 0; m < 4; ++m) {
                    float ss = 0.f;
#pragma unroll
                    for (int bj = 0; bj < 2; ++bj)
#pragma unroll
                        for (int n = 0; n < 2; ++n) { const f32x4 x = acc[ai][bj][m][n]; ss += (x[0] * x[0] + x[1] * x[1]) + (x[2] * x[2] + x[3] * x[3]); }
                    ss += __shfl_xor(ss, 16); ss += __shfl_xor(ss, 32);
                    const float rstd = __builtin_amdgcn_rsqf(ss * (1.0f / 64.0f) + 1e-6f);
                    bf16_t* rowp = base + (size_t)(row0 + ai * HALF + m * 16) * 512;
#pragma unroll
                    for (int bj = 0; bj < 2; ++bj) *(u32x4*)(rowp + 32 * bj) = pack8(acc[ai][bj][m][0] * rstd * gv[bj][0], acc[ai][bj][m][1] * rstd * gv[bj][1]);
                }
        } else if (pn < 8) {
            bf16_t* base = (pn < 6 ? V : U) + 256 * (pn & 1) + 32 * wc + 8 * fq;
#pragma unroll
            for (int ai = 0; ai < 2; ++ai)
#pragma unroll
                for (int m = 0; m < 4; ++m) { bf16_t* rowp = base + (size_t)(row0 + ai * HALF + m * 16) * 512;
#pragma unroll
                    for (int bj = 0; bj < 2; ++bj) *(u32x4*)(rowp + bj * HALF) = pack8(acc[ai][bj][m][0], acc[ai][bj][m][1]); }
        } else {
            bf16_t* base = (pn < 12 ? GA : GP) + 256 * ((pn - 8) & 3) + 32 * wc + 8 * fq;
#pragma unroll
            for (int ai = 0; ai < 2; ++ai)
#pragma unroll
                for (int m = 0; m < 4; ++m) { bf16_t* rowp = base + (size_t)(row0 + ai * HALF + m * 16) * 1024;
#pragma unroll
                    for (int bj = 0; bj < 2; ++bj) { f32x4 v0 = acc[ai][bj][m][0], v1 = acc[ai][bj][m][1];
#pragma unroll
                        for (int e = 0; e < 4; ++e) { v0[e] = sigm(v0[e]); v1[e] = sigm(v1[e]); }
                        *(u32x4*)(rowp + bj * HALF) = pack8(v0, v1); } }
        }
    }
};
struct EpiBranch {
    static constexpr bool PERM = true;
    bf16_t* MG; const bf16_t *GA, *GP;
    __device__ __forceinline__ void operator()(const f32x4 (&acc)[2][2][4][2], const Unit& u, int wr, int wc, int fr, int fq) const {
        const int row0 = u.pm * BM + wr * 64 + fr; const size_t col0 = (size_t)u.pn * BM + wc * 32 + 8 * fq; const bool second = u.aux != 0; const bf16_t* G = second ? GP : GA;
#pragma unroll
        for (int ai = 0; ai < 2; ++ai)
#pragma unroll
            for (int m = 0; m < 4; ++m) { const size_t ro = (size_t)(row0 + ai * HALF + m * 16) * 1024 + col0;
#pragma unroll
                for (int bj = 0; bj < 2; ++bj) { const u32x4 g = *(const u32x4*)(G + ro + bj * HALF); f32x4 v0 = acc[ai][bj][m][0], v1 = acc[ai][bj][m][1];
                    v0[0] *= bflo_(g.x); v0[1] *= bfhi_(g.x); v0[2] *= bflo_(g.y); v0[3] *= bfhi_(g.y); v1[0] *= bflo_(g.z); v1[1] *= bfhi_(g.z); v1[2] *= bflo_(g.w); v1[3] *= bfhi_(g.w);
                    if (second) { const u32x4 o = *(const u32x4*)(MG + ro + bj * HALF);
                        v0[0] += bflo_(o.x); v0[1] += bfhi_(o.x); v0[2] += bflo_(o.y); v0[3] += bfhi_(o.y); v1[0] += bflo_(o.z); v1[1] += bfhi_(o.z); v1[2] += bflo_(o.w); v1[3] += bfhi_(o.w); }
                    *(u32x4*)(MG + ro + bj * HALF) = pack8(v0, v1); } }
    }
};
struct EpiOut {
    static constexpr bool PERM = false;
    const float* x; const float* mod; float* out;
    __device__ __forceinline__ void operator()(const f32x4 (&acc)[2][2][4][2], const Unit& u, int wr, int wc, int fr, int fq) const {
        const int row0 = u.pm * BM + wr * 64 + fr, col0 = u.pn * BM + wc * 32 + 4 * fq; const float* g1 = mod + (u.pm >> 5) * 6144 + 2048 + col0;
        f32x4 gv[2][2];
#pragma unroll
        for (int bj = 0; bj < 2; ++bj)
#pragma unroll
            for (int n = 0; n < 2; ++n) gv[bj][n] = *(const f32x4*)(g1 + bj * HALF + n * 16);
#pragma unroll
        for (int ai = 0; ai < 2; ++ai)
#pragma unroll
            for (int m = 0; m < 4; ++m) { const size_t off = (size_t)(row0 + ai * HALF + m * 16) * 1024 + col0;
#pragma unroll
                for (int bj = 0; bj < 2; ++bj)
#pragma unroll
                    for (int n = 0; n < 2; ++n) { const f32x4 xv = *(const f32x4*)(x + off + bj * HALF + n * 16); *(f32x4*)(out + off + bj * HALF + n * 16) = xv + gv[bj][n] * acc[ai][bj][m][n]; } }
    }
};
struct EpiMoe1 {
    static constexpr bool PERM = true;
    bf16_t* HID;
    __device__ __forceinline__ void operator()(const f32x4 (&acc)[2][2][4][2], const Unit& u, int wr, int wc, int fr, int fq) const {
        const int row0 = u.pm * BM + wr * 64 + fr; bf16_t* base = HID + 128 * u.pn + 32 * wc + 8 * fq;
#pragma unroll
        for (int ai = 0; ai < 2; ++ai)
#pragma unroll
            for (int m = 0; m < 4; ++m) { f32x4 v0 = acc[ai][0][m][0], v1 = acc[ai][0][m][1]; const f32x4 u0 = acc[ai][1][m][0], u1 = acc[ai][1][m][1];
#pragma unroll
                for (int e = 0; e < 4; ++e) { v0[e] = v0[e] * sigm(v0[e]) * u0[e]; v1[e] = v1[e] * sigm(v1[e]) * u1[e]; }
                *(u32x4*)(base + (size_t)(row0 + ai * HALF + m * 16) * 512) = pack8(v0, v1); }
    }
};
struct EpiMoe2 {
    static constexpr bool PERM = true;
    bf16_t* Y; const unsigned* list;
    __device__ __forceinline__ void operator()(const f32x4 (&acc)[2][2][4][2], const Unit& u, int wr, int wc, int fr, int fq) const {
        const int row0 = u.pm * BM + wr * 64 + fr; bf16_t* base = Y + (size_t)u.pn * BM + 32 * wc + 8 * fq;
#pragma unroll
        for (int ai = 0; ai < 2; ++ai)
#pragma unroll
            for (int m = 0; m < 4; ++m) { int pos = u.pos0 + ai * HALF + wr * 64 + m * 16 + fr; pos = pos < u.n ? pos : u.n - 1;
                const float w = __uint_as_float(list[((size_t)u.aux * 16384 + pos) * 2 + 1]);
                bf16_t* rowp = base + (size_t)(row0 + ai * HALF + m * 16) * 1024;
#pragma unroll
                for (int bj = 0; bj < 2; ++bj) *(u32x4*)(rowp + bj * HALF) = pack8(acc[ai][bj][m][0] * w, acc[ai][bj][m][1] * w); }
    }
};

template <class Epi, class Sched, bool GATHER>
__device__ __forceinline__ void gemm_phase(PG8_LAS unsigned char* lds, const Gemm g, const Sched& S, const Epi& E) {
    const int tid = threadIdx.x, wid = __builtin_amdgcn_readfirstlane(tid >> 6), lane = tid & 63, wr = wid >> 2, wc = wid & 3, fr = lane & 15, fq = lane >> 4;
    const int nt = g.nt;
    unsigned voffA[2], voffB[2]; int RA[2]; unsigned CA[2];
#pragma unroll
    for (int i = 0; i < 2; ++i) { int R, C; stage_rc(tid * 16 + i * 8192, R, C); const int Rb = Epi::PERM ? ((R & ~31) + perm32(R & 31)) : R;
        voffA[i] = (unsigned)(R * g.lda + C) * 2u; voffB[i] = (unsigned)(Rb * g.ldb + C) * 2u; RA[i] = R; CA[i] = (unsigned)C * 2u; }
    const size_t kstep = (size_t)(BK * 2);
    const size_t hstepA = (size_t)HALF * g.lda * 2, hstepB = (size_t)HALF * g.ldb * 2;
    const unsigned ldsw = (unsigned)wid * 1024u;
    const int aoff = lds_byte(wr * 64 + fr, fq * 8), boff = lds_byte(wc * 32 + fr, fq * 8);
#define PG8_SA(b, h) (((b) * 2 + (h)) * HTB)
#define PG8_SB(b, h) ((4 + (b) * 2 + (h)) * HTB)
#define PG8_STAGE2(bufoff, gbase, v0, v1) do { \
        __builtin_amdgcn_global_load_lds((const unsigned*)((const char*)(gbase) + (v0)), (PG8_LAS unsigned*)(lds + (bufoff) + ldsw), 16, 0, 0); \
        __builtin_amdgcn_global_load_lds((const unsigned*)((const char*)(gbase) + (v1)), (PG8_LAS unsigned*)(lds + (bufoff) + ldsw + 8192), 16, 0, 0); } while (0)
#define PG8_STAGEB(bufoff, gbase) PG8_STAGE2(bufoff, gbase, voffB[0], voffB[1])
#define PG8_STAGEA(bufoff, ptrN, ptrG, vg0, vg1) do { if constexpr (GATHER) { PG8_STAGE2(bufoff, ptrG, vg0, vg1); } else { PG8_STAGE2(bufoff, ptrN, voffA[0], voffA[1]); } } while (0)
#define PG8_LDA(dst, b, h) do { _Pragma("unroll") for (int m = 0; m < 4; ++m) _Pragma("unroll") for (int k = 0; k < 2; ++k) dst[m][k] = *(const PG8_LAS bf16x8*)(lds + PG8_SA(b, h) + aoff + m * 2048 + k * 1024); } while (0)
#define PG8_LDB(dst, b, h) do { _Pragma("unroll") for (int n = 0; n < 2; ++n) _Pragma("unroll") for (int k = 0; k < 2; ++k) dst[n][k] = *(const PG8_LAS bf16x8*)(lds + PG8_SB(b, h) + boff + n * 2048 + k * 1024); } while (0)
#define PG8_MMA(ai, bj, At, Bt) do { __builtin_amdgcn_s_setprio(1); _Pragma("unroll") for (int m = 0; m < 4; ++m) _Pragma("unroll") for (int n = 0; n < 2; ++n) _Pragma("unroll") for (int k = 0; k < 2; ++k) \
        acc[ai][bj][m][n] = __builtin_amdgcn_mfma_f32_16x16x32_bf16(Bt[n][k], At[m][k], acc[ai][bj][m][n], 0, 0, 0); __builtin_amdgcn_s_setprio(0); } while (0)
#define PG8_WAIT_V(n) asm volatile("s_waitcnt vmcnt(" #n ")" ::: "memory")
#define PG8_WAIT_L(n) asm volatile("s_waitcnt lgkmcnt(" #n ")" ::: "memory")
#define PG8_BAR __builtin_amdgcn_s_barrier()
#define PG8_SCHED __builtin_amdgcn_sched_barrier(0)
    Unit cur, nxt; int ui = 0;
    if (!S.next(0, cur)) return;
    f32x4 acc[2][2][4][2];
#pragma unroll
    for (int a = 0; a < 2; ++a)
#pragma unroll
        for (int b = 0; b < 2; ++b)
#pragma unroll
            for (int m = 0; m < 4; ++m)
#pragma unroll
                for (int n = 0; n < 2; ++n) acc[a][b][m][n] = (f32x4){0.f, 0.f, 0.f, 0.f};
    bf16x8 At[4][2], B0[2][2], B1[2][2];
    const char* cA = (const char*)g.A + cur.a_off; const char* cB = (const char*)g.Bt + cur.b_off;
    unsigned vc00 = 0, vc01 = 0, vc10 = 0, vc11 = 0, vn00 = 0, vn01 = 0, vn10 = 0, vn11 = 0;
    if constexpr (GATHER) { vc00 = S.row_off(cur, RA[0]) + CA[0]; vc01 = S.row_off(cur, RA[1]) + CA[1]; vc10 = S.row_off(cur, HALF + RA[0]) + CA[0]; vc11 = S.row_off(cur, HALF + RA[1]) + CA[1]; }
    const char* gA = (const char*)g.A;
    PG8_STAGEB(PG8_SB(0, 0), cB); PG8_STAGEB(PG8_SB(0, 1), cB + hstepB); PG8_STAGEA(PG8_SA(0, 0), cA, gA, vc00, vc01); PG8_STAGEA(PG8_SA(0, 1), cA + hstepA, gA, vc10, vc11);
    if (wr == 1) PG8_BAR;
    PG8_WAIT_V(2); PG8_BAR;
    PG8_STAGEB(PG8_SB(1, 0), cB + kstep); PG8_STAGEA(PG8_SA(1, 0), cA + kstep, gA + kstep, vc00, vc01); PG8_STAGEB(PG8_SB(1, 1), cB + hstepB + kstep);
    PG8_WAIT_V(6); PG8_BAR;
    for (;;) {
        const bool has_next = S.next(ui + 1, nxt);
        const char* nA = has_next ? (const char*)g.A + nxt.a_off : cA; const char* nB = has_next ? (const char*)g.Bt + nxt.b_off : cB;
        if constexpr (GATHER) {
            if (has_next) { vn00 = S.row_off(nxt, RA[0]) + CA[0]; vn01 = S.row_off(nxt, RA[1]) + CA[1]; vn10 = S.row_off(nxt, HALF + RA[0]) + CA[0]; vn11 = S.row_off(nxt, HALF + RA[1]) + CA[1]; }
            else { vn00 = vc00; vn01 = vc01; vn10 = vc10; vn11 = vc11; }
        }
        for (int t = 0; t < nt; t += 2) {
            const bool last = (t == nt - 2);
            const char* a1 = cA + (size_t)(t + 1) * kstep;
            const char* a2 = last ? nA : cA + (size_t)(t + 2) * kstep; const char* b2 = last ? nB : cB + (size_t)(t + 2) * kstep;
            const char* a3 = a2 + kstep; const char* b3 = b2 + kstep;
            const char* g1 = gA + (size_t)(t + 1) * kstep; const char* g2 = last ? gA : gA + (size_t)(t + 2) * kstep; const char* g3 = g2 + kstep;
            const unsigned w00 = last ? vn00 : vc00, w01 = last ? vn01 : vc01, w10 = last ? vn10 : vc10, w11 = last ? vn11 : vc11;
            PG8_LDB(B0, 0, 0); PG8_LDB(B1, 0, 1); PG8_SCHED; PG8_LDA(At, 0, 0); PG8_STAGEA(PG8_SA(1, 1), a1 + hstepA, g1, vc10, vc11);
            PG8_WAIT_V(8); PG8_WAIT_L(0); PG8_BAR; PG8_MMA(0, 0, At, B0); PG8_MMA(0, 1, At, B1); PG8_BAR; PG8_SCHED;
            PG8_LDA(At, 0, 1); PG8_STAGEB(PG8_SB(0, 0), b2); PG8_STAGEB(PG8_SB(0, 1), b2 + hstepB); PG8_STAGEA(PG8_SA(0, 0), a2, g2, w00, w01);
            PG8_WAIT_V(8); PG8_WAIT_L(0); PG8_BAR; PG8_MMA(1, 0, At, B0); PG8_MMA(1, 1, At, B1); PG8_BAR; PG8_SCHED;
            PG8_LDB(B0, 1, 0); PG8_LDB(B1, 1, 1); PG8_SCHED; PG8_LDA(At, 1, 0); PG8_STAGEA(PG8_SA(0, 1), a2 + hstepA, g2, w10, w11);
            PG8_WAIT_V(8); PG8_WAIT_L(0); PG8_BAR; PG8_MMA(0, 0, At, B0); PG8_MMA(0, 1, At, B1); PG8_BAR; PG8_SCHED;
            PG8_LDA(At, 1, 1); PG8_STAGEB(PG8_SB(1, 0), b3); PG8_STAGEB(PG8_SB(1, 1), b3 + hstepB); PG8_STAGEA(PG8_SA(1, 0), a3, g3, w00, w01);
            PG8_WAIT_V(8); PG8_WAIT_L(0); PG8_BAR; PG8_MMA(1, 0, At, B0); PG8_MMA(1, 1, At, B1); PG8_BAR; PG8_SCHED;
        }
        if (wr == 0) PG8_BAR;
        PG8_WAIT_V(0);
        E(acc, cur, wr, wc, fr, fq);
        if (!has_next) break;
#pragma unroll
        for (int a = 0; a < 2; ++a)
#pragma unroll
            for (int b = 0; b < 2; ++b)
#pragma unroll
                for (int m = 0; m < 4; ++m)
#pragma unroll
                    for (int n = 0; n < 2; ++n) acc[a][b][m][n] = (f32x4){0.f, 0.f, 0.f, 0.f};
        cur = nxt; cA = nA; cB = nB; ++ui;
        if constexpr (GATHER) { vc00 = vn00; vc01 = vn01; vc10 = vn10; vc11 = vn11; }
        if (wr == 1) PG8_BAR;
    }
    PG8_WAIT_V(0);
    PG8_BAR;
#undef PG8_SA
#undef PG8_SB
#undef PG8_STAGE2
#undef PG8_STAGEB
#undef PG8_STAGEA
#undef PG8_LDA
#undef PG8_LDB
#undef PG8_MMA
#undef PG8_WAIT_V
#undef PG8_WAIT_L
#undef PG8_BAR
#undef PG8_SCHED
}
}

__device__ __forceinline__ void transpose_item(const float* W, int N, bf16* dst, int dpitch, int drow0, int dk0, float* scr, int k0, int n0, int lane) {
#pragma unroll 8
    for (int i = 0; i < 32; ++i) { const int kk = 2 * i + (lane >> 5); scr[kk * 33 + (lane & 31)] = W[(size_t)(k0 + kk) * N + n0 + (lane & 31)]; }
    __builtin_amdgcn_s_waitcnt(0xC07F); asm volatile("" ::: "memory");
    const int c = lane & 7;
#pragma unroll
    for (int j = 0; j < 4; ++j) { const int n = (lane >> 3) + 8 * j; const float* s = scr + (8 * c) * 33 + n;
        v4u o; o.x = pk2(s[0 * 33], s[1 * 33]); o.y = pk2(s[2 * 33], s[3 * 33]); o.z = pk2(s[4 * 33], s[5 * 33]); o.w = pk2(s[6 * 33], s[7 * 33]);
        *(v4u*)(dst + (size_t)(drow0 + n) * dpitch + dk0 + k0 + 8 * c) = o; }
    __builtin_amdgcn_s_waitcnt(0xC07F); asm volatile("" ::: "memory");
}
__device__ __forceinline__ int win_rowmap(int n0) {
    if (n0 >= 1024) return n0;
    const int t = n0 >> 8, rem = n0 & 255, wc = rem >> 6, bj = (rem & 63) >> 5;
    return 256 * t + 128 * bj + 32 * wc;
}
__device__ __forceinline__ int win_colmap_inv(int np) {
    if (np >= 1024) return np;
    const int t = np >> 8, rem = np & 255, bj = rem >> 7, wc = (rem & 127) >> 5, j = rem & 31;
    return 256 * t + 64 * wc + 32 * bj + j;
}
__device__ __forceinline__ void ph_prologue(const P& p, unsigned char* ldsb, int bid, int nb) {
    const int tid = threadIdx.x, lane = tid & 63, wave = tid >> 6;
    float* scr = (float*)(ldsb + wave * 16384);
    const int gw = bid * NWAVES + wave, NGW = nb * NWAVES;
    constexpr int I_IN = 16 * 128, I_BA = 8 * 32, I_BP = 4 * 16 * 16, I_OUT = 16 * 32, I_G = 16 * 256, I_U = 16 * 256, I_D = 16 * 256, I_MOD = 96 * MOD_SPLITS;
    constexpr int NITEMS = I_MOD + I_IN + I_BA + I_BP + I_OUT + I_G + I_U + I_D;
    for (int it = gw; it < NITEMS; it += NGW) {
        int r = it;
        if (r < I_MOD) {
            const int ch = r % 96, sp = r / 96, j = ch * 64 + lane;
            float a0 = 0.f, a1 = 0.f;
#pragma unroll 1
            for (int kc = 0; kc < 2; ++kc) { const int k0 = sp * 128 + kc * 64;
                const float s0 = siluf_(p.c[k0 + lane]), s1 = siluf_(p.c[DM + k0 + lane]);
#pragma unroll 8
                for (int kk = 0; kk < 64; ++kk) { const float w = p.ada_w[(size_t)(k0 + kk) * 6144 + j]; a0 += __shfl(s0, kk) * w; a1 += __shfl(s1, kk) * w; } }
            p.miscf[MF_MODP + (sp * 2 + 0) * 6144 + j] = a0; p.miscf[MF_MODP + (sp * 2 + 1) * 6144 + j] = a1;
            continue;
        }
        r -= I_MOD;
        if (r < I_IN) { const int kb = r / 128, nbk = r % 128; transpose_item(p.w_in, DIN, p.WIN, DM, win_rowmap(nbk * 32), 0, scr, kb * 64, nbk * 32, lane); continue; } r -= I_IN;
        if (r < I_BA) { const int kb = r / 32, nbk = r % 32; transpose_item(p.wba, DM, p.WBR, DM, nbk * 32, 0, scr, kb * 64, nbk * 32, lane); continue; } r -= I_BA;
        if (r < I_BP) {
            const int g = r >> 8, cb = (r >> 4) & 15, n = (r & 15) * 64 + lane;
            float a[8];
#pragma unroll
            for (int q = 0; q < 8; ++q) a[q] = 0.f;
            const float* pw = p.pool_w + (size_t)(g * 128 + cb * 8) * 128;
#pragma unroll 4
            for (int j = 0; j < 128; ++j) { const float w = p.wbp[(size_t)(g * 128 + j) * DM + n] * p.pool_scale[g * 128 + j];
#pragma unroll
                for (int q = 0; q < 8; ++q) a[q] += pw[q * 128 + j] * w; }
            v4u o; o.x = pk2(a[0], a[1]); o.y = pk2(a[2], a[3]); o.z = pk2(a[4], a[5]); o.w = pk2(a[6], a[7]);
            *(v4u*)(p.WBR + (size_t)n * DM + 512 + g * 128 + cb * 8) = o;
            continue; } r -= I_BP;
        if (r < I_OUT) { const int kb = r / 32, nbk = r % 32; transpose_item(p.w_out, DM, p.WOUT, DM, nbk * 32, 0, scr, kb * 64, nbk * 32, lane); continue; } r -= I_OUT;
        if (r < I_G) { const int e = r / 256, q = r % 256, kb = q / 16, nbk = q % 16, n0 = nbk * 32;
            transpose_item(p.wgate + (size_t)e * DM * DEXP, DEXP, p.W1 + (size_t)e * 1024 * 1024, DM, 256 * (n0 >> 7) + (n0 & 127), 0, scr, kb * 64, n0, lane); continue; } r -= I_G;
        if (r < I_U) { const int e = r / 256, q = r % 256, kb = q / 16, nbk = q % 16, n0 = nbk * 32;
            transpose_item(p.wup + (size_t)e * DM * DEXP, DEXP, p.W1 + (size_t)e * 1024 * 1024, DM, 256 * (n0 >> 7) + 128 + (n0 & 127), 0, scr, kb * 64, n0, lane); continue; } r -= I_U;
        { const int e = r / 256, q = r % 256, kb = q / 32, nbk = q % 32;
            transpose_item(p.wdown + (size_t)e * DEXP * DM, DM, p.W2 + (size_t)e * 1024 * 512, DEXP, nbk * 32, 0, scr, kb * 64, nbk * 32, lane); }
    }
    if (bid == 0 && wave == 0) {
        float a = p.lq1[lane] * p.lk1[lane], b2 = p.lq2[lane] * p.lk2[lane];
        a = wave_sum(a); b2 = wave_sum(b2);
        const float lam = __expf(a) - __expf(b2) + LAMBDA_INIT;
        const float gq = wave_max(fabsf(p.q_norm_g[lane])), gk = wave_max(fabsf(p.k_norm_g[lane]));
        if (lane == 0) p.miscf[MF_LAM] = lam;
        for (int h = 0; h < NHEAD; ++h) {
            float bm = lane < 32 ? fabsf(p.rel_bias[lane * 4 + h]) : 0.f; bm = wave_max(bm);
            const float shift = 8.0f * gq * gk + bm;
            for (int i = lane; i < 384; i += 64) { const int rel = i - 256; p.miscf[MF_BIAS + h * 384 + i] = (p.rel_bias[t5_bucket(rel) * 4 + h] - shift) * LOG2E; }
        }
    }
}

__device__ __forceinline__ float mod_sum(const P& p, int b, int j) {
    float s = p.ada_b[j];
#pragma unroll
    for (int sp = 0; sp < MOD_SPLITS; ++sp) s += p.miscf[MF_MODP + (sp * 2 + b) * 6144 + j];
    return s;
}
__device__ __forceinline__ void ph_norm1(const P& p, unsigned char* ldsb, int bid, int nb) {
    const int tid = threadIdx.x, lane = tid & 63, wave = tid >> 6;
    float* la = (float*)ldsb; float* ls = la + 1024;
    for (int rb = bid; rb < 256; rb += nb) {
        const int b = rb / 128;
        __syncthreads();
        for (int c = tid; c < 1024; c += NTHR) { la[c] = p.norm1_g[c] * (1.0f + mod_sum(p, b, 1024 + c)); ls[c] = mod_sum(p, b, c); }
        if (tid < 48) { const int j = rb * 48 + tid; p.miscf[MF_MOD + j] = mod_sum(p, j / 6144, j % 6144); }
        __syncthreads();
        for (int i = 0; i < 8; ++i) {
            const int row = rb * 64 + wave * 8 + i;
            const f32x4* xr = (const f32x4*)(p.x + (size_t)row * DM) + lane;
            f32x4 v[4]; float ss = 0.f;
#pragma unroll
            for (int j = 0; j < 4; ++j) { v[j] = xr[64 * j]; ss += v[j].x * v[j].x + v[j].y * v[j].y + v[j].z * v[j].z + v[j].w * v[j].w; }
            const float rstd = rsqrtf(wave_sum(ss) * (1.0f / DM) + RMS_EPS);
            v2u* o = (v2u*)(p.XN + (size_t)row * DM) + lane;
#pragma unroll
            for (int j = 0; j < 4; ++j) { const int c = (64 * j + lane) * 4; const f32x4 a = *(const f32x4*)(la + c), s = *(const f32x4*)(ls + c);
                v2u w; w.x = pk2(v[j].x * rstd * a.x + s.x, v[j].y * rstd * a.y + s.y); w.y = pk2(v[j].z * rstd * a.z + s.z, v[j].w * rstd * a.w + s.w); o[64 * j] = w; }
        }
    }
}

template <class Epi>
__device__ __forceinline__ void gemm_nt_naive(const bf16* A, int lda, const bf16* Bt, int ldb, int M, int N, int K, const Epi& epi, unsigned char* ldsb, int bid, int nb) {
    float* As = (float*)ldsb;
    float* Bs = As + 32 * 68;
    const int tid = threadIdx.x, tm = tid >> 5, tn = tid & 31;
    const int ntn = N / 128, nt = (M / 64) * ntn;
    for (int t = bid; t < nt; t += nb) {
        const int m0 = (t / ntn) * 64, n0 = (t % ntn) * 128;
        float acc[4][4];
#pragma unroll
        for (int i = 0; i < 4; ++i)
#pragma unroll
            for (int j = 0; j < 4; ++j) acc[i][j] = 0.f;
        for (int k0 = 0; k0 < K; k0 += 32) {
            __syncthreads();
            { const int r = tid >> 3, kq = (tid & 7) * 4; const v2u v = *(const v2u*)(A + (size_t)(m0 + r) * lda + k0 + kq);
              As[(kq + 0) * 68 + r] = bflo(v.x); As[(kq + 1) * 68 + r] = bfhi(v.x); As[(kq + 2) * 68 + r] = bflo(v.y); As[(kq + 3) * 68 + r] = bfhi(v.y); }
            { const int r = tid >> 2, kq = (tid & 3) * 8; const v4u v = *(const v4u*)(Bt + (size_t)(n0 + r) * ldb + k0 + kq);
              Bs[(kq + 0) * 132 + r] = bflo(v.x); Bs[(kq + 1) * 132 + r] = bfhi(v.x); Bs[(kq + 2) * 132 + r] = bflo(v.y); Bs[(kq + 3) * 132 + r] = bfhi(v.y);
              Bs[(kq + 4) * 132 + r] = bflo(v.z); Bs[(kq + 5) * 132 + r] = bfhi(v.z); Bs[(kq + 6) * 132 + r] = bflo(v.w); Bs[(kq + 7) * 132 + r] = bfhi(v.w); }
            __syncthreads();
#pragma unroll 8
            for (int k = 0; k < 32; ++k) {
                const f32x4 a = *(const f32x4*)(As + k * 68 + tm * 4), b = *(const f32x4*)(Bs + k * 132 + tn * 4);
#pragma unroll
                for (int i = 0; i < 4; ++i)
#pragma unroll
                    for (int j = 0; j < 4; ++j) acc[i][j] += a[i] * b[j];
            }
        }
#pragma unroll
        for (int i = 0; i < 4; ++i)
#pragma unroll
            for (int j = 0; j < 4; ++j) epi(m0 + tm * 4 + i, n0 + tn * 4 + j, acc[i][j]);
    }
}

struct EpiInNaive {
    float* qkraw; bf16 *V, *U, *GA, *GP;
    __device__ __forceinline__ void operator()(int r, int np, float v) const {
        const int c = win_colmap_inv(np);
        if (c < 1024) qkraw[(size_t)r * 1024 + c] = v;
        else if (c < 1536) V[(size_t)r * 512 + c - 1024] = (bf16)f2bf(v);
        else if (c < 2048) U[(size_t)r * 512 + c - 1536] = (bf16)f2bf(v);
        else if (c < 3072) GA[(size_t)r * 1024 + c - 2048] = (bf16)f2bf(sigmoidf_(v));
        else GP[(size_t)r * 1024 + c - 3072] = (bf16)f2bf(sigmoidf_(v));
    }
};
__device__ __forceinline__ void ph_inproj_naive(const P& p, unsigned char* ldsb, int bid, int nb) {
    EpiInNaive e{p.out, p.V, p.U, p.GA, p.GP};
    gemm_nt_naive(p.XN, DM, p.WIN, DM, MTOK, DIN, DM, e, ldsb, bid, nb);
}
__device__ __forceinline__ void ph_qknorm_naive(const P& p, int bid, int nb) {
    const int tid = threadIdx.x, lane = tid & 63, wave = tid >> 6;
    for (int row = bid * NWAVES + wave; row < MTOK; row += nb * NWAVES) {
        const float* src = p.out + (size_t)row * 1024 + lane * 16;
        float v[16]; float ss = 0.f;
#pragma unroll
        for (int i = 0; i < 16; ++i) { v[i] = src[i]; ss += v[i] * v[i]; }
        ss += __shfl_xor(ss, 1); ss += __shfl_xor(ss, 2);
        const float rstd = rsqrtf(ss * (1.0f / 64.0f) + RMS_EPS);
        const bool isq = lane < 32; const int d0 = (lane & 3) * 16;
        bf16* dst = (isq ? p.Q : p.K) + (size_t)row * 512 + (lane & 31) * 16;
#pragma unroll
        for (int i = 0; i < 16; ++i) { const float g = isq ? p.q_norm_g[d0 + i] * (0.125f * LOG2E) : p.k_norm_g[d0 + i]; dst[i] = (bf16)f2bf(v[i] * rstd * g); }
    }
}

__device__ __forceinline__ float block_max(float v, float* red, int tid) {
    v = wave_max(v); __syncthreads(); if ((tid & 63) == 0) red[tid >> 6] = v; __syncthreads();
    float r = red[0];
#pragma unroll
    for (int i = 1; i < 8; ++i) r = fmaxf(r, red[i]);
    return r;
}
__device__ __forceinline__ float block_sum(float v, float* red, int tid) {
    v = wave_sum(v); __syncthreads(); if ((tid & 63) == 0) red[tid >> 6] = v; __syncthreads();
    float r = 0.f;
#pragma unroll
    for (int i = 0; i < 8; ++i) r += red[i];
    return r;
}
__device__ __forceinline__ void ph_attn_naive(const P& p, unsigned char* ldsb, int bid, int nb) {
    float* sc1 = (float*)ldsb; float* sc2 = sc1 + 8192; float* qs = sc2 + 8192; float* red = qs + 128; float* po = red + 32;
    const int tid = threadIdx.x;
    const float lam = p.miscf[MF_LAM];
    for (int item = bid; item < NB * NHEAD * SEQ; item += nb) {
        const int q = item % SEQ, bh = item / SEQ, h = bh % NHEAD, b = bh / NHEAD;
        const int nk = 64 * (q / 64 + 1);
        const size_t rowq = (size_t)b * SEQ + q;
        __syncthreads();
        if (tid < 128) qs[tid] = bf2f(p.Q[rowq * 512 + h * 128 + tid]);
        __syncthreads();
        float mx1 = -INFINITY, mx2 = -INFINITY;
        for (int j = tid; j < nk; j += NTHR) {
            const bf16* kr = p.K + ((size_t)b * SEQ + j) * 512 + h * 128;
            float s1 = 0.f, s2 = 0.f;
#pragma unroll
            for (int d = 0; d < 64; d += 8) {
                const v4u a = *(const v4u*)(kr + d), c = *(const v4u*)(kr + 64 + d);
                s1 += qs[d] * bflo(a.x) + qs[d + 1] * bfhi(a.x) + qs[d + 2] * bflo(a.y) + qs[d + 3] * bfhi(a.y) + qs[d + 4] * bflo(a.z) + qs[d + 5] * bfhi(a.z) + qs[d + 6] * bflo(a.w) + qs[d + 7] * bfhi(a.w);
                s2 += qs[64 + d] * bflo(c.x) + qs[65 + d] * bfhi(c.x) + qs[66 + d] * bflo(c.y) + qs[67 + d] * bfhi(c.y) + qs[68 + d] * bflo(c.z) + qs[69 + d] * bfhi(c.z) + qs[70 + d] * bflo(c.w) + qs[71 + d] * bfhi(c.w);
            }
            int rel = j - q; if (rel < -256) rel = -256;
            const float bv = p.miscf[MF_BIAS + h * 384 + rel + 256];
            s1 += bv; s2 += bv; sc1[j] = s1; sc2[j] = s2; mx1 = fmaxf(mx1, s1); mx2 = fmaxf(mx2, s2);
        }
        mx1 = block_max(mx1, red, tid); mx2 = block_max(mx2, red, tid);
        float l1 = 0.f, l2 = 0.f;
        for (int j = tid; j < nk; j += NTHR) { const float p1 = exp2f(sc1[j] - mx1), p2 = exp2f(sc2[j] - mx2); sc1[j] = p1; sc2[j] = p2; l1 += p1; l2 += p2; }
        l1 = block_sum(l1, red, tid); l2 = block_sum(l2, red, tid);
        const float i1 = 1.0f / l1, i2 = lam / l2;
        const int d = tid & 127, kq = tid >> 7;
        float o = 0.f;
        const bf16* vb = p.V + (size_t)b * SEQ * 512 + h * 128 + d;
        for (int j = kq; j < nk; j += 4) o += (sc1[j] * i1 - sc2[j] * i2) * bf2f(vb[(size_t)j * 512]);
        po[kq * 128 + d] = o;
        __syncthreads();
        float ov = 0.f, ss = 0.f;
        if (tid < 128) { ov = po[tid] + po[128 + tid] + po[256 + tid] + po[384 + tid]; ss = ov * ov; }
        ss = block_sum(ss, red, tid);
        if (tid < 128) { const float r = rsqrtf(ss * (1.0f / 128.0f) + RMS_EPS); p.AB[rowq * 1024 + h * 128 + tid] = (bf16)f2bf(ov * r * p.subln_g[tid] * (1.0f - LAMBDA_INIT)); }
    }
}
__device__ __forceinline__ void ph_pool_naive(const P& p, unsigned char* ldsb, int bid, int nb) {
    float* mt = (float*)ldsb;
    const int tid = threadIdx.x, i = tid >> 5, c4 = (tid & 31) * 4;
    for (int item = bid; item < (MTOK / 16) * 4; item += nb) {
        const int rb = item >> 2, g = item & 3, w = 2 << g;
        const int r = rb * 16 + i, t = r % SEQ;
        __syncthreads();
#pragma unroll
        for (int cc = 0; cc < 4; ++cc) { const int c = c4 + cc; float s = 0.f;
            for (int jj = 0; jj < w; ++jj) if (t - jj >= 0) s += bf2f(p.U[(size_t)(r - jj) * 512 + g * 128 + c]);
            const float cnt = (float)(t + 1 < w ? t + 1 : w);
            mt[i * 128 + c] = s / cnt - bf2f(p.U[(size_t)r * 512 + g * 128 + c]); }
        __syncthreads();
#pragma unroll
        for (int dd = 0; dd < 4; ++dd) { const int d = c4 + dd; float a = 0.f;
            for (int c = 0; c < 128; ++c) a += mt[i * 128 + c] * p.pool_w[(size_t)(g * 128 + c) * 128 + d];
            p.AB[(size_t)r * 1024 + 512 + g * 128 + d] = (bf16)f2bf(a * p.pool_scale[g * 128 + d]); }
    }
}

struct EpiBrA { bf16* MG; const bf16* GA; __device__ __forceinline__ void operator()(int r, int c, float v) const { MG[(size_t)r * 1024 + c] = (bf16)f2bf(bf2f(GA[(size_t)r * 1024 + c]) * v); } };
struct EpiBrB { bf16* MG; const bf16* GP; __device__ __forceinline__ void operator()(int r, int c, float v) const { MG[(size_t)r * 1024 + c] = (bf16)f2bf(bf2f(MG[(size_t)r * 1024 + c]) + bf2f(GP[(size_t)r * 1024 + c]) * v); } };
__device__ __forceinline__ void ph_branch_naive(const P& p, unsigned char* ldsb, int bid, int nb) {
    EpiBrA ea{p.XN, p.GA}; gemm_nt_naive(p.AB, 1024, p.WBR, 1024, MTOK, DM, 512, ea, ldsb, bid, nb);
    __syncthreads();
    EpiBrB eb{p.XN, p.GP}; gemm_nt_naive(p.AB + 512, 1024, p.WBR + 512, 1024, MTOK, DM, 512, eb, ldsb, bid, nb);
}
struct EpiOutNaive { const float* x; const float* mod; float* out; __device__ __forceinline__ void operator()(int r, int c, float v) const {
    const int b = r / SEQ; out[(size_t)r * 1024 + c] = x[(size_t)r * 1024 + c] + mod[b * 6144 + 2048 + c] * v; } };
__device__ __forceinline__ void ph_wout_naive(const P& p, unsigned char* ldsb, int bid, int nb) {
    EpiOutNaive e{p.x, p.miscf + MF_MOD, p.out}; gemm_nt_naive(p.XN, 1024, p.WOUT, 1024, MTOK, DM, DM, e, ldsb, bid, nb);
}

__device__ __forceinline__ void ph_norm2_route(const P& p, unsigned char* ldsb, int bid, int nb) {
    const int tid = threadIdx.x, lane = tid & 63, wave = tid >> 6;
    float* la = (float*)ldsb; float* ls = la + 1024; float* wr = ls + 1024;
    int4* rt = (int4*)(wr + 20 * 1024); unsigned* lcnt = (unsigned*)(rt + 64); unsigned* lbase = lcnt + 16; unsigned* posl = lbase + 16;
    if (tid < 16) lcnt[tid] = 0u;
    for (int i = tid; i < 1024 * 20; i += NTHR) { const int o = i / 1024, c = i % 1024; wr[i] = o < 4 ? p.rgw[c * 4 + o] : p.rew[c * 16 + o - 4]; }
    for (int rb = bid; rb < 256; rb += nb) {
        const int b = rb / 128;
        __syncthreads();
        for (int c = tid; c < 1024; c += NTHR) { la[c] = p.norm2_g[c] * (1.0f + p.miscf[MF_MOD + b * 6144 + 4096 + c]); ls[c] = p.miscf[MF_MOD + b * 6144 + 3072 + c]; }
        __syncthreads();
#pragma unroll 1
        for (int i = 0; i < 8; ++i) {
            const int row = rb * 64 + wave * 8 + i;
            const f32x4* xr = (const f32x4*)(p.out + (size_t)row * DM) + lane;
            f32x4 v[4]; float ss = 0.f;
#pragma unroll
            for (int j = 0; j < 4; ++j) { v[j] = xr[64 * j]; ss += v[j].x * v[j].x + v[j].y * v[j].y + v[j].z * v[j].z + v[j].w * v[j].w; }
            const float rstd = rsqrtf(wave_sum(ss) * (1.0f / DM) + RMS_EPS);
            v2u* o = (v2u*)(p.XN + (size_t)row * DM) + lane;
#pragma unroll
            for (int j = 0; j < 4; ++j) { const int c = (64 * j + lane) * 4; const f32x4 a = *(const f32x4*)(la + c), s = *(const f32x4*)(ls + c);
                f32x4 hh; hh.x = v[j].x * rstd * a.x + s.x; hh.y = v[j].y * rstd * a.y + s.y; hh.z = v[j].z * rstd * a.z + s.z; hh.w = v[j].w * rstd * a.w + s.w;
                v2u w; w.x = pk2(hh.x, hh.y); w.y = pk2(hh.z, hh.w); o[64 * j] = w; v[j] = hh; }
            float mylg = 0.f;
#pragma unroll 1
            for (int oo = 0; oo < 20; ++oo) { float s = 0.f;
#pragma unroll
                for (int j = 0; j < 4; ++j) { const f32x4 w = *(const f32x4*)(wr + oo * 1024 + (64 * j + lane) * 4); s += v[j].x * w.x + v[j].y * w.y + v[j].z * w.z + v[j].w * w.w; }
                s = wave_sum(s); mylg = (lane == oo) ? s : mylg; }
            float lg[20];
#pragma unroll
            for (int k = 0; k < 20; ++k) lg[k] = __shfl(mylg, k);
            if (lane == 0) {
                const float g0 = lg[0] + p.rgb[0], g1 = lg[1] + p.rgb[1], g2 = lg[2] + p.rgb[2], g3 = lg[3] + p.rgb[3];
                int gi = 0; float gm = g0;
                if (g1 > gm) { gm = g1; gi = 1; } if (g2 > gm) { gm = g2; gi = 2; } if (g3 > gm) { gm = g3; gi = 3; }
                const float gval = 1.0f / (__expf(g0 - gm) + __expf(g1 - gm) + __expf(g2 - gm) + __expf(g3 - gm));
                float el[4];
#pragma unroll
                for (int k = 0; k < 4; ++k) { float t = 0.f;
#pragma unroll
                    for (int gg = 0; gg < 4; ++gg) t = (gg == gi) ? lg[4 + gg * 4 + k] + p.reb[gg * 4 + k] : t;
                    el[k] = t; }
                int i0 = 0; float m0 = el[0];
#pragma unroll
                for (int k = 1; k < 4; ++k) if (el[k] > m0) { m0 = el[k]; i0 = k; }
                int i1 = 0; float m1 = -INFINITY;
#pragma unroll
                for (int k = 0; k < 4; ++k) if (k != i0 && el[k] > m1) { m1 = el[k]; i1 = k; }
                const float e1 = __expf(m1 - m0);
                const float w0 = gval / (1.0f + e1), w1 = gval * e1 / (1.0f + e1);
                int4 ri; ri.x = (gi * 4 + i0) | ((gi * 4 + i1) << 8); ri.y = 0; ri.z = __float_as_int(w0); ri.w = __float_as_int(w1);
                rt[wave * 8 + i] = ri;
            }
        }
        __syncthreads();
        int myE = 0, myL = 0;
        if (tid < 128) { const int4 ri = rt[tid >> 1]; myE = (tid & 1) ? ((ri.x >> 8) & 0xff) : (ri.x & 0xff); myL = (int)atomicAdd(&lcnt[myE], 1u); }
        __syncthreads();
        if (tid < 16) { const unsigned c = lcnt[tid]; lbase[tid] = c ? atomicAdd(p.ctl + CW_CNT + tid * 64, c) : 0u; }
        __syncthreads();
        if (tid < 128) { const int r = tid >> 1, row = rb * 64 + r; const int4 ri = rt[r]; const unsigned pos = lbase[myE] + (unsigned)myL;
            uint2 l; l.x = (unsigned)row; l.y = (unsigned)((tid & 1) ? ri.w : ri.z); *(uint2*)(p.list + ((size_t)myE * MTOK + pos) * 2) = l;
            posl[tid] = pos; }
        __syncthreads();
        if (tid < 64) { int4 ri = rt[tid]; ri.y = (int)(posl[2 * tid] | (posl[2 * tid + 1] << 16)); *(int4*)(p.route + (size_t)(rb * 64 + tid) * 4) = ri; }
        if (tid < 16) lcnt[tid] = 0u;
    }
}

__device__ __forceinline__ void moe_offsets(const P& p, int* arr) {
    __syncthreads();
    if (threadIdx.x == 0) { int o = 0;
        for (int e = 0; e < NEXP; ++e) { const int n = (int)__hip_atomic_load(p.ctl + CW_CNT + e * 64, __ATOMIC_RELAXED, __HIP_MEMORY_SCOPE_AGENT); arr[e] = n; arr[16 + e] = o; arr[33 + e] = o >> 8; o += (n + 255) & ~255; }
        arr[32] = o; arr[33 + 16] = o >> 8; }
    __syncthreads();
}
__device__ __forceinline__ void ph_moe1_naive(const P& p, unsigned char* ldsb, int bid, int nb) {
    float* hs = (float*)ldsb;
    const int tid = threadIdx.x;
    int* cnt = (int*)(ldsb + 65536); int* off = cnt + 16; moe_offsets(p, cnt);
#pragma unroll 1
    for (int e = 0; e < NEXP; ++e) {
        const int n = cnt[e];
#pragma unroll 1
        for (int pb = bid; pb * 8 < n; pb += nb) {
            __syncthreads();
            for (int idx = tid; idx < 8 * 128; idx += NTHR) { const int s = idx >> 7, ch = idx & 127, pos = pb * 8 + s;
                if (pos < n) { const unsigned tok = p.list[((size_t)e * MTOK + pos) * 2]; const v4u v = *(const v4u*)(p.XN + (size_t)tok * 1024 + ch * 8);
                    float* d = hs + s * 1024 + ch * 8; d[0] = bflo(v.x); d[1] = bfhi(v.x); d[2] = bflo(v.y); d[3] = bfhi(v.y); d[4] = bflo(v.z); d[5] = bfhi(v.z); d[6] = bflo(v.w); d[7] = bfhi(v.w); }
                else { float* d = hs + s * 1024 + ch * 8;
#pragma unroll
                    for (int q = 0; q < 8; ++q) d[q] = 0.f; } }
            __syncthreads();
            const int j = tid;
            const bf16* gr = p.W1 + (size_t)e * 1024 * 1024 + (size_t)(256 * (j >> 7) + (j & 127)) * 1024; const bf16* ur = gr + 128 * 1024;
            float ag[8], au[8];
#pragma unroll
            for (int s = 0; s < 8; ++s) { ag[s] = 0.f; au[s] = 0.f; }
            for (int k = 0; k < 1024; k += 8) {
                const v4u g = *(const v4u*)(gr + k), u = *(const v4u*)(ur + k);
                const float gf[8] = {bflo(g.x), bfhi(g.x), bflo(g.y), bfhi(g.y), bflo(g.z), bfhi(g.z), bflo(g.w), bfhi(g.w)};
                const float uf[8] = {bflo(u.x), bfhi(u.x), bflo(u.y), bfhi(u.y), bflo(u.z), bfhi(u.z), bflo(u.w), bfhi(u.w)};
#pragma unroll
                for (int s = 0; s < 8; ++s) {
#pragma unroll
                    for (int q = 0; q < 8; ++q) { const float hv = hs[s * 1024 + k + q]; ag[s] += hv * gf[q]; au[s] += hv * uf[q]; } }
            }
#pragma unroll
            for (int s = 0; s < 8; ++s) { const int pos = pb * 8 + s; if (pos < n) p.HID[(size_t)(off[e] + pos) * 512 + j] = (bf16)f2bf(siluf_(ag[s]) * au[s]); }
        }
    }
}
__device__ __forceinline__ void ph_moe2_naive(const P& p, unsigned char* ldsb, int bid, int nb) {
    float* hs = (float*)ldsb;
    const int tid = threadIdx.x;
    int* cnt = (int*)(ldsb + 65536); int* off = cnt + 16; moe_offsets(p, cnt);
#pragma unroll 1
    for (int e = 0; e < NEXP; ++e) {
        const int n = cnt[e];
#pragma unroll 1
        for (int pb = bid; pb * 8 < n; pb += nb) {
            __syncthreads();
            { const int s = tid >> 6, ch = tid & 63, pos = pb * 8 + s; float* d = hs + s * 512 + ch * 8;
                if (pos < n) { const v4u v = *(const v4u*)(p.HID + (size_t)(off[e] + pos) * 512 + ch * 8);
                    d[0] = bflo(v.x); d[1] = bfhi(v.x); d[2] = bflo(v.y); d[3] = bfhi(v.y); d[4] = bflo(v.z); d[5] = bfhi(v.z); d[6] = bflo(v.w); d[7] = bfhi(v.w); }
                else {
#pragma unroll
                    for (int q = 0; q < 8; ++q) d[q] = 0.f; } }
            __syncthreads();
#pragma unroll 1
            for (int half = 0; half < 2; ++half) {
                const int nn = tid + half * 512;
                const bf16* wr = p.W2 + (size_t)e * 1024 * 512 + (size_t)nn * 512;
                float a[8];
#pragma unroll
                for (int s = 0; s < 8; ++s) a[s] = 0.f;
                for (int k = 0; k < 512; k += 8) {
                    const v4u g = *(const v4u*)(wr + k);
                    const float gf[8] = {bflo(g.x), bfhi(g.x), bflo(g.y), bfhi(g.y), bflo(g.z), bfhi(g.z), bflo(g.w), bfhi(g.w)};
#pragma unroll
                    for (int s = 0; s < 8; ++s) {
#pragma unroll
                        for (int q = 0; q < 8; ++q) a[s] += hs[s * 512 + k + q] * gf[q]; }
                }
#pragma unroll
                for (int s = 0; s < 8; ++s) { const int pos = pb * 8 + s; if (pos < n) { const float w = __uint_as_float(p.list[((size_t)e * MTOK + pos) * 2 + 1]);
                    p.Y[(size_t)(off[e] + pos) * 1024 + nn] = (bf16)f2bf(a[s] * w); } }
            }
        }
    }
}
__device__ __forceinline__ void ph_combine(const P& p, unsigned char* ldsb, int bid, int nb) {
    const int tid = threadIdx.x, lane = tid & 63, wave = tid >> 6;
    int* cnt = (int*)ldsb; int* off = cnt + 16; moe_offsets(p, cnt);
    for (int row = bid * NWAVES + wave; row < MTOK; row += nb * NWAVES) {
        const int4 ri = *(const int4*)(p.route + (size_t)row * 4);
        const size_t s0 = (size_t)(off[ri.x & 0xff] + (ri.y & 0xffff)), s1 = (size_t)(off[(ri.x >> 8) & 0xff] + ((ri.y >> 16) & 0xffff));
        const int b = row / SEQ;
        const float* g2 = p.miscf + MF_MOD + b * 6144 + 5120;
        f32x4* xo = (f32x4*)(p.out + (size_t)row * DM) + lane;
        const v2u* y0 = (const v2u*)(p.Y + s0 * 1024) + lane; const v2u* y1 = (const v2u*)(p.Y + s1 * 1024) + lane;
#pragma unroll
        for (int j = 0; j < 4; ++j) { const int c = (64 * j + lane) * 4; const f32x4 g = *(const f32x4*)(g2 + c); f32x4 v = xo[64 * j]; const v2u a = y0[64 * j], d = y1[64 * j];
            v.x += g.x * (bflo(a.x) + bflo(d.x)); v.y += g.y * (bfhi(a.x) + bfhi(d.x)); v.z += g.z * (bflo(a.y) + bflo(d.y)); v.w += g.w * (bfhi(a.y) + bfhi(d.y)); xo[64 * j] = v; }
    }
}


namespace att {
typedef short bf16x8 __attribute__((ext_vector_type(8)));
typedef short s16x4 __attribute__((ext_vector_type(4)));
typedef float f32x16 __attribute__((ext_vector_type(16)));
typedef unsigned u32x4 __attribute__((ext_vector_type(4)));
constexpr int NSLOT = 3, SLOTB = 16384;
constexpr int LDS_K = 0, LDS_V = NSLOT * SLOTB, LDS_BT = 2 * NSLOT * SLOTB, LDS_WS = LDS_BT + 1536, LDS_END = LDS_WS + 8 * 256;
constexpr int XROW = 132;
__device__ __forceinline__ int crow(int r, int hi) { return (r & 3) + 8 * (r >> 2) + 4 * hi; }
__device__ __forceinline__ s16x4 vtr(const LAS unsigned char* p) { typedef short v4i16_t __attribute__((ext_vector_type(4))); return __builtin_bit_cast(s16x4, __builtin_amdgcn_ds_read_tr16_b64_v4i16((LAS v4i16_t*)p)); }
#define ATT_WAIT_BAR(N) asm volatile("s_waitcnt vmcnt(" #N ") lgkmcnt(0)\n\ts_barrier" ::: "memory")

__device__ __forceinline__ void attn_unit(const P& p, LAS unsigned char* lds, int b, int h, int qb) {
    const int tid = threadIdx.x, lane = tid & 63, r32 = lane & 31, hi = lane >> 5;
    const int wid = __builtin_amdgcn_readfirstlane(tid >> 6), qg = wid & 3, mp = wid >> 2;
    const size_t rowbase = (size_t)b * SEQ;
    const int q0w = qb * 128 + qg * 32;
    const int NT = 2 * qb + 2, myNT = NT - (qg < 2 ? 1 : 0);
    LAS float* bt = (LAS float*)(lds + LDS_BT);
    for (int i = tid; i < 384; i += NTHR) bt[i] = p.miscf[MF_BIAS + h * 384 + i];
    const float cfar = p.miscf[MF_BIAS + h * 384];
    bf16x8 qr[4];
    { const bf16* Qw = p.Q + (rowbase + q0w + r32) * 512 + h * 128 + mp * 64 + hi * 8;
#pragma unroll
      for (int d0 = 0; d0 < 4; ++d0) qr[d0] = *(const bf16x8*)(Qw + d0 * 16); }
    const bf16* ksrc = p.K + (rowbase + lane) * 512 + h * 128 + (2 * wid) * 8;
    const bf16* vsrc = p.V + (rowbase + 16 * (wid & 3) + (lane >> 2)) * 512 + h * 128 + (wid >> 2) * 32 + (lane & 3) * 8;
    const unsigned kdst = LDS_K + (2 * wid) * 1024, vdst = LDS_V + (wid >> 2) * 4096 + (wid & 3) * 1024;
#define ATT_ISSUE(t, so) do { const size_t go_ = (size_t)(t) * 64 * 512; const unsigned so_ = (unsigned)__builtin_amdgcn_readfirstlane(so); \
        __builtin_amdgcn_global_load_lds((const unsigned*)(ksrc + go_), (LAS unsigned*)(lds + kdst + so_), 16, 0, 0); \
        __builtin_amdgcn_global_load_lds((const unsigned*)(ksrc + go_ + 8), (LAS unsigned*)(lds + kdst + 1024 + so_), 16, 0, 0); \
        __builtin_amdgcn_global_load_lds((const unsigned*)(vsrc + go_), (LAS unsigned*)(lds + vdst + so_), 16, 0, 0); \
        __builtin_amdgcn_global_load_lds((const unsigned*)(vsrc + go_ + 64), (LAS unsigned*)(lds + vdst + 8192 + so_), 16, 0, 0); } while (0)
    ATT_ISSUE(0, 0); ATT_ISSUE(1, SLOTB);
    f32x16 o[4];
#pragma unroll
    for (int d0 = 0; d0 < 4; ++d0) o[d0] = (f32x16){0.f, 0.f, 0.f, 0.f, 0.f, 0.f, 0.f, 0.f, 0.f, 0.f, 0.f, 0.f, 0.f, 0.f, 0.f, 0.f};
    float l_reg = 0.f;
    const LAS unsigned char* kp0 = lds + LDS_K + mp * 8192 + hi * 1024 + r32 * 16;
    const LAS unsigned char* vp0 = lds + LDS_V + ((lane >> 4) & 1) * 32 + (lane & 3) * 8 + (4 * hi + ((lane & 15) >> 2)) * 64;
    int slot = 0;
#pragma unroll 1
    for (int t = 0; t < NT; ++t) {
        if (t + 1 < NT) { ATT_WAIT_BAR(4); } else { ATT_WAIT_BAR(0); }
        { const int s2 = slot == 0 ? 2 * SLOTB : slot - SLOTB;
          if (t + 2 < NT) ATT_ISSUE(t + 2, s2); }
        if (t < myNT) {
            const LAS unsigned char* kp = kp0 + slot; const LAS unsigned char* vp = vp0 + slot;
            const bool nearb = (t * 64 + 63 - q0w) > -91;
            const float ci = nearb ? 0.f : cfar;
            f32x16 c0, c1;
#pragma unroll
            for (int r = 0; r < 16; ++r) { c0[r] = ci; c1[r] = ci; }
#pragma unroll
            for (int d0 = 0; d0 < 4; ++d0) {
                const bf16x8 k0 = *(const LAS bf16x8*)(kp + d0 * 2048), k1 = *(const LAS bf16x8*)(kp + d0 * 2048 + 512);
                c0 = __builtin_amdgcn_mfma_f32_32x32x16_bf16(k0, qr[d0], c0, 0, 0, 0);
                c1 = __builtin_amdgcn_mfma_f32_32x32x16_bf16(k1, qr[d0], c1, 0, 0, 0);
            }
            if (nearb) {
                const LAS float* bp = bt + (t * 64 - q0w - r32 + 256 + 4 * hi);
#pragma unroll
                for (int r = 0; r < 16; ++r) { const int cr = (r & 3) + 8 * (r >> 2); c0[r] += bp[cr]; c1[r] += bp[cr + 32]; }
            }
            float sacc = 0.f;
#pragma unroll
            for (int r = 0; r < 16; ++r) { c0[r] = __builtin_amdgcn_exp2f(c0[r]); c1[r] = __builtin_amdgcn_exp2f(c1[r]); sacc += c0[r] + c1[r]; }
            l_reg += sacc;
            u32x4 pw[4];
#pragma unroll
            for (int j = 0; j < 4; ++j) { pw[0][j] = pg8::cvt_pk_bf16(c0[2 * j], c0[2 * j + 1]); pw[1][j] = pg8::cvt_pk_bf16(c0[8 + 2 * j], c0[9 + 2 * j]);
                                          pw[2][j] = pg8::cvt_pk_bf16(c1[2 * j], c1[2 * j + 1]); pw[3][j] = pg8::cvt_pk_bf16(c1[8 + 2 * j], c1[9 + 2 * j]); }
#pragma unroll
            for (int d0 = 0; d0 < 4; ++d0)
#pragma unroll
                for (int ks = 0; ks < 4; ++ks) {
                    const s16x4 lo = vtr(vp + d0 * 4096 + ks * 1024), hh = vtr(vp + d0 * 4096 + ks * 1024 + 512);
                    const bf16x8 vf = (bf16x8){lo[0], lo[1], lo[2], lo[3], hh[0], hh[1], hh[2], hh[3]};
                    o[d0] = __builtin_amdgcn_mfma_f32_32x32x16_bf16(__builtin_bit_cast(bf16x8, pw[ks]), vf, o[d0], 0, 0, 0);
                }
        }
        slot = slot == 2 * SLOTB ? 0 : slot + SLOTB;
    }
#undef ATT_ISSUE
    l_reg += __shfl_xor(l_reg, 32);
    LAS float* wsf = (LAS float*)(lds + LDS_WS) + wid * 64;
    { const float lam = p.miscf[MF_LAM]; if (hi == 0) wsf[r32] = (mp == 0 ? 1.0f : lam) / l_reg; }
    asm volatile("s_waitcnt lgkmcnt(0)" ::: "memory");
#pragma unroll
    for (int r = 0; r < 16; ++r) { const float f = wsf[crow(r, hi)];
#pragma unroll
        for (int d0 = 0; d0 < 4; ++d0) o[d0][r] *= f; }
    ATT_WAIT_BAR(0);
    LAS float* X = (LAS float*)lds + qg * 32 * XROW;
    if (mp == 1) {
#pragma unroll
        for (int d0 = 0; d0 < 4; ++d0)
#pragma unroll
            for (int r = 0; r < 16; ++r) X[crow(r, hi) * XROW + d0 * 32 + r32] = o[d0][r];
    }
    ATT_WAIT_BAR(0);
    if (mp == 0) {
#pragma unroll
        for (int d0 = 0; d0 < 4; ++d0)
#pragma unroll
            for (int r = 0; r < 16; ++r) { LAS float* xp = X + crow(r, hi) * XROW + d0 * 32 + r32; *xp = o[d0][r] - *xp; }
        asm volatile("s_waitcnt lgkmcnt(0)" ::: "memory");
        const int row = lane >> 1, half = lane & 1;
        const LAS float* xr = X + row * XROW + half * 64;
        f32x4 v[16]; float ss = 0.f;
#pragma unroll
        for (int i = 0; i < 16; ++i) { v[i] = *(const LAS f32x4*)(xr + 4 * i); ss += v[i].x * v[i].x + v[i].y * v[i].y + v[i].z * v[i].z + v[i].w * v[i].w; }
        ss += __shfl_xor(ss, 1);
        const float rs = __builtin_amdgcn_rsqf(ss * (1.0f / 128.0f) + RMS_EPS) * (1.0f - LAMBDA_INIT);
        const float* gp = p.subln_g + half * 64;
        bf16* op = p.AB + (rowbase + q0w + row) * 1024 + h * 128 + half * 64;
#pragma unroll
        for (int i = 0; i < 8; ++i) { const f32x4 g0 = *(const f32x4*)(gp + 8 * i), g1 = *(const f32x4*)(gp + 8 * i + 4); const f32x4 a = v[2 * i] * rs * g0, c = v[2 * i + 1] * rs * g1;
            u32x4 w; w.x = pg8::cvt_pk_bf16(a.x, a.y); w.y = pg8::cvt_pk_bf16(a.z, a.w); w.z = pg8::cvt_pk_bf16(c.x, c.y); w.w = pg8::cvt_pk_bf16(c.z, c.w); *(u32x4*)(op + 8 * i) = w; }
    }
    ATT_WAIT_BAR(0);
}
#undef ATT_WAIT_BAR
}
__device__ __forceinline__ void ph_attn(const P& p, LAS unsigned char* lds, int bid, int nb) {
    const int vcu = (bid % 8) * (nb / 8) + bid / 8;
    for (int v = vcu; v < 256; v += nb) {
        const int bh = v >> 5, s = v & 31;
        att::attn_unit(p, lds, bh >> 2, bh & 3, 63 - s);
        att::attn_unit(p, lds, bh >> 2, bh & 3, s);
    }
}


__device__ __forceinline__ void ph_pool(const P& p, int bid, int nb) {
    const int tid = threadIdx.x, lane = tid & 63, wave = tid >> 6;
    const int g = lane >> 4, w = 2 << g;
    for (int row = bid * NWAVES + wave; row < MTOK; row += nb * NWAVES) {
        const int t = row % SEQ, cnt = t + 1 < w ? t + 1 : w;
        const bf16* up = p.U + (size_t)row * 512 + lane * 8;
        float s[8];
#pragma unroll
        for (int q = 0; q < 8; ++q) s[q] = 0.f;
        v4u cur = *(const v4u*)up;
        for (int jj = 0; jj < cnt; ++jj) { const v4u v = *(const v4u*)(up - (size_t)jj * 512);
            s[0] += bflo(v.x); s[1] += bfhi(v.x); s[2] += bflo(v.y); s[3] += bfhi(v.y); s[4] += bflo(v.z); s[5] += bfhi(v.z); s[6] += bflo(v.w); s[7] += bfhi(v.w); }
        const float ic = 1.0f / (float)cnt;
        v4u o; o.x = pk2(s[0] * ic - bflo(cur.x), s[1] * ic - bfhi(cur.x)); o.y = pk2(s[2] * ic - bflo(cur.y), s[3] * ic - bfhi(cur.y));
        o.z = pk2(s[4] * ic - bflo(cur.z), s[5] * ic - bfhi(cur.z)); o.w = pk2(s[6] * ic - bflo(cur.w), s[7] * ic - bfhi(cur.w));
        *(v4u*)(p.AB + (size_t)row * 1024 + 512 + lane * 8) = o;
    }
}

struct BranchOrder {
    pg8::StaticOrder so;
    __device__ bool next(int i, pg8::Unit& u) const { if (!so.tile((long)(i >> 1) * so.G + so.c, u)) return false; u.aux = i & 1; u.a_off += (unsigned)(i & 1) * 1024u; u.b_off += (unsigned)(i & 1) * 1024u; return true; }
    __device__ unsigned row_off(const pg8::Unit&, int) const { return 0u; }
};
__device__ __forceinline__ void ph_inproj(const P& p, LAS unsigned char* lds, int bid, int nb) {
    pg8::Gemm g{p.XN, p.WIN, 1024, 1024, 16};
    pg8::StaticOrder S; S.init(MTOK, DIN, 1024, 1024, nb, bid);
    pg8::EpiIn E{p.Q, p.K, p.V, p.U, p.GA, p.GP, p.q_norm_g, p.k_norm_g};
    pg8::gemm_phase<pg8::EpiIn, pg8::StaticOrder, false>(lds, g, S, E);
}
__device__ __forceinline__ void ph_branch(const P& p, LAS unsigned char* lds, int bid, int nb) {
    pg8::Gemm g{p.AB, p.WBR, 1024, 1024, 8};
    BranchOrder S; S.so.init(MTOK, DM, 1024, 1024, nb, bid);
    pg8::EpiBranch E{p.XN, p.GA, p.GP};
    pg8::gemm_phase<pg8::EpiBranch, BranchOrder, false>(lds, g, S, E);
}
__device__ __forceinline__ void ph_wout(const P& p, LAS unsigned char* lds, int bid, int nb) {
    pg8::Gemm g{p.XN, p.WOUT, 1024, 1024, 16};
    pg8::StaticOrder S; S.init(MTOK, DM, 1024, 1024, nb, bid);
    pg8::EpiOut E{p.x, p.miscf + MF_MOD, p.out};
    pg8::gemm_phase<pg8::EpiOut, pg8::StaticOrder, false>(lds, g, S, E);
}


struct MoeOrder {
    const LAS int* arr; const unsigned* list; int G, vcu, npn; unsigned bstride, tB, tA;
    __device__ bool next(int i, pg8::Unit& u) const {
        const int L = i * G + vcu, T = arr[33 + 16]; if (L >= T * npn) return false;
        const int tile = L / npn, pn = L % npn; int e = 0;
#pragma unroll
        for (int k = 1; k < 16; ++k) e += (arr[33 + k] <= tile) ? 1 : 0;
        const int mt = tile - arr[33 + e];
        u.aux = e; u.pn = pn; u.pm = tile; u.n = arr[e]; u.pos0 = mt * 256; u.a_off = (unsigned)tile * tA; u.b_off = (unsigned)e * bstride + (unsigned)pn * tB; return true;
    }
    __device__ unsigned row_off(const pg8::Unit& u, int r) const { int pos = u.pos0 + r; pos = pos < u.n ? pos : u.n - 1; return list[((size_t)u.aux * 16384 + pos) * 2] * 2048u; }
};
__device__ __forceinline__ void ph_moe1(const P& p, LAS unsigned char* lds, unsigned char* ldsg, int bid, int nb) {
    int* arr = (int*)(ldsg + 131072); moe_offsets(p, arr);
    pg8::Gemm g{p.XN, p.W1, 1024, 1024, 16};
    MoeOrder S{(const LAS int*)(lds + 131072), p.list, nb, (bid % 8) * (nb / 8) + bid / 8, 4, 1024u * 1024u * 2u, 256u * 1024u * 2u, 0u};
    pg8::EpiMoe1 E{p.HID};
    pg8::gemm_phase<pg8::EpiMoe1, MoeOrder, true>(lds, g, S, E);
}
__device__ __forceinline__ void ph_moe2(const P& p, LAS unsigned char* lds, unsigned char* ldsg, int bid, int nb) {
    int* arr = (int*)(ldsg + 131072); moe_offsets(p, arr);
    pg8::Gemm g{p.HID, p.W2, 512, 512, 8};
    MoeOrder S{(const LAS int*)(lds + 131072), p.list, nb, (bid % 8) * (nb / 8) + bid / 8, 4, 1024u * 512u * 2u, 256u * 512u * 2u, 256u * 512u * 2u};
    pg8::EpiMoe2 E{p.Y, p.list};
    pg8::gemm_phase<pg8::EpiMoe2, MoeOrder, false>(lds, g, S, E);
}

constexpr int N_PHASES = 11;
__global__ void __launch_bounds__(NTHR, 2) mega_fwd(Args args) {
    extern __shared__ __attribute__((aligned(16))) unsigned char lds[];
    P p;
    p.x = args.in[0]; p.c = args.in[1]; p.rel_bias = args.in[2]; p.ada_w = args.in[3]; p.ada_b = args.in[4]; p.norm1_g = args.in[5]; p.w_in = args.in[6]; p.q_norm_g = args.in[7]; p.k_norm_g = args.in[8];
    p.lq1 = args.in[9]; p.lk1 = args.in[10]; p.lq2 = args.in[11]; p.lk2 = args.in[12]; p.subln_g = args.in[13]; p.wba = args.in[14]; p.pool_w = args.in[15]; p.pool_scale = args.in[16]; p.wbp = args.in[17];
    p.w_out = args.in[18]; p.norm2_g = args.in[19]; p.rgw = args.in[20]; p.rgb = args.in[21]; p.rew = args.in[22]; p.reb = args.in[23]; p.wgate = args.in[24]; p.wup = args.in[25]; p.wdown = args.in[26];
    p.out = args.out; p.ws = args.ws;
    unsigned char* ws = args.ws;
    p.ctl = (unsigned*)(ws + WS_CTL); p.miscf = (float*)(ws + WS_MISC); p.list = (unsigned*)(ws + WS_LIST); p.route = (int*)(ws + WS_ROUTE);
    p.WIN = (bf16*)(ws + WS_WIN); p.WBR = (bf16*)(ws + WS_WBR); p.WOUT = (bf16*)(ws + WS_WOUT); p.W1 = (bf16*)(ws + WS_W1); p.W2 = (bf16*)(ws + WS_W2);
    p.XN = (bf16*)(ws + WS_XN); p.Q = (bf16*)(ws + WS_Q); p.K = (bf16*)(ws + WS_K); p.V = (bf16*)(ws + WS_V); p.U = (bf16*)(ws + WS_U); p.GA = (bf16*)(ws + WS_GA); p.GP = (bf16*)(ws + WS_GP);
    p.AB = (bf16*)(ws + WS_AB); p.HID = (bf16*)(ws + WS_HID); p.Y = (bf16*)(ws + WS_Y);
    const int bid = blockIdx.x, nb = gridDim.x;
    const int lo = args.ph_lo, hi = args.ph_hi;
    volatile LAS unsigned* MISC = (volatile LAS unsigned*)((LAS unsigned char*)lds + LDS_BYTES - 64);
    XcdBarrier bar; bar.bar = p.ctl + CW_BAR; bar.x = 0; bar.st = nullptr;
    if (hi - lo > 1) {
        if (threadIdx.x < 2) MISC[threadIdx.x] = 0u;
        __syncthreads();
        bar = xcd_barrier_post(p.ctl + CW_BAR, MISC);
    }
#ifndef PHASE_MASK
#define PHASE_MASK 0xFFFF
#endif
#define IN(k) (((PHASE_MASK >> (k)) & 1) && lo <= (k) && (k) < hi)
#define SEAM(k) do { if (IN(k) && IN((k) + 1)) xcd_barrier(bar); } while (0)
    if (IN(0)) { for (int rp = 0; rp < NREP(0); ++rp) { ph_prologue(p, lds, bid, nb); __syncthreads(); } } SEAM(0);
    if (IN(1)) { for (int rp = 0; rp < NREP(1); ++rp) { ph_norm1(p, lds, bid, nb); __syncthreads(); } } SEAM(1);
#if FAST_INPROJ == 2
    if (IN(2)) { ph_inproj_naive(p, lds, bid, nb); } SEAM(2);
    if (IN(3)) { ph_qknorm_naive(p, bid, nb); __syncthreads(); ph_inproj(p, (LAS unsigned char*)lds, bid, nb); } SEAM(3);
#elif FAST_INPROJ
    if (IN(2)) { for (int rp = 0; rp < NREP(2); ++rp) ph_inproj(p, (LAS unsigned char*)lds, bid, nb); } SEAM(2);
#else
    if (IN(2)) { ph_inproj_naive(p, lds, bid, nb); } SEAM(2);
    if (IN(3)) { ph_qknorm_naive(p, bid, nb); } SEAM(3);
#endif
#if FAST_ATTN
    if (IN(4)) { for (int rp = 0; rp < NREP(4); ++rp) ph_attn(p, (LAS unsigned char*)lds, bid, nb); __syncthreads(); for (int rp = 0; rp < NREP(11); ++rp) { ph_pool(p, bid, nb); } } SEAM(4);
#else
    if (IN(4)) { ph_attn_naive(p, lds, bid, nb); __syncthreads(); ph_pool_naive(p, lds, bid, nb); } SEAM(4);
#endif
#if FAST_BRANCH
    if (IN(5)) { for (int rp = 0; rp < NREP(5); ++rp) ph_branch(p, (LAS unsigned char*)lds, bid, nb); } SEAM(5);
#else
    if (IN(5)) { ph_branch_naive(p, lds, bid, nb); } SEAM(5);
#endif
#if FAST_WOUT
    if (IN(6)) { for (int rp = 0; rp < NREP(6); ++rp) ph_wout(p, (LAS unsigned char*)lds, bid, nb); } SEAM(6);
#else
    if (IN(6)) { ph_wout_naive(p, lds, bid, nb); } SEAM(6);
#endif
    if (IN(7)) { ph_norm2_route(p, lds, bid, nb); } SEAM(7);
#if FAST_MOE
    if (IN(8)) { for (int rp = 0; rp < NREP(8); ++rp) ph_moe1(p, (LAS unsigned char*)lds, lds, bid, nb); } SEAM(8);
    if (IN(9)) { for (int rp = 0; rp < NREP(9); ++rp) ph_moe2(p, (LAS unsigned char*)lds, lds, bid, nb); } SEAM(9);
#else
    if (IN(8)) { ph_moe1_naive(p, lds, bid, nb); } SEAM(8);
    if (IN(9)) { ph_moe2_naive(p, lds, bid, nb); } SEAM(9);
#endif
    if (IN(10)) { ph_combine(p, lds, bid, nb); }
#undef IN
#undef SEAM
}

extern "C" void kernel_launch(void* const* d_in, const int* in_sizes, int n_in, void* d_out, int out_size, void* d_ws, size_t ws_size, hipStream_t stream) {
    static int grid = 0;
    if (grid == 0) {
        if (n_in != 27 || in_sizes[0] != MTOK * DM || out_size != MTOK * DM || ws_size < WS_END) {
            fprintf(stderr, "kernel_launch: unexpected shapes: n_in %d in0 %d out %d ws %zu; nothing launched\n", n_in, n_in > 0 ? in_sizes[0] : -1, out_size, ws_size); grid = -1; return; }
        int dev = 0, cus = 0;
        if (hipGetDevice(&dev) != hipSuccess || hipDeviceGetAttribute(&cus, hipDeviceAttributeMultiprocessorCount, dev) != hipSuccess) { grid = -1; return; }
        if (hipFuncSetAttribute((const void*)mega_fwd, hipFuncAttributeMaxDynamicSharedMemorySize, LDS_BYTES) != hipSuccess) { fprintf(stderr, "kernel_launch: hipFuncSetAttribute failed\n"); grid = -1; return; }
        int per_cu = 0;
        if (hipOccupancyMaxActiveBlocksPerMultiprocessor(&per_cu, (const void*)mega_fwd, NTHR, LDS_BYTES) != hipSuccess || per_cu < 1)
            fprintf(stderr, "kernel_launch: note: occupancy query reports %d workgroups per CU\n", per_cu);
        (void)hipGetLastError();
        grid = cus;
    }
    if (grid < 0) return;
    (void)hipMemsetAsync((char*)d_ws + WS_CTL, 0, CTL_ZERO_BYTES, stream);
    Args a{};
    for (int i = 0; i < 27; ++i) a.in[i] = (const float*)d_in[i];
    a.out = (float*)d_out; a.ws = (unsigned char*)d_ws;
    if (MK_N_LAUNCHES == 1) {
        a.ph_lo = 0; a.ph_hi = N_PHASES;
        hipLaunchKernelGGL(mega_fwd, dim3(grid), dim3(NTHR), LDS_BYTES, stream, a);
    } else {
        for (int k = 0; k < N_PHASES; ++k) { a.ph_lo = k; a.ph_hi = k + 1; hipLaunchKernelGGL(mega_fwd, dim3(grid), dim3(NTHR), LDS_BYTES, stream, a); }
    }
}
```

```cpp
#include <hip/hip_runtime.h>
#include <cstdio>
#include <cstdint>
#include <cmath>

#define FAST_INPROJ 1
#define FAST_BRANCH 1
#define FAST_WOUT 1
#define FAST_MOE 1
#define FAST_ATTN 1
#ifndef ATT_PROBE
#define ATT_PROBE 0
#endif
#ifndef REP_PHASE
#define REP_PHASE -1
#endif
#define NREP(k) ((REP_PHASE) == (k) ? 2 : 1)
#ifndef MK_N_LAUNCHES
#define MK_N_LAUNCHES 1
#endif

#define GAS __attribute__((address_space(1)))
#define LAS __attribute__((address_space(3)))
typedef unsigned short bf16;
typedef unsigned v4u __attribute__((ext_vector_type(4)));
typedef unsigned v2u __attribute__((ext_vector_type(2)));
typedef float f32x4 __attribute__((ext_vector_type(4)));

constexpr int NB = 2, SEQ = 8192, DM = 1024, MTOK = NB * SEQ, DIN = 4096, DATT = 512, DPOOL = 512, NEXP = 16, DEXP = 512;
constexpr int NHEAD = 4, HD = 64;
constexpr float RMS_EPS = 1e-6f;
constexpr float LOG2E = 1.4426950408889634f;
constexpr float LAMBDA_INIT = 0.2f;
constexpr int NWAVES = 8, NTHR = 512;
constexpr int LDS_BYTES = 147456;
constexpr int MOE_ROWS = 36864;

constexpr size_t MiB = 1u << 20;
constexpr size_t WS_CTL = 0, CTL_ZERO_BYTES = 1 * MiB;
constexpr size_t WS_MISC = 1 * MiB;
constexpr size_t WS_LIST = 2 * MiB;
constexpr size_t WS_ROUTE = WS_MISC + 512 * 1024;
constexpr size_t WS_WIN = 4 * MiB, WS_WBR = 12 * MiB, WS_WOUT = 14 * MiB, WS_W1 = 16 * MiB, WS_W2 = 48 * MiB;
constexpr size_t WS_XN = 64 * MiB;
constexpr size_t WS_Q = 96 * MiB, WS_K = 112 * MiB, WS_V = 128 * MiB, WS_U = 144 * MiB, WS_GA = 160 * MiB, WS_GP = 192 * MiB;
constexpr size_t WS_AB = 224 * MiB;
constexpr size_t WS_HID = 96 * MiB, WS_Y = 132 * MiB;
constexpr size_t WS_END = 256 * MiB;
constexpr int MF_LAM = 0, MF_BIAS = 64  , MF_MOD = 2048  , MF_MODP = 16384  ;
constexpr int MOD_SPLITS = 8;
constexpr int CW_CNT = 64;
constexpr int CW_BAR = 4096;

struct Args { const float* in[27]; float* out; unsigned char* ws; int ph_lo, ph_hi; };

struct P {
    const float *x, *c, *rel_bias, *ada_w, *ada_b, *norm1_g, *w_in, *q_norm_g, *k_norm_g, *lq1, *lk1, *lq2, *lk2, *subln_g, *wba, *pool_w, *pool_scale, *wbp, *w_out, *norm2_g,
        *rgw, *rgb, *rew, *reb, *wgate, *wup, *wdown;
    float* out; unsigned char* ws;
    unsigned* ctl; float* miscf; unsigned* list; int* route;
    bf16 *WIN, *WBR, *WOUT, *W1, *W2, *XN, *Q, *K, *V, *U, *GA, *GP, *AB, *HID, *Y;
};

__device__ __forceinline__ unsigned f2bf(float f) { unsigned u = __float_as_uint(f); return (u + 0x7fffu + ((u >> 16) & 1u)) >> 16; }
__device__ __forceinline__ unsigned pk2(float lo, float hi) { return f2bf(lo) | (f2bf(hi) << 16); }
__device__ __forceinline__ float bf2f(unsigned h) { return __uint_as_float(h << 16); }
__device__ __forceinline__ float bflo(unsigned w) { return __uint_as_float(w << 16); }
__device__ __forceinline__ float bfhi(unsigned w) { return __uint_as_float(w & 0xffff0000u); }
__device__ __forceinline__ float wave_sum(float v) {
#pragma unroll
    for (int o = 1; o < 64; o <<= 1) v += __shfl_xor(v, o);
    return v;
}
__device__ __forceinline__ float wave_max(float v) {
#pragma unroll
    for (int o = 1; o < 64; o <<= 1) v = fmaxf(v, __shfl_xor(v, o));
    return v;
}
__device__ __forceinline__ float sigmoidf_(float v) { return 1.0f / (1.0f + __expf(-v)); }
__device__ __forceinline__ float siluf_(float v) { return v / (1.0f + __expf(-v)); }
__device__ __forceinline__ int t5_bucket(int rel) {
    int n = rel < 0 ? -rel : rel;
    int b;
    if (n < 8) b = n; else if (n < 12) b = 8; else if (n < 16) b = 9; else if (n < 23) b = 10; else if (n < 32) b = 11; else if (n < 46) b = 12; else if (n < 64) b = 13; else if (n < 91) b = 14; else b = 15;
    return b + (rel > 0 ? 16 : 0);
}

#define XB_TMO      128
#define XB_XCNT(j)  (256  + 64 * (j))
#define XB_XSUB(j)  (1280 + 64 * (j))
#define XB_XGEN(j)  (2304 + 64 * (j))
#define XB_TOP      3328
#define XB_TOPGEN   3392
#define XCD_BAR_WORDS 3456
#define XB_SPIN_CAP (1u << 18)
__device__ __forceinline__ unsigned xb_ld(unsigned* p)              { return __hip_atomic_load(p, __ATOMIC_RELAXED, __HIP_MEMORY_SCOPE_AGENT); }
__device__ __forceinline__ unsigned xb_add(unsigned* p, unsigned v) { return __hip_atomic_fetch_add(p, v, __ATOMIC_RELAXED, __HIP_MEMORY_SCOPE_AGENT); }
__device__ __forceinline__ unsigned xb_xcc_id() { return (unsigned)__builtin_amdgcn_s_getreg((3 << 11) | 20) & 0xFu; }
#define XB_SPIN(cond, bar) do { unsigned _sp = 0; while (cond) { __builtin_amdgcn_s_sleep(1); \
    if ((++_sp & 255u) == 0u) { if (xb_ld(&(bar)[XB_TMO])) break; if (_sp > XB_SPIN_CAP) { atomicAdd(&(bar)[XB_TMO], 1u); break; } } } } while (0)
struct XcdBarrier { unsigned* bar; unsigned x; volatile LAS unsigned* st; };
__device__ __forceinline__ XcdBarrier xcd_barrier_post(unsigned* bar, volatile LAS unsigned* st) {
    XcdBarrier b; b.bar = bar; b.x = xb_xcc_id(); b.st = st;
    if (threadIdx.x == 0) (void)xb_add(&bar[XB_XCNT(b.x)], 1u);
    return b;
}
__device__ __forceinline__ void xcd_barrier_complete(unsigned* bar, unsigned x, unsigned& nloc, unsigned& nx) {
    const unsigned G = gridDim.x * gridDim.y * gridDim.z;
    unsigned sum, cnt, mine, sp = 0u;
    for (;;) {
        sum = 0u; cnt = 0u; mine = 0u;
#pragma unroll
        for (unsigned j = 0; j < 16; ++j) { const unsigned c = xb_ld(&bar[XB_XCNT(j)]); sum += c; cnt += (c > 0u) ? 1u : 0u; mine = (j == x) ? c : mine; }
        if (sum == G) break;
        __builtin_amdgcn_s_sleep(1);
        if ((++sp & 255u) == 0u) { if (xb_ld(&bar[XB_TMO])) break; if (sp > XB_SPIN_CAP) { atomicAdd(&bar[XB_TMO], 1u); break; } }
    }
    nloc = mine > 0u ? mine : 1u; nx = cnt > 0u ? cnt : 1u;
}
__device__ __forceinline__ void xcd_barrier(const XcdBarrier& b) {
    asm volatile("s_waitcnt vmcnt(0)" ::: "memory");
    __syncthreads();
    if (threadIdx.x == 0) {
        unsigned* bar = b.bar;
        __builtin_amdgcn_s_waitcnt(0);
        unsigned nloc = b.st[0], nx = b.st[1];
        if (nloc == 0u) { xcd_barrier_complete(bar, b.x, nloc, nx); b.st[0] = nloc; b.st[1] = nx; }
        const unsigned old = xb_add(&bar[XB_XSUB(b.x)], 1u);
        const unsigned gen = old / nloc;
        if (old + 1u == (gen + 1u) * nloc) {
            __builtin_amdgcn_fence(__ATOMIC_RELEASE, "agent");
            asm volatile("s_waitcnt vmcnt(0)" ::: "memory");
            const unsigned og = xb_add(&bar[XB_TOP], 1u);
            const unsigned tg = og / nx;
            if (og + 1u == (tg + 1u) * nx) xb_add(&bar[XB_TOPGEN], 1u);
            else XB_SPIN(xb_ld(&bar[XB_TOPGEN]) == tg, bar);
            __builtin_amdgcn_fence(__ATOMIC_ACQUIRE, "agent");
            xb_add(&bar[XB_XGEN(b.x)], 1u);
            asm volatile("s_waitcnt vmcnt(0)" ::: "memory");
        } else {
            XB_SPIN(xb_ld(&bar[XB_XGEN(b.x)]) == gen, bar);
            __builtin_amdgcn_fence(__ATOMIC_ACQUIRE, "agent");
            asm volatile("s_waitcnt vmcnt(0)" ::: "memory");
        }
    }
    __syncthreads();
}


namespace pg8 {
#define PG8_LAS __attribute__((address_space(3)))
typedef unsigned short bf16_t;
typedef short bf16x8 __attribute__((ext_vector_type(8)));
typedef float f32x4 __attribute__((ext_vector_type(4)));
typedef unsigned u32x4 __attribute__((ext_vector_type(4)));
constexpr int BM = 256, BK = 64, HALF = 128, HTB = HALF * BK * 2, STAGE_BYTES = 8 * HTB, NXCD = 8, WGM = 8;
__host__ __device__ __forceinline__ int lds_byte(int r, int c) { const int st = (r >> 4) * 2 + (c >> 5), rr = r & 15, cc = c & 31, ob = rr * 64 + cc * 2; return st * 1024 + (ob ^ (((ob >> 9) & 1) << 5)); }
__host__ __device__ __forceinline__ void stage_rc(int b, int& R, int& C) { const int st = b / 1024, sb = b % 1024, swz = sb ^ (((sb >> 9) & 1) << 5); R = (st >> 1) * 16 + swz / 64; C = (st & 1) * 32 + (swz % 64) / 2; }
__host__ __device__ __forceinline__ int perm32(int rho) { const int n = rho >> 4, i = rho & 15; return 8 * (i >> 2) + 4 * n + (i & 3); }

struct Unit { int pm, pn, aux, n, pos0; unsigned a_off, b_off; };
struct Gemm { const bf16_t* A; const bf16_t* Bt; int lda, ldb, nt; };

struct StaticOrder {
    int nM, nN, nwg, G, c; unsigned tA, tB;
    __device__ void init(int M, int N, int lda, int ldb, int G_, int c_) { nM = M / BM; nN = N / BM; nwg = nM * nN; G = G_; c = c_; tA = (unsigned)(BM * lda * 2); tB = (unsigned)(BM * ldb * 2); }
    __device__ bool tile(long L, Unit& u) const {
        if (L >= nwg) return false;
        int wgid = (int)L; { const int q = nwg / NXCD, r = nwg % NXCD, xcd = wgid % NXCD, off = wgid / NXCD; wgid = (xcd < r ? xcd * (q + 1) : r * (q + 1) + (xcd - r) * q) + off; }
        const int nig = WGM * nN, gid = wgid / nig, fm = gid * WGM, gsz = (nM - fm) < WGM ? (nM - fm) : WGM;
        u.pm = fm + ((wgid % nig) % gsz); u.pn = (wgid % nig) / gsz; u.aux = 0; u.n = 0; u.pos0 = 0; u.a_off = (unsigned)u.pm * tA; u.b_off = (unsigned)u.pn * tB; return true;
    }
    __device__ bool next(int i, Unit& u) const { return tile((long)i * G + c, u); }
    __device__ unsigned row_off(const Unit&, int) const { return 0u; }
};

typedef float f32x2_t __attribute__((ext_vector_type(2))); typedef __bf16 bf16x2_t __attribute__((ext_vector_type(2)));
__device__ __forceinline__ unsigned cvt_pk_bf16(float lo, float hi) { f32x2_t v = {lo, hi}; bf16x2_t b = __builtin_convertvector(v, bf16x2_t); return __builtin_bit_cast(unsigned, b); }
__device__ __forceinline__ float bflo_(unsigned w) { return __uint_as_float(w << 16); }
__device__ __forceinline__ float bfhi_(unsigned w) { return __uint_as_float(w & 0xffff0000u); }
__device__ __forceinline__ float sigm(float v) { return __builtin_amdgcn_rcpf(1.0f + __builtin_amdgcn_exp2f(-1.4426950408889634f * v)); }
__device__ __forceinline__ u32x4 pack8(const f32x4 v0, const f32x4 v1) { u32x4 w; w.x = cvt_pk_bf16(v0[0], v0[1]); w.y = cvt_pk_bf16(v0[2], v0[3]); w.z = cvt_pk_bf16(v1[0], v1[1]); w.w = cvt_pk_bf16(v1[2], v1[3]); return w; }


struct EpiIn {
    static constexpr bool PERM = true;
    bf16_t *Q, *K, *V, *U, *GA, *GP; const float *qg, *kg;
    __device__ __forceinline__ void operator()(const f32x4 (&acc)[2][2][4][2], const Unit& u, int wr, int wc, int fr, int fq) const {
        const int row0 = u.pm * BM + wr * 64 + fr, pn = u.pn;
#ifdef EPI_MASK
        if (!((EPI_MASK >> pn) & 1)) return;
#endif
        if (pn < 4) {
            const bool isq = pn < 2; bf16_t* base = (isq ? Q : K) + 256 * (pn & 1) + 64 * wc + 8 * fq; const float* gp = isq ? qg : kg; const float sc = isq ? 0.125f * 1.4426950408889634f : 1.0f;
            f32x4 gv[2][2];
#pragma unroll
            for (int bj = 0; bj < 2; ++bj)
#pragma unroll
                for (int n = 0; n < 2; ++n) gv[bj][n] = *(const f32x4*)(gp + 32 * bj + 8 * fq + 4 * n) * sc;
#pragma unroll
            for (int ai = 0; ai < 2; ++ai)
#pragma unroll
                for (int m = 0; m < 4; ++m) {
                    float ss = 0.f;
#pragma unroll
                    for (int bj = 0; bj < 2; ++bj)
#pragma unroll
                        for (int n = 0; n < 2; ++n) { const f32x4 x = acc[ai][bj][m][n]; ss += (x[0] * x[0] + x[1] * x[1]) + (x[2] * x[2] + x[3] * x[3]); }
                    ss += __shfl_xor(ss, 16); ss += __shfl_xor(ss, 32);
                    const float rstd = __builtin_amdgcn_rsqf(ss * (1.0f / 64.0f) + 1e-6f);
                    bf16_t* rowp = base + (size_t)(row0 + ai * HALF + m * 16) * 512;
#pragma unroll
                    for (int bj = 0; bj < 2; ++bj) *(u32x4*)(rowp + 32 * bj) = pack8(acc[ai][bj][m][0] * rstd * gv[bj][0], acc[ai][bj][m][1] * rstd * gv[bj][1]);
                }
        } else if (pn < 6) {
            bf16_t* base = V + (size_t)(256 * (pn - 4) + wr * 64 + fr) * 16384 + (size_t)u.pm * BM + 32 * wc + 8 * fq;
#pragma unroll
            for (int ai = 0; ai < 2; ++ai)
#pragma unroll
                for (int m = 0; m < 4; ++m) { bf16_t* rowp = base + (size_t)(ai * HALF + m * 16) * 16384;
#pragma unroll
                    for (int bj = 0; bj < 2; ++bj) *(u32x4*)(rowp + bj * HALF) = pack8(acc[ai][bj][m][0], acc[ai][bj][m][1]); }
        } else if (pn < 8) {
            bf16_t* base = U + 256 * (pn & 1) + 32 * wc + 8 * fq;
#pragma unroll
            for (int ai = 0; ai < 2; ++ai)
#pragma unroll
                for (int m = 0; m < 4; ++m) { bf16_t* rowp = base + (size_t)(row0 + ai * HALF + m * 16) * 512;
#pragma unroll
                    for (int bj = 0; bj < 2; ++bj) *(u32x4*)(rowp + bj * HALF) = pack8(acc[ai][bj][m][0], acc[ai][bj][m][1]); }
        } else {
            bf16_t* base = (pn < 12 ? GA : GP) + 256 * ((pn - 8) & 3) + 32 * wc + 8 * fq;
#pragma unroll
            for (int ai = 0; ai < 2; ++ai)
#pragma unroll
                for (int m = 0; m < 4; ++m) { bf16_t* rowp = base + (size_t)(row0 + ai * HALF + m * 16) * 1024;
#pragma unroll
                    for (int bj = 0; bj < 2; ++bj) { f32x4 v0 = acc[ai][bj][m][0], v1 = acc[ai][bj][m][1];
#pragma unroll
                        for (int e = 0; e < 4; ++e) { v0[e] = sigm(v0[e]); v1[e] = sigm(v1[e]); }
                        *(u32x4*)(rowp + bj * HALF) = pack8(v0, v1); } }
        }
    }
};
struct EpiBranch {
    static constexpr bool PERM = true;
    bf16_t* MG; const bf16_t *GA, *GP;
    __device__ __forceinline__ void operator()(const f32x4 (&acc)[2][2][4][2], const Unit& u, int wr, int wc, int fr, int fq) const {
        const int row0 = u.pm * BM + wr * 64 + fr; const size_t col0 = (size_t)u.pn * BM + wc * 32 + 8 * fq; const bool second = u.aux != 0; const bf16_t* G = second ? GP : GA;
#pragma unroll
        for (int ai = 0; ai < 2; ++ai)
#pragma unroll
            for (int m = 0; m < 4; ++m) { const size_t ro = (size_t)(row0 + ai * HALF + m * 16) * 1024 + col0;
#pragma unroll
                for (int bj = 0; bj < 2; ++bj) { const u32x4 g = *(const u32x4*)(G + ro + bj * HALF); f32x4 v0 = acc[ai][bj][m][0], v1 = acc[ai][bj][m][1];
                    v0[0] *= bflo_(g.x); v0[1] *= bfhi_(g.x); v0[2] *= bflo_(g.y); v0[3] *= bfhi_(g.y); v1[0] *= bflo_(g.z); v1[1] *= bfhi_(g.z); v1[2] *= bflo_(g.w); v1[3] *= bfhi_(g.w);
                    if (second) { const u32x4 o = *(const u32x4*)(MG + ro + bj * HALF);
                        v0[0] += bflo_(o.x); v0[1] += bfhi_(o.x); v0[2] += bflo_(o.y); v0[3] += bfhi_(o.y); v1[0] += bflo_(o.z); v1[1] += bfhi_(o.z); v1[2] += bflo_(o.w); v1[3] += bfhi_(o.w); }
                    *(u32x4*)(MG + ro + bj * HALF) = pack8(v0, v1); } }
    }
};
struct EpiOut {
    static constexpr bool PERM = false;
    const float* x; const float* mod; float* out;
    __device__ __forceinline__ void operator()(const f32x4 (&acc)[2][2][4][2], const Unit& u, int wr, int wc, int fr, int fq) const {
        const int row0 = u.pm * BM + wr * 64 + fr, col0 = u.pn * BM + wc * 32 + 4 * fq; const float* g1 = mod + (u.pm >> 5) * 6144 + 2048 + col0;
        f32x4 gv[2][2];
#pragma unroll
        for (int bj = 0; bj < 2; ++bj)
#pragma unroll
            for (int n = 0; n < 2; ++n) gv[bj][n] = *(const f32x4*)(g1 + bj * HALF + n * 16);
#pragma unroll
        for (int ai = 0; ai < 2; ++ai)
#pragma unroll
            for (int m = 0; m < 4; ++m) { const size_t off = (size_t)(row0 + ai * HALF + m * 16) * 1024 + col0;
#pragma unroll
                for (int bj = 0; bj < 2; ++bj)
#pragma unroll
                    for (int n = 0; n < 2; ++n) { const f32x4 xv = *(const f32x4*)(x + off + bj * HALF + n * 16); *(f32x4*)(out + off + bj * HALF + n * 16) = xv + gv[bj][n] * acc[ai][bj][m][n]; } }
    }
};
struct EpiMoe1 {
    static constexpr bool PERM = true;
    bf16_t* HID;
    __device__ __forceinline__ void operator()(const f32x4 (&acc)[2][2][4][2], const Unit& u, int wr, int wc, int fr, int fq) const {
        const int row0 = u.pm * BM + wr * 64 + fr; bf16_t* base = HID + 128 * u.pn + 32 * wc + 8 * fq;
#pragma unroll
        for (int ai = 0; ai < 2; ++ai)
#pragma unroll
            for (int m = 0; m < 4; ++m) { f32x4 v0 = acc[ai][0][m][0], v1 = acc[ai][0][m][1]; const f32x4 u0 = acc[ai][1][m][0], u1 = acc[ai][1][m][1];
#pragma unroll
                for (int e = 0; e < 4; ++e) { v0[e] = v0[e] * sigm(v0[e]) * u0[e]; v1[e] = v1[e] * sigm(v1[e]) * u1[e]; }
                *(u32x4*)(base + (size_t)(row0 + ai * HALF + m * 16) * 512) = pack8(v0, v1); }
    }
};
struct EpiMoe2 {
    static constexpr bool PERM = true;
    bf16_t* Y; const unsigned* list;
    __device__ __forceinline__ void operator()(const f32x4 (&acc)[2][2][4][2], const Unit& u, int wr, int wc, int fr, int fq) const {
        const int row0 = u.pm * BM + wr * 64 + fr; bf16_t* base = Y + (size_t)u.pn * BM + 32 * wc + 8 * fq;
#pragma unroll
        for (int ai = 0; ai < 2; ++ai)
#pragma unroll
            for (int m = 0; m < 4; ++m) { int pos = u.pos0 + ai * HALF + wr * 64 + m * 16 + fr; pos = pos < u.n ? pos : u.n - 1;
                const float w = __uint_as_float(list[((size_t)u.aux * 16384 + pos) * 2 + 1]);
                bf16_t* rowp = base + (size_t)(row0 + ai * HALF + m * 16) * 1024;
#pragma unroll
                for (int bj = 0; bj < 2; ++bj) *(u32x4*)(rowp + bj * HALF) = pack8(acc[ai][bj][m][0] * w, acc[ai][bj][m][1] * w); }
    }
};

template <class Epi, class Sched, bool GATHER>
__device__ __forceinline__ void gemm_phase(PG8_LAS unsigned char* lds, const Gemm g, const Sched& S, const Epi& E) {
    const int tid = threadIdx.x, wid = __builtin_amdgcn_readfirstlane(tid >> 6), lane = tid & 63, wr = wid >> 2, wc = wid & 3, fr = lane & 15, fq = lane >> 4;
    const int nt = g.nt;
    unsigned voffA[2], voffB[2]; int RA[2]; unsigned CA[2];
#pragma unroll
    for (int i = 0; i < 2; ++i) { int R, C; stage_rc(tid * 16 + i * 8192, R, C); const int Rb = Epi::PERM ? ((R & ~31) + perm32(R & 31)) : R;
        voffA[i] = (unsigned)(R * g.lda + C) * 2u; voffB[i] = (unsigned)(Rb * g.ldb + C) * 2u; RA[i] = R; CA[i] = (unsigned)C * 2u; }
    const size_t kstep = (size_t)(BK * 2);
    const size_t hstepA = (size_t)HALF * g.lda * 2, hstepB = (size_t)HALF * g.ldb * 2;
    const unsigned ldsw = (unsigned)wid * 1024u;
    const int aoff = lds_byte(wr * 64 + fr, fq * 8), boff = lds_byte(wc * 32 + fr, fq * 8);
#define PG8_SA(b, h) (((b) * 2 + (h)) * HTB)
#define PG8_SB(b, h) ((4 + (b) * 2 + (h)) * HTB)
#define PG8_STAGE2(bufoff, gbase, v0, v1) do { \
        __builtin_amdgcn_global_load_lds((const unsigned*)((const char*)(gbase) + (v0)), (PG8_LAS unsigned*)(lds + (bufoff) + ldsw), 16, 0, 0); \
        __builtin_amdgcn_global_load_lds((const unsigned*)((const char*)(gbase) + (v1)), (PG8_LAS unsigned*)(lds + (bufoff) + ldsw + 8192), 16, 0, 0); } while (0)
#define PG8_STAGEB(bufoff, gbase) PG8_STAGE2(bufoff, gbase, voffB[0], voffB[1])
#define PG8_STAGEA(bufoff, ptrN, ptrG, vg0, vg1) do { if constexpr (GATHER) { PG8_STAGE2(bufoff, ptrG, vg0, vg1); } else { PG8_STAGE2(bufoff, ptrN, voffA[0], voffA[1]); } } while (0)
#define PG8_LDA(dst, b, h) do { _Pragma("unroll") for (int m = 0; m < 4; ++m) _Pragma("unroll") for (int k = 0; k < 2; ++k) dst[m][k] = *(const PG8_LAS bf16x8*)(lds + PG8_SA(b, h) + aoff + m * 2048 + k * 1024); } while (0)
#define PG8_LDB(dst, b, h) do { _Pragma("unroll") for (int n = 0; n < 2; ++n) _Pragma("unroll") for (int k = 0; k < 2; ++k) dst[n][k] = *(const PG8_LAS bf16x8*)(lds + PG8_SB(b, h) + boff + n * 2048 + k * 1024); } while (0)
#define PG8_MMA(ai, bj, At, Bt) do { __builtin_amdgcn_s_setprio(1); _Pragma("unroll") for (int m = 0; m < 4; ++m) _Pragma("unroll") for (int n = 0; n < 2; ++n) _Pragma("unroll") for (int k = 0; k < 2; ++k) \
        acc[ai][bj][m][n] = __builtin_amdgcn_mfma_f32_16x16x32_bf16(Bt[n][k], At[m][k], acc[ai][bj][m][n], 0, 0, 0); __builtin_amdgcn_s_setprio(0); } while (0)
#define PG8_WAIT_V(n) asm volatile("s_waitcnt vmcnt(" #n ")" ::: "memory")
#define PG8_WAIT_L(n) asm volatile("s_waitcnt lgkmcnt(" #n ")" ::: "memory")
#define PG8_BAR __builtin_amdgcn_s_barrier()
#define PG8_SCHED __builtin_amdgcn_sched_barrier(0)
    Unit cur, nxt; int ui = 0;
    if (!S.next(0, cur)) return;
    f32x4 acc[2][2][4][2];
#pragma unroll
    for (int a = 0; a < 2; ++a)
#pragma unroll
        for (int b = 0; b < 2; ++b)
#pragma unroll
            for (int m = 0; m < 4; ++m)
#pragma unroll
                for (int n = 0; n < 2; ++n) acc[a][b][m][n] = (f32x4){0.f, 0.f, 0.f, 0.f};
    bf16x8 At[4][2], B0[2][2], B1[2][2];
    const char* cA = (const char*)g.A + cur.a_off; const char* cB = (const char*)g.Bt + cur.b_off;
    unsigned vc00 = 0, vc01 = 0, vc10 = 0, vc11 = 0, vn00 = 0, vn01 = 0, vn10 = 0, vn11 = 0;
    if constexpr (GATHER) { vc00 = S.row_off(cur, RA[0]) + CA[0]; vc01 = S.row_off(cur, RA[1]) + CA[1]; vc10 = S.row_off(cur, HALF + RA[0]) + CA[0]; vc11 = S.row_off(cur, HALF + RA[1]) + CA[1]; }
    const char* gA = (const char*)g.A;
    PG8_STAGEB(PG8_SB(0, 0), cB); PG8_STAGEB(PG8_SB(0, 1), cB + hstepB); PG8_STAGEA(PG8_SA(0, 0), cA, gA, vc00, vc01); PG8_STAGEA(PG8_SA(0, 1), cA + hstepA, gA, vc10, vc11);
    if (wr == 1) PG8_BAR;
    PG8_WAIT_V(2); PG8_BAR;
    PG8_STAGEB(PG8_SB(1, 0), cB + kstep); PG8_STAGEA(PG8_SA(1, 0), cA + kstep, gA + kstep, vc00, vc01); PG8_STAGEB(PG8_SB(1, 1), cB + hstepB + kstep);
    PG8_WAIT_V(6); PG8_BAR;
    for (;;) {
        const bool has_next = S.next(ui + 1, nxt);
        const char* nA = has_next ? (const char*)g.A + nxt.a_off : cA; const char* nB = has_next ? (const char*)g.Bt + nxt.b_off : cB;
        if constexpr (GATHER) {
            if (has_next) { vn00 = S.row_off(nxt, RA[0]) + CA[0]; vn01 = S.row_off(nxt, RA[1]) + CA[1]; vn10 = S.row_off(nxt, HALF + RA[0]) + CA[0]; vn11 = S.row_off(nxt, HALF + RA[1]) + CA[1]; }
            else { vn00 = vc00; vn01 = vc01; vn10 = vc10; vn11 = vc11; }
        }
        for (int t = 0; t < nt; t += 2) {
            const bool last = (t == nt - 2);
            const char* a1 = cA + (size_t)(t + 1) * kstep;
            const char* a2 = last ? nA : cA + (size_t)(t + 2) * kstep; const char* b2 = last ? nB : cB + (size_t)(t + 2) * kstep;
            const char* a3 = a2 + kstep; const char* b3 = b2 + kstep;
            const char* g1 = gA + (size_t)(t + 1) * kstep; const char* g2 = last ? gA : gA + (size_t)(t + 2) * kstep; const char* g3 = g2 + kstep;
            const unsigned w00 = last ? vn00 : vc00, w01 = last ? vn01 : vc01, w10 = last ? vn10 : vc10, w11 = last ? vn11 : vc11;
            PG8_LDB(B0, 0, 0); PG8_LDB(B1, 0, 1); PG8_SCHED; PG8_LDA(At, 0, 0); PG8_STAGEA(PG8_SA(1, 1), a1 + hstepA, g1, vc10, vc11);
            PG8_WAIT_V(8); PG8_WAIT_L(0); PG8_BAR; PG8_MMA(0, 0, At, B0); PG8_MMA(0, 1, At, B1); PG8_BAR; PG8_SCHED;
            PG8_LDA(At, 0, 1); PG8_STAGEB(PG8_SB(0, 0), b2); PG8_STAGEB(PG8_SB(0, 1), b2 + hstepB); PG8_STAGEA(PG8_SA(0, 0), a2, g2, w00, w01);
            PG8_WAIT_V(8); PG8_WAIT_L(0); PG8_BAR; PG8_MMA(1, 0, At, B0); PG8_MMA(1, 1, At, B1); PG8_BAR; PG8_SCHED;
            PG8_LDB(B0, 1, 0); PG8_LDB(B1, 1, 1); PG8_SCHED; PG8_LDA(At, 1, 0); PG8_STAGEA(PG8_SA(0, 1), a2 + hstepA, g2, w10, w11);
            PG8_WAIT_V(8); PG8_WAIT_L(0); PG8_BAR; PG8_MMA(0, 0, At, B0); PG8_MMA(0, 1, At, B1); PG8_BAR; PG8_SCHED;
            PG8_LDA(At, 1, 1); PG8_STAGEB(PG8_SB(1, 0), b3); PG8_STAGEB(PG8_SB(1, 1), b3 + hstepB); PG8_STAGEA(PG8_SA(1, 0), a3, g3, w00, w01);
            PG8_WAIT_V(8); PG8_WAIT_L(0); PG8_BAR; PG8_MMA(1, 0, At, B0); PG8_MMA(1, 1, At, B1); PG8_BAR; PG8_SCHED;
        }
        if (wr == 0) PG8_BAR;
        PG8_WAIT_V(0);
        E(acc, cur, wr, wc, fr, fq);
        if (!has_next) break;
#pragma unroll
        for (int a = 0; a < 2; ++a)
#pragma unroll
            for (int b = 0; b < 2; ++b)
#pragma unroll
                for (int m = 0; m < 4; ++m)
#pragma unroll
                    for (int n = 0; n < 2; ++n) acc[a][b][m][n] = (f32x4){0.f, 0.f, 0.f, 0.f};
        cur = nxt; cA = nA; cB = nB; ++ui;
        if constexpr (GATHER) { vc00 = vn00; vc01 = vn01; vc10 = vn10; vc11 = vn11; }
        if (wr == 1) PG8_BAR;
    }
    PG8_WAIT_V(0);
    PG8_BAR;
#undef PG8_SA
#undef PG8_SB
#undef PG8_STAGE2
#undef PG8_STAGEB
#undef PG8_STAGEA
#undef PG8_LDA
#undef PG8_LDB
#undef PG8_MMA
#undef PG8_WAIT_V
#undef PG8_WAIT_L
#undef PG8_BAR
#undef PG8_SCHED
}
}

__device__ __forceinline__ void transpose_item(const float* W, int N, bf16* dst, int dpitch, int drow0, int dk0, float* scr, int k0, int n0, int lane) {
#pragma unroll 8
    for (int i = 0; i < 32; ++i) { const int kk = 2 * i + (lane >> 5); scr[kk * 33 + (lane & 31)] = W[(size_t)(k0 + kk) * N + n0 + (lane & 31)]; }
    __builtin_amdgcn_s_waitcnt(0xC07F); asm volatile("" ::: "memory");
    const int c = lane & 7;
#pragma unroll
    for (int j = 0; j < 4; ++j) { const int n = (lane >> 3) + 8 * j; const float* s = scr + (8 * c) * 33 + n;
        v4u o; o.x = pk2(s[0 * 33], s[1 * 33]); o.y = pk2(s[2 * 33], s[3 * 33]); o.z = pk2(s[4 * 33], s[5 * 33]); o.w = pk2(s[6 * 33], s[7 * 33]);
        *(v4u*)(dst + (size_t)(drow0 + n) * dpitch + dk0 + k0 + 8 * c) = o; }
    __builtin_amdgcn_s_waitcnt(0xC07F); asm volatile("" ::: "memory");
}
__device__ __forceinline__ int win_rowmap(int n0) {
    if (n0 >= 1024) return n0;
    const int t = n0 >> 8, rem = n0 & 255, wc = rem >> 6, bj = (rem & 63) >> 5;
    return 256 * t + 128 * bj + 32 * wc;
}
__device__ __forceinline__ int win_colmap_inv(int np) {
    if (np >= 1024) return np;
    const int t = np >> 8, rem = np & 255, bj = rem >> 7, wc = (rem & 127) >> 5, j = rem & 31;
    return 256 * t + 64 * wc + 32 * bj + j;
}
__device__ __forceinline__ void ph_prologue(const P& p, unsigned char* ldsb, int bid, int nb) {
    const int tid = threadIdx.x, lane = tid & 63, wave = tid >> 6;
    float* scr = (float*)(ldsb + wave * 16384);
    const int gw = bid * NWAVES + wave, NGW = nb * NWAVES;
    constexpr int I_IN = 16 * 128, I_BA = 8 * 32, I_BP = 4 * 16 * 16, I_OUT = 16 * 32, I_G = 16 * 256, I_U = 16 * 256, I_D = 16 * 256, I_MOD = 96 * MOD_SPLITS;
    constexpr int NITEMS = I_MOD + I_IN + I_BA + I_BP + I_OUT + I_G + I_U + I_D;
    for (int it = gw; it < NITEMS; it += NGW) {
        int r = it;
        if (r < I_MOD) {
            const int ch = r % 96, sp = r / 96, j = ch * 64 + lane;
            float a0 = 0.f, a1 = 0.f;
#pragma unroll 1
            for (int kc = 0; kc < 2; ++kc) { const int k0 = sp * 128 + kc * 64;
                const float s0 = siluf_(p.c[k0 + lane]), s1 = siluf_(p.c[DM + k0 + lane]);
#pragma unroll 8
                for (int kk = 0; kk < 64; ++kk) { const float w = p.ada_w[(size_t)(k0 + kk) * 6144 + j]; a0 += __shfl(s0, kk) * w; a1 += __shfl(s1, kk) * w; } }
            p.miscf[MF_MODP + (sp * 2 + 0) * 6144 + j] = a0; p.miscf[MF_MODP + (sp * 2 + 1) * 6144 + j] = a1;
            continue;
        }
        r -= I_MOD;
        if (r < I_IN) { const int kb = r / 128, nbk = r % 128; transpose_item(p.w_in, DIN, p.WIN, DM, win_rowmap(nbk * 32), 0, scr, kb * 64, nbk * 32, lane); continue; } r -= I_IN;
        if (r < I_BA) { const int kb = r / 32, nbk = r % 32; transpose_item(p.wba, DM, p.WBR, DM, nbk * 32, 0, scr, kb * 64, nbk * 32, lane); continue; } r -= I_BA;
        if (r < I_BP) {
            const int g = r >> 8, cb = (r >> 4) & 15, n = (r & 15) * 64 + lane;
            float a[8];
#pragma unroll
            for (int q = 0; q < 8; ++q) a[q] = 0.f;
            const float* pw = p.pool_w + (size_t)(g * 128 + cb * 8) * 128;
#pragma unroll 4
            for (int j = 0; j < 128; ++j) { const float w = p.wbp[(size_t)(g * 128 + j) * DM + n] * p.pool_scale[g * 128 + j];
#pragma unroll
                for (int q = 0; q < 8; ++q) a[q] += pw[q * 128 + j] * w; }
            v4u o; o.x = pk2(a[0], a[1]); o.y = pk2(a[2], a[3]); o.z = pk2(a[4], a[5]); o.w = pk2(a[6], a[7]);
            *(v4u*)(p.WBR + (size_t)n * DM + 512 + g * 128 + cb * 8) = o;
            continue; } r -= I_BP;
        if (r < I_OUT) { const int kb = r / 32, nbk = r % 32; transpose_item(p.w_out, DM, p.WOUT, DM, nbk * 32, 0, scr, kb * 64, nbk * 32, lane); continue; } r -= I_OUT;
        if (r < I_G) { const int e = r / 256, q = r % 256, kb = q / 16, nbk = q % 16, n0 = nbk * 32;
            transpose_item(p.wgate + (size_t)e * DM * DEXP, DEXP, p.W1 + (size_t)e * 1024 * 1024, DM, 256 * (n0 >> 7) + (n0 & 127), 0, scr, kb * 64, n0, lane); continue; } r -= I_G;
        if (r < I_U) { const int e = r / 256, q = r % 256, kb = q / 16, nbk = q % 16, n0 = nbk * 32;
            transpose_item(p.wup + (size_t)e * DM * DEXP, DEXP, p.W1 + (size_t)e * 1024 * 1024, DM, 256 * (n0 >> 7) + 128 + (n0 & 127), 0, scr, kb * 64, n0, lane); continue; } r -= I_U;
        { const int e = r / 256, q = r % 256, kb = q / 32, nbk = q % 32;
            transpose_item(p.wdown + (size_t)e * DEXP * DM, DM, p.W2 + (size_t)e * 1024 * 512, DEXP, nbk * 32, 0, scr, kb * 64, nbk * 32, lane); }
    }
    if (bid == 0 && wave == 0) {
        float a = p.lq1[lane] * p.lk1[lane], b2 = p.lq2[lane] * p.lk2[lane];
        a = wave_sum(a); b2 = wave_sum(b2);
        const float lam = __expf(a) - __expf(b2) + LAMBDA_INIT;
        const float gq = wave_max(fabsf(p.q_norm_g[lane])), gk = wave_max(fabsf(p.k_norm_g[lane]));
        if (lane == 0) p.miscf[MF_LAM] = lam;
        for (int h = 0; h < NHEAD; ++h) {
            float bm = lane < 32 ? fabsf(p.rel_bias[lane * 4 + h]) : 0.f; bm = wave_max(bm);
            const float shift = 8.0f * gq * gk + bm;
            for (int i = lane; i < 384; i += 64) { const int rel = i - 256; p.miscf[MF_BIAS + h * 384 + i] = (p.rel_bias[t5_bucket(rel) * 4 + h] - shift) * LOG2E; }
        }
    }
}

__device__ __forceinline__ float mod_sum(const P& p, int b, int j) {
    float s = p.ada_b[j];
#pragma unroll
    for (int sp = 0; sp < MOD_SPLITS; ++sp) s += p.miscf[MF_MODP + (sp * 2 + b) * 6144 + j];
    return s;
}
__device__ __forceinline__ void ph_norm1(const P& p, unsigned char* ldsb, int bid, int nb) {
    const int tid = threadIdx.x, lane = tid & 63, wave = tid >> 6;
    float* la = (float*)ldsb; float* ls = la + 1024;
    for (int rb = bid; rb < 256; rb += nb) {
        const int b = rb / 128;
        __syncthreads();
        for (int c = tid; c < 1024; c += NTHR) { la[c] = p.norm1_g[c] * (1.0f + mod_sum(p, b, 1024 + c)); ls[c] = mod_sum(p, b, c); }
        if (tid < 48) { const int j = rb * 48 + tid; p.miscf[MF_MOD + j] = mod_sum(p, j / 6144, j % 6144); }
        __syncthreads();
        f32x4 xv[8][4];
#pragma unroll
        for (int i = 0; i < 8; ++i) { const f32x4* xr = (const f32x4*)(p.x + (size_t)(rb * 64 + wave * 8 + i) * DM) + lane;
#pragma unroll
            for (int j = 0; j < 4; ++j) xv[i][j] = xr[64 * j]; }
#pragma unroll
        for (int i = 0; i < 8; ++i) {
            const int row = rb * 64 + wave * 8 + i;
            float ss = 0.f;
#pragma unroll
            for (int j = 0; j < 4; ++j) ss += xv[i][j].x * xv[i][j].x + xv[i][j].y * xv[i][j].y + xv[i][j].z * xv[i][j].z + xv[i][j].w * xv[i][j].w;
            const float rstd = rsqrtf(wave_sum(ss) * (1.0f / DM) + RMS_EPS);
            v2u* o = (v2u*)(p.XN + (size_t)row * DM) + lane;
#pragma unroll
            for (int j = 0; j < 4; ++j) { const int c = (64 * j + lane) * 4; const f32x4 a = *(const f32x4*)(la + c), s = *(const f32x4*)(ls + c); const f32x4 v = xv[i][j];
                v2u w; w.x = pk2(v.x * rstd * a.x + s.x, v.y * rstd * a.y + s.y); w.y = pk2(v.z * rstd * a.z + s.z, v.w * rstd * a.w + s.w); o[64 * j] = w; }
        }
    }
}

template <class Epi>
__device__ __forceinline__ void gemm_nt_naive(const bf16* A, int lda, const bf16* Bt, int ldb, int M, int N, int K, const Epi& epi, unsigned char* ldsb, int bid, int nb) {
    float* As = (float*)ldsb;
    float* Bs = As + 32 * 68;
    const int tid = threadIdx.x, tm = tid >> 5, tn = tid & 31;
    const int ntn = N / 128, nt = (M / 64) * ntn;
    for (int t = bid; t < nt; t += nb) {
        const int m0 = (t / ntn) * 64, n0 = (t % ntn) * 128;
        float acc[4][4];
#pragma unroll
        for (int i = 0; i < 4; ++i)
#pragma unroll
            for (int j = 0; j < 4; ++j) acc[i][j] = 0.f;
        for (int k0 = 0; k0 < K; k0 += 32) {
            __syncthreads();
            { const int r = tid >> 3, kq = (tid & 7) * 4; const v2u v = *(const v2u*)(A + (size_t)(m0 + r) * lda + k0 + kq);
              As[(kq + 0) * 68 + r] = bflo(v.x); As[(kq + 1) * 68 + r] = bfhi(v.x); As[(kq + 2) * 68 + r] = bflo(v.y); As[(kq + 3) * 68 + r] = bfhi(v.y); }
            { const int r = tid >> 2, kq = (tid & 3) * 8; const v4u v = *(const v4u*)(Bt + (size_t)(n0 + r) * ldb + k0 + kq);
              Bs[(kq + 0) * 132 + r] = bflo(v.x); Bs[(kq + 1) * 132 + r] = bfhi(v.x); Bs[(kq + 2) * 132 + r] = bflo(v.y); Bs[(kq + 3) * 132 + r] = bfhi(v.y);
              Bs[(kq + 4) * 132 + r] = bflo(v.z); Bs[(kq + 5) * 132 + r] = bfhi(v.z); Bs[(kq + 6) * 132 + r] = bflo(v.w); Bs[(kq + 7) * 132 + r] = bfhi(v.w); }
            __syncthreads();
#pragma unroll 8
            for (int k = 0; k < 32; ++k) {
                const f32x4 a = *(const f32x4*)(As + k * 68 + tm * 4), b = *(const f32x4*)(Bs + k * 132 + tn * 4);
#pragma unroll
                for (int i = 0; i < 4; ++i)
#pragma unroll
                    for (int j = 0; j < 4; ++j) acc[i][j] += a[i] * b[j];
            }
        }
#pragma unroll
        for (int i = 0; i < 4; ++i)
#pragma unroll
            for (int j = 0; j < 4; ++j) epi(m0 + tm * 4 + i, n0 + tn * 4 + j, acc[i][j]);
    }
}

struct EpiInNaive {
    float* qkraw; bf16 *V, *U, *GA, *GP;
    __device__ __forceinline__ void operator()(int r, int np, float v) const {
        const int c = win_colmap_inv(np);
        if (c < 1024) qkraw[(size_t)r * 1024 + c] = v;
        else if (c < 1536) V[(size_t)r * 512 + c - 1024] = (bf16)f2bf(v);
        else if (c < 2048) U[(size_t)r * 512 + c - 1536] = (bf16)f2bf(v);
        else if (c < 3072) GA[(size_t)r * 1024 + c - 2048] = (bf16)f2bf(sigmoidf_(v));
        else GP[(size_t)r * 1024 + c - 3072] = (bf16)f2bf(sigmoidf_(v));
    }
};
__device__ __forceinline__ void ph_inproj_naive(const P& p, unsigned char* ldsb, int bid, int nb) {
    EpiInNaive e{p.out, p.V, p.U, p.GA, p.GP};
    gemm_nt_naive(p.XN, DM, p.WIN, DM, MTOK, DIN, DM, e, ldsb, bid, nb);
}
__device__ __forceinline__ void ph_qknorm_naive(const P& p, int bid, int nb) {
    const int tid = threadIdx.x, lane = tid & 63, wave = tid >> 6;
    for (int row = bid * NWAVES + wave; row < MTOK; row += nb * NWAVES) {
        const float* src = p.out + (size_t)row * 1024 + lane * 16;
        float v[16]; float ss = 0.f;
#pragma unroll
        for (int i = 0; i < 16; ++i) { v[i] = src[i]; ss += v[i] * v[i]; }
        ss += __shfl_xor(ss, 1); ss += __shfl_xor(ss, 2);
        const float rstd = rsqrtf(ss * (1.0f / 64.0f) + RMS_EPS);
        const bool isq = lane < 32; const int d0 = (lane & 3) * 16;
        bf16* dst = (isq ? p.Q : p.K) + (size_t)row * 512 + (lane & 31) * 16;
#pragma unroll
        for (int i = 0; i < 16; ++i) { const float g = isq ? p.q_norm_g[d0 + i] * (0.125f * LOG2E) : p.k_norm_g[d0 + i]; dst[i] = (bf16)f2bf(v[i] * rstd * g); }
    }
}

__device__ __forceinline__ float block_max(float v, float* red, int tid) {
    v = wave_max(v); __syncthreads(); if ((tid & 63) == 0) red[tid >> 6] = v; __syncthreads();
    float r = red[0];
#pragma unroll
    for (int i = 1; i < 8; ++i) r = fmaxf(r, red[i]);
    return r;
}
__device__ __forceinline__ float block_sum(float v, float* red, int tid) {
    v = wave_sum(v); __syncthreads(); if ((tid & 63) == 0) red[tid >> 6] = v; __syncthreads();
    float r = 0.f;
#pragma unroll
    for (int i = 0; i < 8; ++i) r += red[i];
    return r;
}
__device__ __forceinline__ void ph_attn_naive(const P& p, unsigned char* ldsb, int bid, int nb) {
    float* sc1 = (float*)ldsb; float* sc2 = sc1 + 8192; float* qs = sc2 + 8192; float* red = qs + 128; float* po = red + 32;
    const int tid = threadIdx.x;
    const float lam = p.miscf[MF_LAM];
    for (int item = bid; item < NB * NHEAD * SEQ; item += nb) {
        const int q = item % SEQ, bh = item / SEQ, h = bh % NHEAD, b = bh / NHEAD;
        const int nk = 64 * (q / 64 + 1);
        const size_t rowq = (size_t)b * SEQ + q;
        __syncthreads();
        if (tid < 128) qs[tid] = bf2f(p.Q[rowq * 512 + h * 128 + tid]);
        __syncthreads();
        float mx1 = -INFINITY, mx2 = -INFINITY;
        for (int j = tid; j < nk; j += NTHR) {
            const bf16* kr = p.K + ((size_t)b * SEQ + j) * 512 + h * 128;
            float s1 = 0.f, s2 = 0.f;
#pragma unroll
            for (int d = 0; d < 64; d += 8) {
                const v4u a = *(const v4u*)(kr + d), c = *(const v4u*)(kr + 64 + d);
                s1 += qs[d] * bflo(a.x) + qs[d + 1] * bfhi(a.x) + qs[d + 2] * bflo(a.y) + qs[d + 3] * bfhi(a.y) + qs[d + 4] * bflo(a.z) + qs[d + 5] * bfhi(a.z) + qs[d + 6] * bflo(a.w) + qs[d + 7] * bfhi(a.w);
                s2 += qs[64 + d] * bflo(c.x) + qs[65 + d] * bfhi(c.x) + qs[66 + d] * bflo(c.y) + qs[67 + d] * bfhi(c.y) + qs[68 + d] * bflo(c.z) + qs[69 + d] * bfhi(c.z) + qs[70 + d] * bflo(c.w) + qs[71 + d] * bfhi(c.w);
            }
            int rel = j - q; if (rel < -256) rel = -256;
            const float bv = p.miscf[MF_BIAS + h * 384 + rel + 256];
            s1 += bv; s2 += bv; sc1[j] = s1; sc2[j] = s2; mx1 = fmaxf(mx1, s1); mx2 = fmaxf(mx2, s2);
        }
        mx1 = block_max(mx1, red, tid); mx2 = block_max(mx2, red, tid);
        float l1 = 0.f, l2 = 0.f;
        for (int j = tid; j < nk; j += NTHR) { const float p1 = exp2f(sc1[j] - mx1), p2 = exp2f(sc2[j] - mx2); sc1[j] = p1; sc2[j] = p2; l1 += p1; l2 += p2; }
        l1 = block_sum(l1, red, tid); l2 = block_sum(l2, red, tid);
        const float i1 = 1.0f / l1, i2 = lam / l2;
        const int d = tid & 127, kq = tid >> 7;
        float o = 0.f;
        const bf16* vb = p.V + (size_t)b * SEQ * 512 + h * 128 + d;
        for (int j = kq; j < nk; j += 4) o += (sc1[j] * i1 - sc2[j] * i2) * bf2f(vb[(size_t)j * 512]);
        po[kq * 128 + d] = o;
        __syncthreads();
        float ov = 0.f, ss = 0.f;
        if (tid < 128) { ov = po[tid] + po[128 + tid] + po[256 + tid] + po[384 + tid]; ss = ov * ov; }
        ss = block_sum(ss, red, tid);
        if (tid < 128) { const float r = rsqrtf(ss * (1.0f / 128.0f) + RMS_EPS); p.AB[rowq * 1024 + h * 128 + tid] = (bf16)f2bf(ov * r * p.subln_g[tid] * (1.0f - LAMBDA_INIT)); }
    }
}
__device__ __forceinline__ void ph_pool_naive(const P& p, unsigned char* ldsb, int bid, int nb) {
    float* mt = (float*)ldsb;
    const int tid = threadIdx.x, i = tid >> 5, c4 = (tid & 31) * 4;
    for (int item = bid; item < (MTOK / 16) * 4; item += nb) {
        const int rb = item >> 2, g = item & 3, w = 2 << g;
        const int r = rb * 16 + i, t = r % SEQ;
        __syncthreads();
#pragma unroll
        for (int cc = 0; cc < 4; ++cc) { const int c = c4 + cc; float s = 0.f;
            for (int jj = 0; jj < w; ++jj) if (t - jj >= 0) s += bf2f(p.U[(size_t)(r - jj) * 512 + g * 128 + c]);
            const float cnt = (float)(t + 1 < w ? t + 1 : w);
            mt[i * 128 + c] = s / cnt - bf2f(p.U[(size_t)r * 512 + g * 128 + c]); }
        __syncthreads();
#pragma unroll
        for (int dd = 0; dd < 4; ++dd) { const int d = c4 + dd; float a = 0.f;
            for (int c = 0; c < 128; ++c) a += mt[i * 128 + c] * p.pool_w[(size_t)(g * 128 + c) * 128 + d];
            p.AB[(size_t)r * 1024 + 512 + g * 128 + d] = (bf16)f2bf(a * p.pool_scale[g * 128 + d]); }
    }
}

struct EpiBrA { bf16* MG; const bf16* GA; __device__ __forceinline__ void operator()(int r, int c, float v) const { MG[(size_t)r * 1024 + c] = (bf16)f2bf(bf2f(GA[(size_t)r * 1024 + c]) * v); } };
struct EpiBrB { bf16* MG; const bf16* GP; __device__ __forceinline__ void operator()(int r, int c, float v) const { MG[(size_t)r * 1024 + c] = (bf16)f2bf(bf2f(MG[(size_t)r * 1024 + c]) + bf2f(GP[(size_t)r * 1024 + c]) * v); } };
__device__ __forceinline__ void ph_branch_naive(const P& p, unsigned char* ldsb, int bid, int nb) {
    EpiBrA ea{p.XN, p.GA}; gemm_nt_naive(p.AB, 1024, p.WBR, 1024, MTOK, DM, 512, ea, ldsb, bid, nb);
    __syncthreads();
    EpiBrB eb{p.XN, p.GP}; gemm_nt_naive(p.AB + 512, 1024, p.WBR + 512, 1024, MTOK, DM, 512, eb, ldsb, bid, nb);
}
struct EpiOutNaive { const float* x; const float* mod; float* out; __device__ __forceinline__ void operator()(int r, int c, float v) const {
    const int b = r / SEQ; out[(size_t)r * 1024 + c] = x[(size_t)r * 1024 + c] + mod[b * 6144 + 2048 + c] * v; } };
__device__ __forceinline__ void ph_wout_naive(const P& p, unsigned char* ldsb, int bid, int nb) {
    EpiOutNaive e{p.x, p.miscf + MF_MOD, p.out}; gemm_nt_naive(p.XN, 1024, p.WOUT, 1024, MTOK, DM, DM, e, ldsb, bid, nb);
}

__device__ __forceinline__ void ph_norm2_route(const P& p, unsigned char* ldsb, int bid, int nb) {
    const int tid = threadIdx.x, lane = tid & 63, wave = tid >> 6;
    float* la = (float*)ldsb; float* ls = la + 1024; float* wr = ls + 1024;
    int4* rt = (int4*)(wr + 20 * 1024); unsigned* lcnt = (unsigned*)(rt + 64); unsigned* lbase = lcnt + 16; unsigned* posl = lbase + 16;
    if (tid < 16) lcnt[tid] = 0u;
    for (int i = tid; i < 1024 * 20; i += NTHR) { const int o = i / 1024, c = i % 1024; wr[i] = o < 4 ? p.rgw[c * 4 + o] : p.rew[c * 16 + o - 4]; }
    for (int rb = bid; rb < 256; rb += nb) {
        const int b = rb / 128;
        __syncthreads();
        for (int c = tid; c < 1024; c += NTHR) { la[c] = p.norm2_g[c] * (1.0f + p.miscf[MF_MOD + b * 6144 + 4096 + c]); ls[c] = p.miscf[MF_MOD + b * 6144 + 3072 + c]; }
        __syncthreads();
        f32x4 nx[4];
        { const f32x4* xr = (const f32x4*)(p.out + (size_t)(rb * 64 + wave * 8) * DM) + lane;
#pragma unroll
          for (int j = 0; j < 4; ++j) nx[j] = xr[64 * j]; }
#pragma unroll 1
        for (int i = 0; i < 8; ++i) {
            const int row = rb * 64 + wave * 8 + i;
            f32x4 v[4]; float ss = 0.f;
#pragma unroll
            for (int j = 0; j < 4; ++j) { v[j] = nx[j]; ss += v[j].x * v[j].x + v[j].y * v[j].y + v[j].z * v[j].z + v[j].w * v[j].w; }
            if (i + 1 < 8) { const f32x4* xr = (const f32x4*)(p.out + (size_t)(row + 1) * DM) + lane;
#pragma unroll
                for (int j = 0; j < 4; ++j) nx[j] = xr[64 * j]; }
            const float rstd = rsqrtf(wave_sum(ss) * (1.0f / DM) + RMS_EPS);
            v2u* o = (v2u*)(p.XN + (size_t)row * DM) + lane;
#pragma unroll
            for (int j = 0; j < 4; ++j) { const int c = (64 * j + lane) * 4; const f32x4 a = *(const f32x4*)(la + c), s = *(const f32x4*)(ls + c);
                f32x4 hh; hh.x = v[j].x * rstd * a.x + s.x; hh.y = v[j].y * rstd * a.y + s.y; hh.z = v[j].z * rstd * a.z + s.z; hh.w = v[j].w * rstd * a.w + s.w;
                v2u w; w.x = pk2(hh.x, hh.y); w.y = pk2(hh.z, hh.w); o[64 * j] = w; v[j] = hh; }
            float mylg = 0.f;
#pragma unroll 1
            for (int oo = 0; oo < 20; ++oo) { float s = 0.f;
#pragma unroll
                for (int j = 0; j < 4; ++j) { const f32x4 w = *(const f32x4*)(wr + oo * 1024 + (64 * j + lane) * 4); s += v[j].x * w.x + v[j].y * w.y + v[j].z * w.z + v[j].w * w.w; }
                s = wave_sum(s); mylg = (lane == oo) ? s : mylg; }
            float lg[20];
#pragma unroll
            for (int k = 0; k < 20; ++k) lg[k] = __shfl(mylg, k);
            if (lane == 0) {
                const float g0 = lg[0] + p.rgb[0], g1 = lg[1] + p.rgb[1], g2 = lg[2] + p.rgb[2], g3 = lg[3] + p.rgb[3];
                int gi = 0; float gm = g0;
                if (g1 > gm) { gm = g1; gi = 1; } if (g2 > gm) { gm = g2; gi = 2; } if (g3 > gm) { gm = g3; gi = 3; }
                const float gval = 1.0f / (__expf(g0 - gm) + __expf(g1 - gm) + __expf(g2 - gm) + __expf(g3 - gm));
                float el[4];
#pragma unroll
                for (int k = 0; k < 4; ++k) { float t = 0.f;
#pragma unroll
                    for (int gg = 0; gg < 4; ++gg) t = (gg == gi) ? lg[4 + gg * 4 + k] + p.reb[gg * 4 + k] : t;
                    el[k] = t; }
                int i0 = 0; float m0 = el[0];
#pragma unroll
                for (int k = 1; k < 4; ++k) if (el[k] > m0) { m0 = el[k]; i0 = k; }
                int i1 = 0; float m1 = -INFINITY;
#pragma unroll
                for (int k = 0; k < 4; ++k) if (k != i0 && el[k] > m1) { m1 = el[k]; i1 = k; }
                const float e1 = __expf(m1 - m0);
                const float w0 = gval / (1.0f + e1), w1 = gval * e1 / (1.0f + e1);
                int4 ri; ri.x = (gi * 4 + i0) | ((gi * 4 + i1) << 8); ri.y = 0; ri.z = __float_as_int(w0); ri.w = __float_as_int(w1);
                rt[wave * 8 + i] = ri;
            }
        }
        __syncthreads();
        int myE = 0, myL = 0;
        if (tid < 128) { const int4 ri = rt[tid >> 1]; myE = (tid & 1) ? ((ri.x >> 8) & 0xff) : (ri.x & 0xff); myL = (int)atomicAdd(&lcnt[myE], 1u); }
        __syncthreads();
        if (tid < 16) { const unsigned c = lcnt[tid]; lbase[tid] = c ? atomicAdd(p.ctl + CW_CNT + tid * 64, c) : 0u; }
        __syncthreads();
        if (tid < 128) { const int r = tid >> 1, row = rb * 64 + r; const int4 ri = rt[r]; const unsigned pos = lbase[myE] + (unsigned)myL;
            uint2 l; l.x = (unsigned)row; l.y = (unsigned)((tid & 1) ? ri.w : ri.z); *(uint2*)(p.list + ((size_t)myE * MTOK + pos) * 2) = l;
            posl[tid] = pos; }
        __syncthreads();
        if (tid < 64) { int4 ri = rt[tid]; ri.y = (int)(posl[2 * tid] | (posl[2 * tid + 1] << 16)); *(int4*)(p.route + (size_t)(rb * 64 + tid) * 4) = ri; }
        if (tid < 16) lcnt[tid] = 0u;
    }
}

__device__ __forceinline__ void moe_offsets(const P& p, int* arr) {
    __syncthreads();
    if (threadIdx.x == 0) { int o = 0;
        for (int e = 0; e < NEXP; ++e) { const int n = (int)__hip_atomic_load(p.ctl + CW_CNT + e * 64, __ATOMIC_RELAXED, __HIP_MEMORY_SCOPE_AGENT); arr[e] = n; arr[16 + e] = o; arr[33 + e] = o >> 8; o += (n + 255) & ~255; }
        arr[32] = o; arr[33 + 16] = o >> 8; }
    __syncthreads();
}
__device__ __forceinline__ void ph_moe1_naive(const P& p, unsigned char* ldsb, int bid, int nb) {
    float* hs = (float*)ldsb;
    const int tid = threadIdx.x;
    int* cnt = (int*)(ldsb + 65536); int* off = cnt + 16; moe_offsets(p, cnt);
#pragma unroll 1
    for (int e = 0; e < NEXP; ++e) {
        const int n = cnt[e];
#pragma unroll 1
        for (int pb = bid; pb * 8 < n; pb += nb) {
            __syncthreads();
            for (int idx = tid; idx < 8 * 128; idx += NTHR) { const int s = idx >> 7, ch = idx & 127, pos = pb * 8 + s;
                if (pos < n) { const unsigned tok = p.list[((size_t)e * MTOK + pos) * 2]; const v4u v = *(const v4u*)(p.XN + (size_t)tok * 1024 + ch * 8);
                    float* d = hs + s * 1024 + ch * 8; d[0] = bflo(v.x); d[1] = bfhi(v.x); d[2] = bflo(v.y); d[3] = bfhi(v.y); d[4] = bflo(v.z); d[5] = bfhi(v.z); d[6] = bflo(v.w); d[7] = bfhi(v.w); }
                else { float* d = hs + s * 1024 + ch * 8;
#pragma unroll
                    for (int q = 0; q < 8; ++q) d[q] = 0.f; } }
            __syncthreads();
            const int j = tid;
            const bf16* gr = p.W1 + (size_t)e * 1024 * 1024 + (size_t)(256 * (j >> 7) + (j & 127)) * 1024; const bf16* ur = gr + 128 * 1024;
            float ag[8], au[8];
#pragma unroll
            for (int s = 0; s < 8; ++s) { ag[s] = 0.f; au[s] = 0.f; }
            for (int k = 0; k < 1024; k += 8) {
                const v4u g = *(const v4u*)(gr + k), u = *(const v4u*)(ur + k);
                const float gf[8] = {bflo(g.x), bfhi(g.x), bflo(g.y), bfhi(g.y), bflo(g.z), bfhi(g.z), bflo(g.w), bfhi(g.w)};
                const float uf[8] = {bflo(u.x), bfhi(u.x), bflo(u.y), bfhi(u.y), bflo(u.z), bfhi(u.z), bflo(u.w), bfhi(u.w)};
#pragma unroll
                for (int s = 0; s < 8; ++s) {
#pragma unroll
                    for (int q = 0; q < 8; ++q) { const float hv = hs[s * 1024 + k + q]; ag[s] += hv * gf[q]; au[s] += hv * uf[q]; } }
            }
#pragma unroll
            for (int s = 0; s < 8; ++s) { const int pos = pb * 8 + s; if (pos < n) p.HID[(size_t)(off[e] + pos) * 512 + j] = (bf16)f2bf(siluf_(ag[s]) * au[s]); }
        }
    }
}
__device__ __forceinline__ void ph_moe2_naive(const P& p, unsigned char* ldsb, int bid, int nb) {
    float* hs = (float*)ldsb;
    const int tid = threadIdx.x;
    int* cnt = (int*)(ldsb + 65536); int* off = cnt + 16; moe_offsets(p, cnt);
#pragma unroll 1
    for (int e = 0; e < NEXP; ++e) {
        const int n = cnt[e];
#pragma unroll 1
        for (int pb = bid; pb * 8 < n; pb += nb) {
            __syncthreads();
            { const int s = tid >> 6, ch = tid & 63, pos = pb * 8 + s; float* d = hs + s * 512 + ch * 8;
                if (pos < n) { const v4u v = *(const v4u*)(p.HID + (size_t)(off[e] + pos) * 512 + ch * 8);
                    d[0] = bflo(v.x); d[1] = bfhi(v.x); d[2] = bflo(v.y); d[3] = bfhi(v.y); d[4] = bflo(v.z); d[5] = bfhi(v.z); d[6] = bflo(v.w); d[7] = bfhi(v.w); }
                else {
#pragma unroll
                    for (int q = 0; q < 8; ++q) d[q] = 0.f; } }
            __syncthreads();
#pragma unroll 1
            for (int half = 0; half < 2; ++half) {
                const int nn = tid + half * 512;
                const bf16* wr = p.W2 + (size_t)e * 1024 * 512 + (size_t)nn * 512;
                float a[8];
#pragma unroll
                for (int s = 0; s < 8; ++s) a[s] = 0.f;
                for (int k = 0; k < 512; k += 8) {
                    const v4u g = *(const v4u*)(wr + k);
                    const float gf[8] = {bflo(g.x), bfhi(g.x), bflo(g.y), bfhi(g.y), bflo(g.z), bfhi(g.z), bflo(g.w), bfhi(g.w)};
#pragma unroll
                    for (int s = 0; s < 8; ++s) {
#pragma unroll
                        for (int q = 0; q < 8; ++q) a[s] += hs[s * 512 + k + q] * gf[q]; }
                }
#pragma unroll
                for (int s = 0; s < 8; ++s) { const int pos = pb * 8 + s; if (pos < n) { const float w = __uint_as_float(p.list[((size_t)e * MTOK + pos) * 2 + 1]);
                    p.Y[(size_t)(off[e] + pos) * 1024 + nn] = (bf16)f2bf(a[s] * w); } }
            }
        }
    }
}
__device__ __forceinline__ void ph_combine(const P& p, unsigned char* ldsb, int bid, int nb) {
    const int tid = threadIdx.x, lane = tid & 63, wave = tid >> 6;
    int* cnt = (int*)ldsb; int* off = cnt + 16; moe_offsets(p, cnt);
    for (int row = bid * NWAVES + wave; row < MTOK; row += nb * NWAVES) {
        const int4 ri = *(const int4*)(p.route + (size_t)row * 4);
        const size_t s0 = (size_t)(off[ri.x & 0xff] + (ri.y & 0xffff)), s1 = (size_t)(off[(ri.x >> 8) & 0xff] + ((ri.y >> 16) & 0xffff));
        const int b = row / SEQ;
        const float* g2 = p.miscf + MF_MOD + b * 6144 + 5120;
        f32x4* xo = (f32x4*)(p.out + (size_t)row * DM) + lane;
        const v2u* y0 = (const v2u*)(p.Y + s0 * 1024) + lane; const v2u* y1 = (const v2u*)(p.Y + s1 * 1024) + lane;
#pragma unroll
        for (int j = 0; j < 4; ++j) { const int c = (64 * j + lane) * 4; const f32x4 g = *(const f32x4*)(g2 + c); f32x4 v = xo[64 * j]; const v2u a = y0[64 * j], d = y1[64 * j];
            v.x += g.x * (bflo(a.x) + bflo(d.x)); v.y += g.y * (bfhi(a.x) + bfhi(d.x)); v.z += g.z * (bflo(a.y) + bflo(d.y)); v.w += g.w * (bfhi(a.y) + bfhi(d.y)); xo[64 * j] = v; }
    }
}


namespace att {
typedef short bf16x8 __attribute__((ext_vector_type(8)));
typedef short s16x4 __attribute__((ext_vector_type(4)));
typedef float f32x16 __attribute__((ext_vector_type(16)));
typedef unsigned u32x4 __attribute__((ext_vector_type(4)));
constexpr int NSLOT = 3, SLOTB = 16384;
constexpr int LDS_K = 0, LDS_V = NSLOT * SLOTB, LDS_BT = 2 * NSLOT * SLOTB, LDS_WS = LDS_BT + 1536, LDS_END = LDS_WS + 8 * 256;
constexpr int XROW = 132;
__device__ __forceinline__ int crow(int r, int hi) { return (r & 3) + 8 * (r >> 2) + 4 * hi; }
__device__ __forceinline__ s16x4 vtr(const LAS unsigned char* p) { typedef short v4i16_t __attribute__((ext_vector_type(4))); return __builtin_bit_cast(s16x4, __builtin_amdgcn_ds_read_tr16_b64_v4i16((LAS v4i16_t*)p)); }
#define ATT_WAIT_BAR(N) asm volatile("s_waitcnt vmcnt(" #N ") lgkmcnt(0)\n\ts_barrier" ::: "memory")
__device__ __forceinline__ void glds16(const void* gsrc, unsigned lds_dst) { unsigned keep;
    asm volatile("s_mov_b32 %0, m0\n\ts_mov_b32 m0, %2\n\ts_nop 0\n\tglobal_load_lds_dwordx4 %1, off\n\ts_mov_b32 m0, %0" : "=&s"(keep) : "v"(gsrc), "s"(lds_dst) : "memory"); }

template <int MODE> __device__ __forceinline__ void attn_unit(const P& p, LAS unsigned char* lds, int b, int h, int qb) {
    const int tid = threadIdx.x, lane = tid & 63, r32 = lane & 31, hi = lane >> 5;
    const int wid = __builtin_amdgcn_readfirstlane(tid >> 6), qg = wid & 3, mp = wid >> 2;
    const size_t rowbase = (size_t)b * SEQ;
    const int q0w = qb * 128 + qg * 32;
    const int NT = 2 * qb + 2, myNT = NT - (qg < 2 ? 1 : 0);
    LAS float* bt = (LAS float*)(lds + LDS_BT);
    for (int i = tid; i < 384; i += NTHR) bt[i] = p.miscf[MF_BIAS + h * 384 + i];
    const float cfar = p.miscf[MF_BIAS + h * 384];
    bf16x8 qr[4];
    { const bf16* Qw = p.Q + (rowbase + q0w + r32) * 512 + h * 128 + mp * 64 + hi * 8;
#pragma unroll
      for (int d0 = 0; d0 < 4; ++d0) qr[d0] = *(const bf16x8*)(Qw + d0 * 16); }
    const int krow0 = 8 * wid + (lane >> 4), krow1 = krow0 + 4;
    const bf16* ksrc = p.K + (rowbase + krow0) * 512 + h * 128 + (((lane & 15) ^ (krow0 & 15)) * 8);
    const bf16* ksrc1 = p.K + (rowbase + krow1) * 512 + h * 128 + (((lane & 15) ^ (krow1 & 15)) * 8);
    const bf16* vsrc; const bf16* vsrc1;
    { const int vr0 = 8 * wid + (lane >> 4), vr1 = vr0 + 4; const int c0_ = (lane & 15) ^ (vr0 & 15), c1_ = (lane & 15) ^ (vr1 & 15);
      vsrc = p.V + (size_t)(h * 128 + 2 * vr0 + (c0_ >> 3)) * 16384 + rowbase + (c0_ & 7) * 8;
      vsrc1 = p.V + (size_t)(h * 128 + 2 * vr1 + (c1_ >> 3)) * 16384 + rowbase + (c1_ & 7) * 8; }
    const unsigned kdst = LDS_K + (2 * wid) * 1024, vdst = LDS_V + (2 * wid) * 1024;
    const unsigned lds0 = (unsigned)(uintptr_t)lds;
#define ATT_ISSUE(t, so) do { const size_t gk_ = (size_t)(t) * 64 * 512, gv_ = (size_t)(t) * 64; const unsigned so_ = lds0 + (unsigned)__builtin_amdgcn_readfirstlane(so); \
        glds16(ksrc + gk_, (unsigned)__builtin_amdgcn_readfirstlane(so_ + kdst)); glds16(ksrc1 + gk_, (unsigned)__builtin_amdgcn_readfirstlane(so_ + kdst + 1024)); \
        glds16(vsrc + gv_, (unsigned)__builtin_amdgcn_readfirstlane(so_ + vdst)); glds16(vsrc1 + gv_, (unsigned)__builtin_amdgcn_readfirstlane(so_ + vdst + 1024)); } while (0)
    if (MODE != 2) { ATT_ISSUE(0, 0); ATT_ISSUE(1, SLOTB); }
    float cfar_ = cfar; asm volatile("" : "+v"(qr[0]), "+v"(qr[1]), "+v"(qr[2]), "+v"(qr[3]), "+v"(cfar_));
    f32x16 o[4];
#pragma unroll
    for (int d0 = 0; d0 < 4; ++d0) o[d0] = (f32x16){0.f, 0.f, 0.f, 0.f, 0.f, 0.f, 0.f, 0.f, 0.f, 0.f, 0.f, 0.f, 0.f, 0.f, 0.f, 0.f};
    float l_reg = 0.f;
    const int kap = (r32 & 0x13) | ((r32 & 4) << 1) | ((r32 & 8) >> 1);
    const LAS unsigned char* kp0 = lds + LDS_K + kap * 256;
    int kofs[4];
#pragma unroll
    for (int d0 = 0; d0 < 4; ++d0) kofs[d0] = ((mp * 8 + 2 * d0 + hi) ^ (kap & 15)) << 4;
    const int rl = r32 >> 1;
    const LAS unsigned char* vp0 = lds + LDS_V + rl * 256;
    int vofs[4];
#pragma unroll
    for (int ks = 0; ks < 4; ++ks) vofs[ks] = (((lane & 1) * 8 + 2 * ks + hi) ^ rl) << 4;
    bool scaled = false;
    int slot = 0;
#pragma unroll 1
    for (int t = 0; t < NT; ++t) {
        if (MODE == 2) { ATT_WAIT_BAR(0); } else if (t + 1 < NT) { ATT_WAIT_BAR(4); } else { ATT_WAIT_BAR(0); }
        { const int s2 = slot == 0 ? 2 * SLOTB : slot - SLOTB;
          if (MODE != 2 && t + 2 < NT) ATT_ISSUE(t + 2, s2); }
        if (MODE != 1 && t < myNT) {
            const LAS unsigned char* kp = kp0 + slot; const LAS unsigned char* vp = vp0 + slot;
            const bool nearb = (t * 64 + 63 - q0w) > -91;
            bf16x8 kf[8];
#pragma unroll
            for (int d0 = 0; d0 < 4; ++d0) { kf[2 * d0] = *(const LAS bf16x8*)(kp + kofs[d0]); kf[2 * d0 + 1] = *(const LAS bf16x8*)(kp + kofs[d0] + 8192); }
            __builtin_amdgcn_sched_barrier(0);
            f32x16 c0 = (f32x16){0.f, 0.f, 0.f, 0.f, 0.f, 0.f, 0.f, 0.f, 0.f, 0.f, 0.f, 0.f, 0.f, 0.f, 0.f, 0.f}, c1 = c0;
#pragma unroll
            for (int d0 = 0; d0 < 4; ++d0) {
                c0 = __builtin_amdgcn_mfma_f32_32x32x16_bf16(kf[2 * d0], qr[d0], c0, 0, 0, 0);
                c1 = __builtin_amdgcn_mfma_f32_32x32x16_bf16(kf[2 * d0 + 1], qr[d0], c1, 0, 0, 0);
            }
            __builtin_amdgcn_sched_barrier(0);
            bf16x8 vfa[8], vfb[8];
#pragma unroll
            for (int i = 0; i < 8; ++i) vfa[i] = *(const LAS bf16x8*)(vp + (i >> 2) * 4096 + vofs[i & 3]);
            __builtin_amdgcn_sched_barrier(0);
            if (nearb) {
                if (!scaled) { scaled = true; const float f = __builtin_amdgcn_exp2f(cfar_); l_reg *= f;
#pragma unroll
                    for (int d0 = 0; d0 < 4; ++d0) o[d0] = o[d0] * f; }
                const LAS float* bp = bt + (t * 64 - q0w - r32 + 256 + 8 * hi);
#pragma unroll
                for (int r = 0; r < 16; ++r) { const int cr = 16 * (r >> 3) + (r & 7); c0[r] += bp[cr]; c1[r] += bp[cr + 32]; }
            }
            float sacc = 0.f;
#pragma unroll
            for (int r = 0; r < 16; ++r) { c0[r] = __builtin_amdgcn_exp2f(c0[r]); c1[r] = __builtin_amdgcn_exp2f(c1[r]); sacc += c0[r] + c1[r]; }
            l_reg += sacc;
            u32x4 pw[4];
#pragma unroll
            for (int j = 0; j < 4; ++j) { pw[0][j] = pg8::cvt_pk_bf16(c0[2 * j], c0[2 * j + 1]); pw[1][j] = pg8::cvt_pk_bf16(c0[8 + 2 * j], c0[9 + 2 * j]);
                                          pw[2][j] = pg8::cvt_pk_bf16(c1[2 * j], c1[2 * j + 1]); pw[3][j] = pg8::cvt_pk_bf16(c1[8 + 2 * j], c1[9 + 2 * j]); }
#pragma unroll
            for (int i = 0; i < 8; ++i) vfb[i] = *(const LAS bf16x8*)(vp + 8192 + (i >> 2) * 4096 + vofs[i & 3]);
#pragma unroll
            for (int d0 = 0; d0 < 2; ++d0)
#pragma unroll
                for (int ks = 0; ks < 4; ++ks) o[d0] = __builtin_amdgcn_mfma_f32_32x32x16_bf16(__builtin_bit_cast(bf16x8, pw[ks]), vfa[d0 * 4 + ks], o[d0], 0, 0, 0);
#pragma unroll
            for (int d0 = 0; d0 < 2; ++d0)
#pragma unroll
                for (int ks = 0; ks < 4; ++ks) o[2 + d0] = __builtin_amdgcn_mfma_f32_32x32x16_bf16(__builtin_bit_cast(bf16x8, pw[ks]), vfb[d0 * 4 + ks], o[2 + d0], 0, 0, 0);
        }
        slot = slot == 2 * SLOTB ? 0 : slot + SLOTB;
    }
#undef ATT_ISSUE
    if (!scaled) { const float f = __builtin_amdgcn_exp2f(cfar_); l_reg *= f;
#pragma unroll
        for (int d0 = 0; d0 < 4; ++d0) o[d0] = o[d0] * f; }
    if (MODE != 0) { asm volatile("" :: "v"(o[0]), "v"(o[1]), "v"(o[2]), "v"(o[3]), "v"(l_reg)); ATT_WAIT_BAR(0); return; }
    l_reg += __shfl_xor(l_reg, 32);
    LAS float* wsf = (LAS float*)(lds + LDS_WS) + wid * 64;
    { const float lam = p.miscf[MF_LAM]; if (hi == 0) wsf[r32] = (mp == 0 ? 1.0f : lam) / l_reg; }
    asm volatile("s_waitcnt lgkmcnt(0)" ::: "memory");
#pragma unroll
    for (int r = 0; r < 16; ++r) { const float f = wsf[crow(r, hi)];
#pragma unroll
        for (int d0 = 0; d0 < 4; ++d0) o[d0][r] *= f; }
    ATT_WAIT_BAR(0);
    LAS float* X = (LAS float*)lds + qg * 32 * XROW;
    if (mp == 1) {
#pragma unroll
        for (int d0 = 0; d0 < 4; ++d0)
#pragma unroll
            for (int r = 0; r < 16; ++r) X[crow(r, hi) * XROW + d0 * 32 + r32] = o[d0][r];
    }
    ATT_WAIT_BAR(0);
    if (mp == 0) {
#pragma unroll
        for (int d0 = 0; d0 < 4; ++d0)
#pragma unroll
            for (int r = 0; r < 16; ++r) { LAS float* xp = X + crow(r, hi) * XROW + d0 * 32 + r32; *xp = o[d0][r] - *xp; }
        asm volatile("s_waitcnt lgkmcnt(0)" ::: "memory");
        const int row = lane >> 1, half = lane & 1;
        const LAS float* xr = X + row * XROW + half * 64;
        f32x4 v[16]; float ss = 0.f;
#pragma unroll
        for (int i = 0; i < 16; ++i) { v[i] = *(const LAS f32x4*)(xr + 4 * i); ss += v[i].x * v[i].x + v[i].y * v[i].y + v[i].z * v[i].z + v[i].w * v[i].w; }
        ss += __shfl_xor(ss, 1);
        const float rs = __builtin_amdgcn_rsqf(ss * (1.0f / 128.0f) + RMS_EPS) * (1.0f - LAMBDA_INIT);
        const float* gp = p.subln_g + half * 64;
        bf16* op = p.AB + (rowbase + q0w + row) * 1024 + h * 128 + half * 64;
#pragma unroll
        for (int i = 0; i < 8; ++i) { const f32x4 g0 = *(const f32x4*)(gp + 8 * i), g1 = *(const f32x4*)(gp + 8 * i + 4); const f32x4 a = v[2 * i] * rs * g0, c = v[2 * i + 1] * rs * g1;
            u32x4 w; w.x = pg8::cvt_pk_bf16(a.x, a.y); w.y = pg8::cvt_pk_bf16(a.z, a.w); w.z = pg8::cvt_pk_bf16(c.x, c.y); w.w = pg8::cvt_pk_bf16(c.z, c.w); *(u32x4*)(op + 8 * i) = w; }
    }
    ATT_WAIT_BAR(0);
}
#undef ATT_WAIT_BAR
}
__device__ __forceinline__ void ph_attn(const P& p, LAS unsigned char* lds, int bid, int nb) {
    const int vcu = (bid % 8) * (nb / 8) + bid / 8;
    for (int v = vcu; v < 256; v += nb) {
        const int bh = v >> 5, s = v & 31;
        att::attn_unit<0>(p, lds, bh >> 2, bh & 3, 63 - s);
        att::attn_unit<0>(p, lds, bh >> 2, bh & 3, s);
#if ATT_PROBE
        att::attn_unit<ATT_PROBE>(p, lds, bh >> 2, bh & 3, 63 - s);
        att::attn_unit<ATT_PROBE>(p, lds, bh >> 2, bh & 3, s);
#endif
    }
}


__device__ __forceinline__ void ph_pool(const P& p, LAS unsigned char* lds, int bid, int nb) {
    const int tid = threadIdx.x, lane = tid & 63, wave = tid >> 6;
    const int g = lane >> 4, w = 2 << g;
    LAS v4u* st = (LAS v4u*)lds;
    for (int rb = bid; rb < MTOK / 64; rb += nb) {
        const int r0 = rb * 64, t0 = r0 % SEQ;
        __syncthreads();
        for (int i = tid; i < 79 * 64; i += NTHR) { const int rr = i >> 6, row = r0 - 15 + rr; if (t0 - 15 + rr >= 0) st[i] = *(const v4u*)(p.U + (size_t)row * 512 + (i & 63) * 8); }
        __syncthreads();
#pragma unroll 1
        for (int i = 0; i < 8; ++i) {
            const int rl = wave * 8 + i, t = t0 + rl, cnt = t + 1 < w ? t + 1 : w;
            float s[8];
#pragma unroll
            for (int q = 0; q < 8; ++q) s[q] = 0.f;
            const v4u cur = st[(15 + rl) * 64 + lane];
#pragma unroll
            for (int jj = 0; jj < 16; ++jj) if (jj < cnt) { const v4u v = st[(15 + rl - jj) * 64 + lane];
                s[0] += bflo(v.x); s[1] += bfhi(v.x); s[2] += bflo(v.y); s[3] += bfhi(v.y); s[4] += bflo(v.z); s[5] += bfhi(v.z); s[6] += bflo(v.w); s[7] += bfhi(v.w); }
            const float ic = 1.0f / (float)cnt;
            v4u o; o.x = pk2(s[0] * ic - bflo(cur.x), s[1] * ic - bfhi(cur.x)); o.y = pk2(s[2] * ic - bflo(cur.y), s[3] * ic - bfhi(cur.y));
            o.z = pk2(s[4] * ic - bflo(cur.z), s[5] * ic - bfhi(cur.z)); o.w = pk2(s[6] * ic - bflo(cur.w), s[7] * ic - bfhi(cur.w));
            *(v4u*)(p.AB + (size_t)(r0 + rl) * 1024 + 512 + lane * 8) = o;
        }
    }
}

struct BranchOrder {
    pg8::StaticOrder so;
    __device__ bool next(int i, pg8::Unit& u) const { if (!so.tile((long)(i >> 1) * so.G + so.c, u)) return false; u.aux = i & 1; u.a_off += (unsigned)(i & 1) * 1024u; u.b_off += (unsigned)(i & 1) * 1024u; return true; }
    __device__ unsigned row_off(const pg8::Unit&, int) const { return 0u; }
};
struct InOrder {
    pg8::StaticOrder so;
    __device__ bool next(int i, pg8::Unit& u) const {
        if (!so.tile((long)i * so.G + so.c, u)) return false;
        if (u.pn == 4 || u.pn == 5) { u.a_off = (unsigned)WS_WIN + (unsigned)(1024 + 256 * (u.pn - 4)) * 2048u; u.b_off = (unsigned)WS_XN + (unsigned)u.pm * 524288u; }
        else { u.a_off = (unsigned)WS_XN + (unsigned)u.pm * 524288u; u.b_off = (unsigned)WS_WIN + (unsigned)u.pn * 524288u; }
        return true; }
    __device__ unsigned row_off(const pg8::Unit&, int) const { return 0u; }
};
__device__ __forceinline__ void ph_inproj(const P& p, LAS unsigned char* lds, int bid, int nb) {
    pg8::Gemm g{(const bf16*)p.ws, (const bf16*)p.ws, 1024, 1024, 16};
    InOrder S; S.so.init(MTOK, DIN, 1024, 1024, nb, bid);
    pg8::EpiIn E{p.Q, p.K, p.V, p.U, p.GA, p.GP, p.q_norm_g, p.k_norm_g};
    pg8::gemm_phase<pg8::EpiIn, InOrder, false>(lds, g, S, E);
}
__device__ __forceinline__ void ph_branch(const P& p, LAS unsigned char* lds, int bid, int nb) {
    pg8::Gemm g{p.AB, p.WBR, 1024, 1024, 8};
    BranchOrder S; S.so.init(MTOK, DM, 1024, 1024, nb, bid);
    pg8::EpiBranch E{p.XN, p.GA, p.GP};
    pg8::gemm_phase<pg8::EpiBranch, BranchOrder, false>(lds, g, S, E);
}
__device__ __forceinline__ void ph_wout(const P& p, LAS unsigned char* lds, int bid, int nb) {
    pg8::Gemm g{p.XN, p.WOUT, 1024, 1024, 16};
    pg8::StaticOrder S; S.init(MTOK, DM, 1024, 1024, nb, bid);
    pg8::EpiOut E{p.x, p.miscf + MF_MOD, p.out};
    pg8::gemm_phase<pg8::EpiOut, pg8::StaticOrder, false>(lds, g, S, E);
}


struct MoeOrder {
    const LAS int* arr; const unsigned* list; int G, vcu, npn; unsigned bstride, tB, tA;
    __device__ bool next(int i, pg8::Unit& u) const {
        const int L = i * G + vcu, T = arr[33 + 16]; if (L >= T * npn) return false;
        const int tile = L / npn, pn = L % npn; int e = 0;
#pragma unroll
        for (int k = 1; k < 16; ++k) e += (arr[33 + k] <= tile) ? 1 : 0;
        const int mt = tile - arr[33 + e];
        u.aux = e; u.pn = pn; u.pm = tile; u.n = arr[e]; u.pos0 = mt * 256; u.a_off = (unsigned)tile * tA; u.b_off = (unsigned)e * bstride + (unsigned)pn * tB; return true;
    }
    __device__ unsigned row_off(const pg8::Unit& u, int r) const { int pos = u.pos0 + r; pos = pos < u.n ? pos : u.n - 1; return list[((size_t)u.aux * 16384 + pos) * 2] * 2048u; }
};
__device__ __forceinline__ void ph_moe1(const P& p, LAS unsigned char* lds, unsigned char* ldsg, int bid, int nb) {
    int* arr = (int*)(ldsg + 131072); moe_offsets(p, arr);
    pg8::Gemm g{p.XN, p.W1, 1024, 1024, 16};
    MoeOrder S{(const LAS int*)(lds + 131072), p.list, nb, (bid % 8) * (nb / 8) + bid / 8, 4, 1024u * 1024u * 2u, 256u * 1024u * 2u, 0u};
    pg8::EpiMoe1 E{p.HID};
    pg8::gemm_phase<pg8::EpiMoe1, MoeOrder, true>(lds, g, S, E);
}
__device__ __forceinline__ void ph_moe2(const P& p, LAS unsigned char* lds, unsigned char* ldsg, int bid, int nb) {
    int* arr = (int*)(ldsg + 131072); moe_offsets(p, arr);
    pg8::Gemm g{p.HID, p.W2, 512, 512, 8};
    MoeOrder S{(const LAS int*)(lds + 131072), p.list, nb, (bid % 8) * (nb / 8) + bid / 8, 4, 1024u * 512u * 2u, 256u * 512u * 2u, 256u * 512u * 2u};
    pg8::EpiMoe2 E{p.Y, p.list};
    pg8::gemm_phase<pg8::EpiMoe2, MoeOrder, false>(lds, g, S, E);
}

constexpr int N_PHASES = 11;
__global__ void __launch_bounds__(NTHR, 2) mega_fwd(Args args) {
    extern __shared__ __attribute__((aligned(16))) unsigned char lds[];
    P p;
    p.x = args.in[0]; p.c = args.in[1]; p.rel_bias = args.in[2]; p.ada_w = args.in[3]; p.ada_b = args.in[4]; p.norm1_g = args.in[5]; p.w_in = args.in[6]; p.q_norm_g = args.in[7]; p.k_norm_g = args.in[8];
    p.lq1 = args.in[9]; p.lk1 = args.in[10]; p.lq2 = args.in[11]; p.lk2 = args.in[12]; p.subln_g = args.in[13]; p.wba = args.in[14]; p.pool_w = args.in[15]; p.pool_scale = args.in[16]; p.wbp = args.in[17];
    p.w_out = args.in[18]; p.norm2_g = args.in[19]; p.rgw = args.in[20]; p.rgb = args.in[21]; p.rew = args.in[22]; p.reb = args.in[23]; p.wgate = args.in[24]; p.wup = args.in[25]; p.wdown = args.in[26];
    p.out = args.out; p.ws = args.ws;
    unsigned char* ws = args.ws;
    p.ctl = (unsigned*)(ws + WS_CTL); p.miscf = (float*)(ws + WS_MISC); p.list = (unsigned*)(ws + WS_LIST); p.route = (int*)(ws + WS_ROUTE);
    p.WIN = (bf16*)(ws + WS_WIN); p.WBR = (bf16*)(ws + WS_WBR); p.WOUT = (bf16*)(ws + WS_WOUT); p.W1 = (bf16*)(ws + WS_W1); p.W2 = (bf16*)(ws + WS_W2);
    p.XN = (bf16*)(ws + WS_XN); p.Q = (bf16*)(ws + WS_Q); p.K = (bf16*)(ws + WS_K); p.V = (bf16*)(ws + WS_V); p.U = (bf16*)(ws + WS_U); p.GA = (bf16*)(ws + WS_GA); p.GP = (bf16*)(ws + WS_GP);
    p.AB = (bf16*)(ws + WS_AB); p.HID = (bf16*)(ws + WS_HID); p.Y = (bf16*)(ws + WS_Y);
    const int bid = blockIdx.x, nb = gridDim.x;
    const int lo = args.ph_lo, hi = args.ph_hi;
    volatile LAS unsigned* MISC = (volatile LAS unsigned*)((LAS unsigned char*)lds + LDS_BYTES - 64);
    XcdBarrier bar; bar.bar = p.ctl + CW_BAR; bar.x = 0; bar.st = nullptr;
    if (hi - lo > 1) {
        if (threadIdx.x < 2) MISC[threadIdx.x] = 0u;
        __syncthreads();
        bar = xcd_barrier_post(p.ctl + CW_BAR, MISC);
    }
#ifndef PHASE_MASK
#define PHASE_MASK 0xFFFF
#endif
#define IN(k) (((PHASE_MASK >> (k)) & 1) && lo <= (k) && (k) < hi)
    const int rz_ = (REP_PHASE >= 0) ? lo : 0;
#ifndef BAR_REP
#define BAR_REP 1
#endif
#define SEAM(k) do { if (IN(k) && IN((k) + 1)) { for (int br_ = 0; br_ < BAR_REP; ++br_) xcd_barrier(bar); } } while (0)
    if (IN(0)) { _Pragma("unroll 1") for (int rp = 0; rp < NREP(0) + rz_; ++rp) { ph_prologue(p, lds, bid, nb); __syncthreads(); } } SEAM(0);
    if (IN(1)) { _Pragma("unroll 1") for (int rp = 0; rp < NREP(1) + rz_; ++rp) { ph_norm1(p, lds, bid, nb); __syncthreads(); } } SEAM(1);
#if FAST_INPROJ == 2
    if (IN(2)) { ph_inproj_naive(p, lds, bid, nb); } SEAM(2);
    if (IN(3)) { ph_qknorm_naive(p, bid, nb); __syncthreads(); ph_inproj(p, (LAS unsigned char*)lds, bid, nb); } SEAM(3);
#elif FAST_INPROJ
    if (IN(2)) { _Pragma("unroll 1") for (int rp = 0; rp < NREP(2) + rz_; ++rp) { ph_inproj(p, (LAS unsigned char*)lds, bid, nb); __syncthreads(); } } SEAM(2);
#else
    if (IN(2)) { ph_inproj_naive(p, lds, bid, nb); } SEAM(2);
    if (IN(3)) { ph_qknorm_naive(p, bid, nb); } SEAM(3);
#endif
#if FAST_ATTN
    if (IN(4)) { _Pragma("unroll 1") for (int rp = 0; rp < NREP(4) + rz_; ++rp) ph_attn(p, (LAS unsigned char*)lds, bid, nb); __syncthreads(); _Pragma("unroll 1") for (int rp = 0; rp < NREP(11) + rz_; ++rp) { ph_pool(p, (LAS unsigned char*)lds, bid, nb); } } SEAM(4);
#else
    if (IN(4)) { ph_attn_naive(p, lds, bid, nb); __syncthreads(); ph_pool_naive(p, lds, bid, nb); } SEAM(4);
#endif
#if FAST_BRANCH
    if (IN(5)) { _Pragma("unroll 1") for (int rp = 0; rp < NREP(5) + rz_; ++rp) ph_branch(p, (LAS unsigned char*)lds, bid, nb); } SEAM(5);
#else
    if (IN(5)) { ph_branch_naive(p, lds, bid, nb); } SEAM(5);
#endif
#if FAST_WOUT
    if (IN(6)) { _Pragma("unroll 1") for (int rp = 0; rp < NREP(6) + rz_; ++rp) ph_wout(p, (LAS unsigned char*)lds, bid, nb); } SEAM(6);
#else
    if (IN(6)) { ph_wout_naive(p, lds, bid, nb); } SEAM(6);
#endif
    if (IN(7)) { ph_norm2_route(p, lds, bid, nb); } SEAM(7);
#if FAST_MOE
    if (IN(8)) { _Pragma("unroll 1") for (int rp = 0; rp < NREP(8) + rz_; ++rp) ph_moe1(p, (LAS unsigned char*)lds, lds, bid, nb); } SEAM(8);
    if (IN(9)) { _Pragma("unroll 1") for (int rp = 0; rp < NREP(9) + rz_; ++rp) ph_moe2(p, (LAS unsigned char*)lds, lds, bid, nb); } SEAM(9);
#else
    if (IN(8)) { ph_moe1_naive(p, lds, bid, nb); } SEAM(8);
    if (IN(9)) { ph_moe2_naive(p, lds, bid, nb); } SEAM(9);
#endif
    if (IN(10)) { ph_combine(p, lds, bid, nb); }
#undef IN
#undef SEAM
}

extern "C" void kernel_launch(void* const* d_in, const int* in_sizes, int n_in, void* d_out, int out_size, void* d_ws, size_t ws_size, hipStream_t stream) {
    static int grid = 0;
    if (grid == 0) {
        if (n_in != 27 || in_sizes[0] != MTOK * DM || out_size != MTOK * DM || ws_size < WS_END) {
            fprintf(stderr, "kernel_launch: unexpected shapes: n_in %d in0 %d out %d ws %zu; nothing launched\n", n_in, n_in > 0 ? in_sizes[0] : -1, out_size, ws_size); grid = -1; return; }
        int dev = 0, cus = 0;
        if (hipGetDevice(&dev) != hipSuccess || hipDeviceGetAttribute(&cus, hipDeviceAttributeMultiprocessorCount, dev) != hipSuccess) { grid = -1; return; }
        if (hipFuncSetAttribute((const void*)mega_fwd, hipFuncAttributeMaxDynamicSharedMemorySize, LDS_BYTES) != hipSuccess) { fprintf(stderr, "kernel_launch: hipFuncSetAttribute failed\n"); grid = -1; return; }
        int per_cu = 0;
        if (hipOccupancyMaxActiveBlocksPerMultiprocessor(&per_cu, (const void*)mega_fwd, NTHR, LDS_BYTES) != hipSuccess || per_cu < 1)
            fprintf(stderr, "kernel_launch: note: occupancy query reports %d workgroups per CU\n", per_cu);
        (void)hipGetLastError();
        grid = cus;
    }
    if (grid < 0) return;
    (void)hipMemsetAsync((char*)d_ws + WS_CTL, 0, CTL_ZERO_BYTES, stream);
    Args a{};
    for (int i = 0; i < 27; ++i) a.in[i] = (const float*)d_in[i];
    a.out = (float*)d_out; a.ws = (unsigned char*)d_ws;
    if (MK_N_LAUNCHES == 1) {
        a.ph_lo = 0; a.ph_hi = N_PHASES;
        hipLaunchKernelGGL(mega_fwd, dim3(grid), dim3(NTHR), LDS_BYTES, stream, a);
    } else {
        for (int k = 0; k < N_PHASES; ++k) { a.ph_lo = k; a.ph_hi = k + 1; hipLaunchKernelGGL(mega_fwd, dim3(grid), dim3(NTHR), LDS_BYTES, stream, a); }
    }
}
```
